# Optimizing an MI355X kernel written in HIP

```python
import jax, jax.numpy as jnp
from jax import lax
import numpy as np

D_MODEL = 1024
BATCH = 8
SEQ = 8192
DEPTH = 2
DEC_BATCH = 16
DEC_SEQ = 16
PAST_LEN = 1024

CHUNK = 64
LIN_BLOCK = 16
N_EVEN = (DEPTH + 1) // 2
N_ODD = DEPTH // 2
F32 = jnp.float32
EPS = 1e-6

H_A = 8
N_A = 64
A_DIM = H_A * N_A
A_W_RANK = 64
A_A_RANK = 64
A_G_RANK = 128
A_PROJ = 3 * A_DIM + A_W_RANK + A_A_RANK + A_G_RANK
A_SPLITS = (A_DIM, 2 * A_DIM, 3 * A_DIM, 3 * A_DIM + A_W_RANK, 3 * A_DIM + A_W_RANK + A_A_RANK)
RWKV_LN_EPS = 64e-5
H_B = 4
DK_B = 128
DV_B = 128
CONV_W = 4
B_CONV_DIM = H_B * (2 * DK_B + DV_B)
B_PROJ = B_CONV_DIM + 2 * H_B + H_B * DV_B
B_SPLITS = (B_CONV_DIM, B_CONV_DIM + H_B, B_CONV_DIM + 2 * H_B)
EVEN_PROJ = A_PROJ + B_PROJ
EVEN_MIX = A_DIM + H_B * DV_B
H_C = 4
DK_C = 64
DV_C = 128
C_A_RANK = 16
GLA_NORMALIZER = 16.0
C_PROJ = H_C * (2 * DK_C + 2 * DV_C) + C_A_RANK
C_SPLITS = (H_C * DK_C, 2 * H_C * DK_C, 2 * H_C * DK_C + H_C * DV_C, 2 * H_C * DK_C + H_C * DV_C + C_A_RANK)
H_D = 4
DK_D = 128
DV_D = 128
D_PROJ = H_D * (2 * DK_D + 2 * DV_D)
D_SPLITS = (H_D * DK_D, 2 * H_D * DK_D, 2 * H_D * DK_D + H_D * DV_D)
ROPE_BASE = 10000.0
ODD_PROJ = C_PROJ + D_PROJ
ODD_MIX = H_C * DV_C + H_D * DV_D
N_MEM = 256
MEM_HEADS = 4
MEM_HD = D_MODEL // MEM_HEADS
D_FF = 2816

kernel_name = 'hybrid_streaming_encoder_step'


def _rmsnorm(x, w):
    xf = x.astype(F32)
    y = xf * lax.rsqrt(jnp.mean(xf * xf, axis=-1, keepdims=True) + EPS)
    return (y * w.astype(F32)).astype(x.dtype)


def _swiglu(h, wg, wu, wd):
    return (jax.nn.silu(h @ wg) * (h @ wu)) @ wd


def _l2norm(x):
    xf = x.astype(F32)
    return xf * lax.rsqrt(jnp.sum(xf * xf, axis=-1, keepdims=True) + EPS)


def _head_rmsnorm(x, w):
    xf = x.astype(F32)
    return xf * lax.rsqrt(jnp.mean(xf * xf, axis=-1, keepdims=True) + EPS) * w.astype(F32)


def _head_layernorm(x, eps):
    xf = x.astype(F32)
    mu = jnp.mean(xf, axis=-1, keepdims=True)
    xc = xf - mu
    return xc * lax.rsqrt(jnp.mean(xc * xc, axis=-1, keepdims=True) + eps)


def _rotary(x, pos):
    d = x.shape[-1]
    inv = ROPE_BASE ** (-jnp.arange(0, d, 2, dtype=F32) / d)
    ang = pos[:, None] * inv[None, :]
    cos, sin = jnp.cos(ang)[:, None, :], jnp.sin(ang)[:, None, :]
    x1, x2 = x[..., : d // 2].astype(F32), x[..., d // 2:].astype(F32)
    return jnp.concatenate([x1 * cos - x2 * sin, x1 * sin + x2 * cos], axis=-1)


def _pad_time(x, pad):
    return jnp.pad(x, [(0, 0), (0, pad)] + [(0, 0)] * (x.ndim - 2))


def _to_blocks(x, L):
    b, t, h, d = x.shape
    return x.reshape(b, t // L, L, h, d).transpose(1, 0, 3, 2, 4)


def _to_blocks3(x, L):
    b, t, h = x.shape
    return x.reshape(b, t // L, L, h).transpose(1, 0, 3, 2)


def _from_blocks(x):
    n, b, h, l, d = x.shape
    return x.transpose(1, 0, 3, 2, 4).reshape(b, n * l, h, d)


def _chunked_decay_linear_attn(q, k, v, log_a, s0, block):
    t = q.shape[1]
    pad = (-t) % block
    q, k, v, log_a = (_to_blocks(_pad_time(z.astype(F32), pad), block) for z in (q, k, v, log_a))
    cum = jnp.cumsum(log_a, axis=3)
    total = cum[:, :, :, -1:, :]
    q_in = q * jnp.exp(cum)
    k_in = k * jnp.exp(-cum)
    k_out = k * jnp.exp(total - cum)
    causal = jnp.tril(jnp.ones((block, block), dtype=bool))
    scores = jnp.where(causal, jnp.einsum('nbhld,nbhmd->nbhlm', q_in, k_in), 0.0)
    intra = jnp.einsum('nbhlm,nbhmv->nbhlv', scores, v)
    dec = jnp.exp(jnp.swapaxes(total, -1, -2))

    def step(s, inp):
        qi, ko, vi, di, oi = inp
        o = jnp.einsum('bhld,bhdv->bhlv', qi, s) + oi
        s = s * di + jnp.einsum('bhld,bhlv->bhdv', ko, vi)
        return s, o

    s_fin, o = lax.scan(step, s0.astype(F32), (q_in, k_out, v, dec, intra))
    return _from_blocks(o)[:, :t], s_fin


def _chunked_gated_delta(q, k, v, g, beta, s0):
    t = q.shape[1]
    L = min(CHUNK, t)
    pad = (-t) % L
    q, k, v = (_to_blocks(_pad_time(z.astype(F32), pad), L) for z in (q, k, v))
    g, beta = (_to_blocks3(_pad_time(z.astype(F32), pad), L) for z in (g, beta))
    dv = v.shape[-1]
    G = jnp.cumsum(g, axis=-1)
    diff = G[..., :, None] - G[..., None, :]
    strict = jnp.tril(jnp.ones((L, L), dtype=bool), -1)
    incl = jnp.tril(jnp.ones((L, L), dtype=bool))
    gam_strict = jnp.where(strict, jnp.exp(jnp.where(strict, diff, 0.0)), 0.0)
    gam_incl = jnp.where(incl, jnp.exp(jnp.where(incl, diff, 0.0)), 0.0)
    eG = jnp.exp(G)
    m = jnp.eye(L, dtype=F32) + beta[..., :, None] * jnp.einsum('nbhld,nbhmd->nbhlm', k, k) * gam_strict
    rhs = jnp.concatenate([beta[..., None] * v, (beta * eG)[..., None] * k], axis=-1)
    sol = lax.linalg.triangular_solve(m, rhs, left_side=True, lower=True, unit_diagonal=True)
    vb, wk = sol[..., :dv], sol[..., dv:]
    qk = jnp.einsum('nbhld,nbhmd->nbhlm', q, k) * gam_incl
    qg = q * eG[..., None]
    kdec = k * jnp.exp(G[..., -1:] - G)[..., None]
    gl = eG[..., -1][..., None, None]

    def step(s, inp):
        vb_i, wk_i, qk_i, qg_i, kd_i, gl_i = inp
        u = vb_i - jnp.einsum('bhld,bhdv->bhlv', wk_i, s)
        o = jnp.einsum('bhld,bhdv->bhlv', qg_i, s) + jnp.einsum('bhlm,bhmv->bhlv', qk_i, u)
        s = gl_i * s + jnp.einsum('bhld,bhlv->bhdv', kd_i, u)
        return s, o

    s_fin, o = lax.scan(step, s0.astype(F32), (vb, wk, qk, qg, kdec, gl))
    return _from_blocks(o)[:, :t], s_fin


def _rwkv7_recurrence(r, w, k, v, a, b, s0):
    def step(s, inp):
        rt, wt, kt, vt, at, bt = inp
        sa = jnp.einsum('bhvk,bhk->bhv', s, at)
        s = s * wt[:, :, None, :] + sa[..., None] * bt[:, :, None, :] + vt[..., None] * kt[:, :, None, :]
        return s, jnp.einsum('bhvk,bhk->bhv', s, rt)

    xs = tuple(jnp.moveaxis(z.astype(F32), 1, 0) for z in (r, w, k, v, a, b))
    s_fin, y = lax.scan(step, s0.astype(F32), xs)
    return jnp.moveaxis(y, 0, 1), s_fin


def _even_mixer(h, shift0, rwkv0, conv0, delta0, W, i):
    b, t, _ = h.shape
    p = h @ W['even_w_in'][i]
    pa, pb = p[..., :A_PROJ], p[..., A_PROJ:]
    prev = jnp.concatenate([shift0.astype(pa.dtype), pa[:, :-1]], axis=1)
    xa = pa + (prev - pa) * W['rwkv_mu'][i]
    new_shift = pa[:, -1:]
    r, k, v, xw, xk_a, xg = jnp.split(xa, A_SPLITS, axis=-1)
    wlog = -jax.nn.softplus(-(W['rwkv_w0'][i] + jnp.tanh(xw) @ W['rwkv_w2'][i]).astype(F32)) - 0.5
    decay = jnp.exp(-jnp.exp(wlog))
    a = jax.nn.sigmoid((W['rwkv_a0'][i] + xk_a @ W['rwkv_a2'][i]).astype(F32))
    gate = jax.nn.sigmoid(xg) @ W['rwkv_g2'][i]
    heads = lambda z: z.astype(F32).reshape(b, t, H_A, N_A)
    r, k, v, a, decay = heads(r), heads(k), heads(v), heads(a), heads(decay)
    kk = _l2norm(k * W['rwkv_kk'][i].reshape(H_A, N_A))
    k = k * (1.0 + (a - 1.0) * W['rwkv_ka'][i].reshape(H_A, N_A))
    y, rwkv_new = _rwkv7_recurrence(r, decay, k, v, -kk, kk * a, rwkv0)
    y = _head_layernorm(y, RWKV_LN_EPS) * W['rwkv_ln_w'][i].reshape(H_A, N_A) + W['rwkv_ln_b'][i].reshape(H_A, N_A)
    y = y + jnp.sum(r * k * W['rwkv_rk'][i], axis=-1, keepdims=True) * v
    y_a = y.reshape(b, t, A_DIM) * gate
    qkv, ba, bb, z = jnp.split(pb, B_SPLITS, axis=-1)
    cat = jnp.concatenate([conv0.astype(qkv.dtype), qkv], axis=1)
    cw = W['delta_conv_w'][i]
    conv = cat[:, 0:t] * cw[0]
    for j in range(1, CONV_W):
        conv = conv + cat[:, j:j + t] * cw[j]
    new_conv = cat[:, t:]
    conv = jax.nn.silu(conv)
    q, kb, vb = jnp.split(conv, (H_B * DK_B, 2 * H_B * DK_B), axis=-1)
    q = _l2norm(q.reshape(b, t, H_B, DK_B)) * DK_B ** -0.5
    kb = _l2norm(kb.reshape(b, t, H_B, DK_B))
    vb = vb.reshape(b, t, H_B, DV_B)
    g = -jnp.exp(W['delta_A_log'][i].astype(F32)) * jax.nn.softplus((ba + W['delta_dt_bias'][i]).astype(F32))
    beta = jax.nn.sigmoid(bb.astype(F32))
    o, delta_new = _chunked_gated_delta(q, kb, vb, g, beta, delta0)
    o = _head_rmsnorm(o, W['delta_norm_w'][i]) * jax.nn.silu(z.reshape(b, t, H_B, DV_B).astype(F32))
    y_b = o.reshape(b, t, H_B * DV_B)
    y = jnp.concatenate([y_a, y_b], axis=-1).astype(h.dtype) @ W['even_w_out'][i]
    return y, new_shift, rwkv_new, new_conv, delta_new


def _odd_mixer(h, pos0, gla0, ret0, W, i):
    b, t, _ = h.shape
    p = h @ W['odd_w_in'][i]
    pc, pd = p[..., :C_PROJ], p[..., C_PROJ:]
    cq, ck, cv, cad, cg = jnp.split(pc, C_SPLITS, axis=-1)
    log_a = jax.nn.log_sigmoid((cad @ W['gla_a2'][i] + W['gla_a_bias'][i]).astype(F32)) / GLA_NORMALIZER
    q = cq.reshape(b, t, H_C, DK_C) * DK_C ** -0.5
    o, gla_new = _chunked_decay_linear_attn(q, ck.reshape(b, t, H_C, DK_C), cv.reshape(b, t, H_C, DV_C),
                                            log_a.reshape(b, t, H_C, DK_C), gla0, LIN_BLOCK)
    y_c = (_head_rmsnorm(o, W['gla_norm_w'][i]) * jax.nn.silu(cg.reshape(b, t, H_C, DV_C).astype(F32))).reshape(b, t, H_C * DV_C)
    dq, dk, dv, dg = jnp.split(pd, D_SPLITS, axis=-1)
    pos = (jnp.arange(t) + pos0).astype(F32)
    q = _rotary(dq.reshape(b, t, H_D, DK_D), pos)
    k = _rotary(dk.reshape(b, t, H_D, DK_D), pos) * DK_D ** -0.5
    log_gamma = jnp.log(1.0 - 2.0 ** (-5.0 - jnp.arange(H_D, dtype=F32)))
    la = jnp.broadcast_to(log_gamma[:, None], (b, t, H_D, 1))
    o, ret_new = _chunked_decay_linear_attn(q, k, dv.reshape(b, t, H_D, DV_D), la, ret0, LIN_BLOCK)
    y_d = (_head_layernorm(o, EPS) * jax.nn.silu(dg.reshape(b, t, H_D, DV_D).astype(F32))).reshape(b, t, H_D * DV_D)
    y = jnp.concatenate([y_c, y_d], axis=-1).astype(h.dtype) @ W['odd_w_out'][i]
    return y, gla_new, ret_new


def _mem_kv(mem, norm_w, wk, wv):
    m = _rmsnorm(mem, norm_w)
    b, n, _ = m.shape
    return (m @ wk).reshape(b, n, MEM_HEADS, MEM_HD), (m @ wv).reshape(b, n, MEM_HEADS, MEM_HD)


def _mem_attn(h, mk, mv, wq, wo):
    b, t, _ = h.shape
    q = (h @ wq).reshape(b, t, MEM_HEADS, MEM_HD)
    s = jnp.einsum('bthd,bmhd->bhtm', q, mk.astype(q.dtype)).astype(F32) * MEM_HD ** -0.5
    pr = jax.nn.softmax(s, axis=-1).astype(h.dtype)
    o = jnp.einsum('bhtm,bmhd->bthd', pr, mv.astype(h.dtype)).reshape(b, t, D_MODEL)
    return o @ wo


def _trunk(x, pos0, mem_k, mem_v, shift, rwkv, conv, delta, gla, ret, W):
    n_shift, n_rwkv, n_conv, n_delta, n_gla, n_ret = [], [], [], [], [], []
    for l in range(DEPTH):
        x = x + 0.5 * _swiglu(_rmsnorm(x, W['norm_ffn1'][l]), W['ffn1_wg'][l], W['ffn1_wu'][l], W['ffn1_wd'][l])
        h = _rmsnorm(x, W['norm_mix'][l])
        i = l // 2
        if l % 2 == 0:
            y, s1, s2, s3, s4 = _even_mixer(h, shift[i], rwkv[i], conv[i], delta[i], W, i)
            n_shift.append(s1)
            n_rwkv.append(s2)
            n_conv.append(s3)
            n_delta.append(s4)
        else:
            y, s5, s6 = _odd_mixer(h, pos0, gla[i], ret[i], W, i)
            n_gla.append(s5)
            n_ret.append(s6)
        x = x + y
        x = x + _mem_attn(_rmsnorm(x, W['norm_mem'][l]), mem_k[l], mem_v[l], W['mem_wq'][l], W['mem_wo'][l])
        x = x + 0.5 * _swiglu(_rmsnorm(x, W['norm_ffn2'][l]), W['ffn2_wg'][l], W['ffn2_wu'][l], W['ffn2_wd'][l])
    return _rmsnorm(x, W['final_norm']), (n_shift, n_rwkv, n_conv, n_delta, n_gla, n_ret)


def setup_inputs(seed: int = 0) -> dict:
    key = jax.random.key(seed)
    keys = iter(jax.random.split(key, 96))

    def nrm(shape, scale=1.0):
        return jax.random.normal(next(keys), shape, F32) * scale

    def unif(shape, lo, hi):
        return jax.random.uniform(next(keys), shape, F32, lo, hi)

    def gain(shape):
        return 1.0 + 0.05 * nrm(shape)

    D = D_MODEL
    return {
        'x_prompt': nrm((BATCH, SEQ, D)),
        'x_sample': nrm((DEC_BATCH, DEC_SEQ, D)),
        'mem_prompt': nrm((BATCH, N_MEM, D)),
        'state_rwkv_shift': nrm((N_EVEN, DEC_BATCH, 1, A_PROJ)),
        'state_rwkv': nrm((N_EVEN, DEC_BATCH, H_A, N_A, N_A), 0.3),
        'state_delta_conv': nrm((N_EVEN, DEC_BATCH, CONV_W - 1, B_CONV_DIM)),
        'state_delta': nrm((N_EVEN, DEC_BATCH, H_B, DK_B, DV_B), DK_B ** -0.5),
        'state_gla': nrm((N_ODD, DEC_BATCH, H_C, DK_C, DV_C), 0.3),
        'state_ret': nrm((N_ODD, DEC_BATCH, H_D, DK_D, DV_D), 0.3),
        'cache_mem_k': nrm((DEPTH, DEC_BATCH, N_MEM, MEM_HEADS, MEM_HD)),
        'cache_mem_v': nrm((DEPTH, DEC_BATCH, N_MEM, MEM_HEADS, MEM_HD)),
        'norm_ffn1': gain((DEPTH, D)),
        'ffn1_wg': nrm((DEPTH, D, D_FF), D ** -0.5),
        'ffn1_wu': nrm((DEPTH, D, D_FF), D ** -0.5),
        'ffn1_wd': nrm((DEPTH, D_FF, D), D_FF ** -0.5),
        'norm_mix': gain((DEPTH, D)),
        'even_w_in': nrm((N_EVEN, D, EVEN_PROJ), D ** -0.5),
        'even_w_out': nrm((N_EVEN, EVEN_MIX, D), EVEN_MIX ** -0.5),
        'rwkv_mu': unif((N_EVEN, A_PROJ), 0.0, 1.0),
        'rwkv_w0': unif((N_EVEN, A_DIM), -4.0, 0.0),
        'rwkv_w2': nrm((N_EVEN, A_W_RANK, A_DIM), 0.5 * A_W_RANK ** -0.5),
        'rwkv_a0': nrm((N_EVEN, A_DIM), 0.5),
        'rwkv_a2': nrm((N_EVEN, A_A_RANK, A_DIM), A_A_RANK ** -0.5),
        'rwkv_g2': nrm((N_EVEN, A_G_RANK, A_DIM), A_G_RANK ** -0.5),
        'rwkv_kk': 0.85 + 0.05 * nrm((N_EVEN, A_DIM)),
        'rwkv_ka': gain((N_EVEN, A_DIM)),
        'rwkv_rk': nrm((N_EVEN, H_A, N_A), 0.1),
        'rwkv_ln_w': gain((N_EVEN, A_DIM)),
        'rwkv_ln_b': nrm((N_EVEN, A_DIM), 0.02),
        'delta_conv_w': nrm((N_EVEN, CONV_W, B_CONV_DIM), 0.5),
        'delta_A_log': jnp.log(unif((N_EVEN, H_B), 1.0, 16.0)),
        'delta_dt_bias': nrm((N_EVEN, H_B), 0.1),
        'delta_norm_w': gain((N_EVEN, DV_B)),
        'odd_w_in': nrm((N_ODD, D, ODD_PROJ), D ** -0.5),
        'odd_w_out': nrm((N_ODD, ODD_MIX, D), ODD_MIX ** -0.5),
        'gla_a2': nrm((N_ODD, C_A_RANK, H_C * DK_C), C_A_RANK ** -0.5),
        'gla_a_bias': nrm((N_ODD, H_C * DK_C), 0.1),
        'gla_norm_w': gain((N_ODD, DV_C)),
        'norm_mem': gain((DEPTH, D)),
        'mem_norm_kv': gain((DEPTH, D)),
        'mem_wq': nrm((DEPTH, D, D), D ** -0.5),
        'mem_wk': nrm((DEPTH, D, D), D ** -0.5),
        'mem_wv': nrm((DEPTH, D, D), D ** -0.5),
        'mem_wo': nrm((DEPTH, D, D), D ** -0.5),
        'norm_ffn2': gain((DEPTH, D)),
        'ffn2_wg': nrm((DEPTH, D, D_FF), D ** -0.5),
        'ffn2_wu': nrm((DEPTH, D, D_FF), D ** -0.5),
        'ffn2_wd': nrm((DEPTH, D_FF, D), D_FF ** -0.5),
        'final_norm': gain((D,)),
    }


def reference(x_prompt, x_sample, mem_prompt, state_rwkv_shift, state_rwkv, state_delta_conv, state_delta,
              state_gla, state_ret, cache_mem_k, cache_mem_v, norm_ffn1, ffn1_wg, ffn1_wu, ffn1_wd, norm_mix,
              even_w_in, even_w_out, rwkv_mu, rwkv_w0, rwkv_w2, rwkv_a0, rwkv_a2, rwkv_g2, rwkv_kk, rwkv_ka,
              rwkv_rk, rwkv_ln_w, rwkv_ln_b, delta_conv_w, delta_A_log, delta_dt_bias, delta_norm_w, odd_w_in,
              odd_w_out, gla_a2, gla_a_bias, gla_norm_w, norm_mem, mem_norm_kv, mem_wq, mem_wk, mem_wv, mem_wo,
              norm_ffn2, ffn2_wg, ffn2_wu, ffn2_wd, final_norm):
    W = dict(norm_ffn1=norm_ffn1, ffn1_wg=ffn1_wg, ffn1_wu=ffn1_wu, ffn1_wd=ffn1_wd, norm_mix=norm_mix,
             even_w_in=even_w_in, even_w_out=even_w_out, rwkv_mu=rwkv_mu, rwkv_w0=rwkv_w0, rwkv_w2=rwkv_w2,
             rwkv_a0=rwkv_a0, rwkv_a2=rwkv_a2, rwkv_g2=rwkv_g2, rwkv_kk=rwkv_kk, rwkv_ka=rwkv_ka,
             rwkv_rk=rwkv_rk, rwkv_ln_w=rwkv_ln_w, rwkv_ln_b=rwkv_ln_b, delta_conv_w=delta_conv_w,
             delta_A_log=delta_A_log, delta_dt_bias=delta_dt_bias, delta_norm_w=delta_norm_w,
             odd_w_in=odd_w_in, odd_w_out=odd_w_out, gla_a2=gla_a2, gla_a_bias=gla_a_bias,
             gla_norm_w=gla_norm_w, norm_mem=norm_mem, mem_wq=mem_wq, mem_wo=mem_wo, norm_ffn2=norm_ffn2,
             ffn2_wg=ffn2_wg, ffn2_wu=ffn2_wu, ffn2_wd=ffn2_wd, final_norm=final_norm)
    dt = x_prompt.dtype
    bp = x_prompt.shape[0]
    pk, pv = [], []
    for l in range(DEPTH):
        mk, mv = _mem_kv(mem_prompt, mem_norm_kv[l], mem_wk[l], mem_wv[l])
        pk.append(mk)
        pv.append(mv)
    z_shift = [jnp.zeros((bp, 1, A_PROJ), F32)] * N_EVEN
    z_rwkv = [jnp.zeros((bp, H_A, N_A, N_A), F32)] * N_EVEN
    z_conv = [jnp.zeros((bp, CONV_W - 1, B_CONV_DIM), F32)] * N_EVEN
    z_delta = [jnp.zeros((bp, H_B, DK_B, DV_B), F32)] * N_EVEN
    z_gla = [jnp.zeros((bp, H_C, DK_C, DV_C), F32)] * N_ODD
    z_ret = [jnp.zeros((bp, H_D, DK_D, DV_D), F32)] * N_ODD
    y_prompt, ps = _trunk(x_prompt, 0, pk, pv, z_shift, z_rwkv, z_conv, z_delta, z_gla, z_ret, W)
    y_sample, ss = _trunk(x_sample, PAST_LEN,
                          [cache_mem_k[l] for l in range(DEPTH)], [cache_mem_v[l] for l in range(DEPTH)],
                          [state_rwkv_shift[i] for i in range(N_EVEN)], [state_rwkv[i] for i in range(N_EVEN)],
                          [state_delta_conv[i] for i in range(N_EVEN)], [state_delta[i] for i in range(N_EVEN)],
                          [state_gla[i] for i in range(N_ODD)], [state_ret[i] for i in range(N_ODD)], W)
    p_shift = jnp.stack(ps[0]).astype(dt)
    p_rwkv = jnp.stack(ps[1]).astype(dt)
    p_conv = jnp.stack(ps[2]).astype(dt)
    p_delta = jnp.stack(ps[3]).astype(dt)
    p_gla = jnp.stack(ps[4]).astype(dt)
    p_ret = jnp.stack(ps[5]).astype(dt)
    p_mem_k = jnp.stack(pk).astype(dt)
    p_mem_v = jnp.stack(pv).astype(dt)
    s_shift = jnp.stack(ss[0]).astype(dt)
    s_rwkv = jnp.stack(ss[1]).astype(dt)
    s_conv = jnp.stack(ss[2]).astype(dt)
    s_delta = jnp.stack(ss[3]).astype(dt)
    s_gla = jnp.stack(ss[4]).astype(dt)
    s_ret = jnp.stack(ss[5]).astype(dt)
    return (y_prompt, y_sample, p_shift, p_rwkv, p_conv, p_delta, p_gla, p_ret, p_mem_k, p_mem_v,
            s_shift, s_rwkv, s_conv, s_delta, s_gla, s_ret)
```

```cpp
#include <hip/hip_runtime.h>
#include <hip/hip_cooperative_groups.h>
#include <cstdio>
#include <cstdint>
namespace cg = cooperative_groups;

#define LAS __attribute__((address_space(3)))
typedef unsigned short bf16_t;
typedef short bf16x8 __attribute__((ext_vector_type(8)));
typedef float f32x4 __attribute__((ext_vector_type(4)));
typedef float f32x2 __attribute__((ext_vector_type(2)));
typedef unsigned u32x4 __attribute__((ext_vector_type(4)));
typedef unsigned u32x2 __attribute__((ext_vector_type(2)));

#define otid() otid_(wv__)
__device__ __forceinline__ int otid_(int wv) { int t = (wv << 6) | (int)__builtin_amdgcn_mbcnt_hi(~0u, __builtin_amdgcn_mbcnt_lo(~0u, 0u)); asm volatile("" : "+v"(t)); return t; }
namespace pg8 {
constexpr int BM = 256, BK = 64, HALF = 128, HTB = HALF * BK * 2, STAGE_BYTES = 8 * HTB, NXCD = 8, WGM = 8;
__host__ __device__ __forceinline__ int lds_byte(int r, int c) { const int st = (r >> 4) * 2 + (c >> 5), rr = r & 15, cc = c & 31, ob = rr * 64 + cc * 2; return st * 1024 + (ob ^ (((ob >> 9) & 1) << 5)); }
__host__ __device__ __forceinline__ void stage_rc(int b, int& R, int& C) { const int st = b / 1024, sb = b % 1024, swz = sb ^ (((sb >> 9) & 1) << 5); R = (st >> 1) * 16 + swz / 64; C = (st & 1) * 32 + (swz % 64) / 2; }
__host__ __device__ __forceinline__ int perm32(int rho) { const int n = rho >> 4, i = rho & 15; return 8 * (i >> 2) + 4 * n + (i & 3); }
struct Unit { int pm, pn; };
struct Gemm { const bf16_t* A; const bf16_t* Bt; int M, N, K; };
struct StaticOrder {
    int nM, nN, nwg, G, c;
    __device__ void init(int M, int N, int G_, int c_) { nM = M / BM; nN = N / BM; nwg = nM * nN; G = G_; c = c_; }
    __device__ bool next(int i, Unit& u) const {
        const long L = (long)i * G + c; if (L >= nwg) return false;
        int wgid = (int)L; { const int q = nwg / NXCD, r = nwg % NXCD, xcd = wgid % NXCD, off = wgid / NXCD; wgid = (xcd < r ? xcd * (q + 1) : r * (q + 1) + (xcd - r) * q) + off; }
        const int nig = WGM * nN, gid = wgid / nig, fm = gid * WGM, gsz = (nM - fm) < WGM ? (nM - fm) : WGM;
        u.pm = fm + ((wgid % nig) % gsz); u.pn = (wgid % nig) / gsz; return true;
    }
};
typedef __bf16 bf16n2 __attribute__((ext_vector_type(2)));
typedef float f32n2 __attribute__((ext_vector_type(2)));
__device__ __forceinline__ unsigned cvt_pk_bf16(float lo, float hi) { const f32n2 v = {lo, hi}; const bf16n2 r = __builtin_convertvector(v, bf16n2); return __builtin_bit_cast(unsigned, r); }

template <class Epi>
__device__ __forceinline__ void gemm_phase(const int wv__, LAS unsigned char* lds, const Gemm g, const StaticOrder& S, const Epi& E) {
    const int tid = otid(), wid = __builtin_amdgcn_readfirstlane(tid >> 6), lane = tid & 63, wr = wid >> 2, wc = wid & 3, fr = lane & 15, fq = lane >> 4;
    const int K = g.K, nt = K / BK;
    unsigned voffA[2], voffB[2];
#pragma unroll
    for (int i = 0; i < 2; ++i) { int R, C; stage_rc(tid * 16 + i * 8192, R, C); const int Rb = Epi::PERM ? ((R & ~31) + perm32(R & 31)) : R;
        voffA[i] = (unsigned)(R * K + C) * 2u; voffB[i] = (unsigned)(Rb * K + C) * 2u; }
    const size_t kstep = (size_t)(BK * 2);
    const size_t hstep = (size_t)HALF * K * 2;
    const size_t tstep = 2 * hstep;
    const unsigned ldsw = (unsigned)wid * 1024u;
    const int aoff = lds_byte(wr * 64 + fr, fq * 8), boff = lds_byte(wc * 32 + fr, fq * 8);
#define PG8_SA(b, h) (((b) * 2 + (h)) * HTB)
#define PG8_SB(b, h) ((4 + (b) * 2 + (h)) * HTB)
#define PG8_STAGE(bufoff, gbase, voff) do { _Pragma("unroll") for (int _i = 0; _i < 2; ++_i) \
        __builtin_amdgcn_global_load_lds((const unsigned*)((const char*)(gbase) + (voff)[_i]), (LAS unsigned*)(lds + (bufoff) + ldsw + _i * 8192), 16, 0, 0); } while (0)
#define PG8_LDA(dst, b, h) do { _Pragma("unroll") for (int m = 0; m < 4; ++m) _Pragma("unroll") for (int k = 0; k < 2; ++k) dst[m][k] = *(const LAS bf16x8*)(lds + PG8_SA(b, h) + aoff + m * 2048 + k * 1024); } while (0)
#define PG8_LDB(dst, b, h) do { _Pragma("unroll") for (int n = 0; n < 2; ++n) _Pragma("unroll") for (int k = 0; k < 2; ++k) dst[n][k] = *(const LAS bf16x8*)(lds + PG8_SB(b, h) + boff + n * 2048 + k * 1024); } while (0)
#define PG8_MMA(ai, bj, At, Bt) do { __builtin_amdgcn_s_setprio(1); _Pragma("unroll") for (int m = 0; m < 4; ++m) _Pragma("unroll") for (int n = 0; n < 2; ++n) _Pragma("unroll") for (int k = 0; k < 2; ++k) \
        acc[ai][bj][m][n] = __builtin_amdgcn_mfma_f32_16x16x32_bf16(Bt[n][k], At[m][k], acc[ai][bj][m][n], 0, 0, 0); __builtin_amdgcn_s_setprio(0); } while (0)
#define PG8_WAIT_V(n) asm volatile("s_waitcnt vmcnt(" #n ")" ::: "memory")
#define PG8_WAIT_L(n) asm volatile("s_waitcnt lgkmcnt(" #n ")" ::: "memory")
#define PG8_BAR __builtin_amdgcn_s_barrier()
#define PG8_SCHED __builtin_amdgcn_sched_barrier(0)
    Unit cur, nxt; int ui = 0;
    if (!S.next(0, cur)) return;
    f32x4 acc[2][2][4][2];
#pragma unroll
    for (int a = 0; a < 2; ++a)
#pragma unroll
        for (int b = 0; b < 2; ++b)
#pragma unroll
            for (int m = 0; m < 4; ++m)
#pragma unroll
                for (int n = 0; n < 2; ++n) acc[a][b][m][n] = (f32x4){0.f, 0.f, 0.f, 0.f};
    bf16x8 At[4][2], B0[2][2], B1[2][2];
    const char* cA = (const char*)g.A + (size_t)cur.pm * tstep; const char* cB = (const char*)g.Bt + (size_t)cur.pn * tstep;
    PG8_STAGE(PG8_SB(0, 0), cB, voffB); PG8_STAGE(PG8_SA(0, 0), cA, voffA); PG8_STAGE(PG8_SB(0, 1), cB + hstep, voffB); PG8_STAGE(PG8_SA(0, 1), cA + hstep, voffA);
    if (wr == 1) PG8_BAR;
    PG8_WAIT_V(4); PG8_BAR;
    PG8_STAGE(PG8_SB(1, 0), cB + kstep, voffB); PG8_STAGE(PG8_SA(1, 0), cA + kstep, voffA); PG8_STAGE(PG8_SB(1, 1), cB + hstep + kstep, voffB);
    PG8_WAIT_V(6); PG8_BAR;
    for (;;) {
        const bool has_next = S.next(ui + 1, nxt);
        const char* nA = has_next ? (const char*)g.A + (size_t)nxt.pm * tstep : cA; const char* nB = has_next ? (const char*)g.Bt + (size_t)nxt.pn * tstep : cB;
#pragma unroll 1
        for (int t = 0; t < nt; t += 2) {
            const bool last = (t == nt - 2);
            const char* a1 = cA + (size_t)(t + 1) * kstep;
            const char* a2 = last ? nA : cA + (size_t)(t + 2) * kstep; const char* b2 = last ? nB : cB + (size_t)(t + 2) * kstep;
            const char* a3 = a2 + kstep; const char* b3 = b2 + kstep;
            PG8_LDB(B0, 0, 0); PG8_SCHED; PG8_LDA(At, 0, 0); PG8_STAGE(PG8_SA(1, 1), a1 + hstep, voffA);
            PG8_WAIT_L(8); PG8_BAR; PG8_WAIT_L(0); PG8_MMA(0, 0, At, B0); PG8_BAR; PG8_SCHED;
            PG8_LDB(B1, 0, 1); PG8_STAGE(PG8_SB(0, 0), b2, voffB);
            PG8_BAR; PG8_WAIT_L(0); PG8_MMA(0, 1, At, B1); PG8_BAR;
            PG8_LDA(At, 0, 1); PG8_STAGE(PG8_SA(0, 0), a2, voffA);
            PG8_BAR; PG8_WAIT_L(0); PG8_MMA(1, 0, At, B0); PG8_BAR; PG8_SCHED;
            PG8_STAGE(PG8_SB(0, 1), b2 + hstep, voffB);
            PG8_WAIT_V(6); PG8_BAR; PG8_MMA(1, 1, At, B1); PG8_BAR;
            PG8_LDB(B0, 1, 0); PG8_SCHED; PG8_LDA(At, 1, 0); PG8_STAGE(PG8_SA(0, 1), a2 + hstep, voffA);
            PG8_WAIT_L(8); PG8_BAR; PG8_WAIT_L(0); PG8_MMA(0, 0, At, B0); PG8_BAR; PG8_SCHED;
            PG8_LDB(B1, 1, 1); PG8_STAGE(PG8_SB(1, 0), b3, voffB);
            PG8_BAR; PG8_WAIT_L(0); PG8_MMA(0, 1, At, B1); PG8_BAR;
            PG8_LDA(At, 1, 1); PG8_STAGE(PG8_SA(1, 0), a3, voffA);
            PG8_BAR; PG8_WAIT_L(0); PG8_MMA(1, 0, At, B0); PG8_BAR; PG8_SCHED;
            PG8_STAGE(PG8_SB(1, 1), b3 + hstep, voffB);
            PG8_WAIT_V(6); PG8_BAR; PG8_MMA(1, 1, At, B1); PG8_BAR;
        }
        E(acc, cur, wr, wc, fr, fq);
        if (!has_next) break;
#pragma unroll
        for (int a = 0; a < 2; ++a)
#pragma unroll
            for (int b = 0; b < 2; ++b)
#pragma unroll
                for (int m = 0; m < 4; ++m)
#pragma unroll
                    for (int n = 0; n < 2; ++n) acc[a][b][m][n] = (f32x4){0.f, 0.f, 0.f, 0.f};
        cur = nxt; cA = nA; cB = nB; ++ui;
    }
    PG8_WAIT_V(0);
    if (wr == 0) PG8_BAR;
    PG8_BAR;
#undef PG8_SA
#undef PG8_SB
#undef PG8_STAGE
#undef PG8_LDA
#undef PG8_LDB
#undef PG8_MMA
#undef PG8_WAIT_V
#undef PG8_WAIT_L
#undef PG8_BAR
#undef PG8_SCHED
}
}
using pg8::cvt_pk_bf16;

constexpr int D = 1024, MP = 65536, MS = 256, MT = MP + MS, FF = 2816;
constexpr int PE = 3840, PO = 3584;
constexpr float EPSF = 1e-6f;
constexpr size_t O_Y = 0;
constexpr size_t O_PSHIFT = (size_t)MT * D;
constexpr size_t O_PRWKV = O_PSHIFT + 8 * 1792;
constexpr size_t O_PCONV = O_PRWKV + 8 * 8 * 64 * 64;
constexpr size_t O_PDELTA = O_PCONV + 8 * 3 * 1536;
constexpr size_t O_PGLA = O_PDELTA + 8 * 4 * 128 * 128;
constexpr size_t O_PRET = O_PGLA + 8 * 4 * 64 * 128;
constexpr size_t O_PMK = O_PRET + 8 * 4 * 128 * 128;
constexpr size_t O_PMV = O_PMK + 2 * 8 * 256 * 1024;
constexpr size_t O_SSHIFT = O_PMV + 2 * 8 * 256 * 1024;
constexpr size_t O_SRWKV = O_SSHIFT + 16 * 1792;
constexpr size_t O_SCONV = O_SRWKV + 16 * 8 * 64 * 64;
constexpr size_t O_SDELTA = O_SCONV + 16 * 3 * 1536;
constexpr size_t O_SGLA = O_SDELTA + 16 * 4 * 128 * 128;
constexpr size_t O_SRET = O_SGLA + 16 * 4 * 64 * 128;
constexpr size_t O_END = O_SRET + 16 * 4 * 128 * 128;
static_assert(O_END == 80631808, "output size");
constexpr size_t al256(size_t x) { return (x + 255) & ~(size_t)255; }
constexpr size_t E_F1U = 0;
constexpr size_t E_F1D = E_F1U + 2ull * 5632 * 1024;
constexpr size_t E_F2U = E_F1D + 2ull * 1024 * 2816;
constexpr size_t E_F2D = E_F2U + 2ull * 5632 * 1024;
constexpr size_t E_EIN = E_F2D + 2ull * 1024 * 2816;
constexpr size_t E_EOUT = E_EIN + 3840ull * 1024;
constexpr size_t E_OIN = E_EOUT + 1024ull * 1024;
constexpr size_t E_OOUT = E_OIN + 3584ull * 1024;
constexpr size_t E_WQ = E_OOUT + 1024ull * 1024;
constexpr size_t E_WO = E_WQ + 2ull * 1024 * 1024;
constexpr size_t E_MKV = E_WO + 2ull * 1024 * 1024;
constexpr size_t E_LR1 = E_MKV + 4096ull * 1024;
constexpr size_t E_LR2 = E_LR1 + 1024ull * 256;
constexpr size_t E_END = E_LR2 + 512ull * 256;
constexpr size_t WS_WT = 0;
constexpr size_t WS_AMEM = al256(WS_WT + E_END * 2);
constexpr size_t WS_SC = al256(WS_AMEM + 2048ull * 1024 * 2);
constexpr size_t WS_BONUS = al256(WS_SC + (size_t)MT * 16 * 4);
constexpr size_t WS_HY = al256(WS_BONUS + (size_t)MT * 8 * 4);
constexpr size_t WS_BIG = al256(WS_HY + (size_t)MT * 1024 * 2);
constexpr size_t WS_LREA = al256(WS_BIG + (size_t)MT * 3840 * 2);
constexpr size_t WS_VBWK = al256(WS_LREA + (size_t)MT * 1024 * 2);
constexpr size_t WS_AP = al256(WS_VBWK + 4160ull * 64 * 256 * 2);
constexpr size_t WS_END = al256(WS_AP + (size_t)MT * 256 * 2);
constexpr size_t WS_KB = WS_BIG + (size_t)MT * 1024 * 2;
constexpr size_t WS_VTB = WS_KB + 96ull * 256 * 256 * 2;
static_assert(WS_END <= (1ull << 30), "workspace budget");
constexpr int LDS_BYTES = 155648;

struct Args { const float* in[49]; float* out; unsigned char* ws; int ph_lo, ph_hi; };
#define KAS __attribute__((address_space(4)))
__device__ __forceinline__ const float* inptr(int k) { const KAS char* kp = (const KAS char*)__builtin_amdgcn_kernarg_segment_ptr(); return *(const float* const volatile KAS*)(kp + 8 * k); }
__device__ __forceinline__ float* outptr() { const KAS char* kp = (const KAS char*)__builtin_amdgcn_kernarg_segment_ptr(); return *(float* const volatile KAS*)(kp + 8 * 49); }
__device__ __forceinline__ unsigned char* wsptr() { const KAS char* kp = (const KAS char*)__builtin_amdgcn_kernarg_segment_ptr(); return *(unsigned char* const volatile KAS*)(kp + 8 * 50); }

__device__ __forceinline__ float bf2f(bf16_t b) { return __uint_as_float((unsigned)b << 16); }
__device__ __forceinline__ bf16_t f2bf(float f) { return (bf16_t)(cvt_pk_bf16(f, 0.f) & 0xffffu); }
__device__ __forceinline__ float bflo(unsigned w) { return __uint_as_float(w << 16); }
__device__ __forceinline__ float bfhi(unsigned w) { return __uint_as_float(w & 0xffff0000u); }
__device__ __forceinline__ void unpack8(const u32x4 w, float (&f)[8]) { f[0] = bflo(w.x); f[1] = bfhi(w.x); f[2] = bflo(w.y); f[3] = bfhi(w.y); f[4] = bflo(w.z); f[5] = bfhi(w.z); f[6] = bflo(w.w); f[7] = bfhi(w.w); }
__device__ __forceinline__ u32x4 pack8(const float (&f)[8]) { u32x4 w; w.x = cvt_pk_bf16(f[0], f[1]); w.y = cvt_pk_bf16(f[2], f[3]); w.z = cvt_pk_bf16(f[4], f[5]); w.w = cvt_pk_bf16(f[6], f[7]); return w; }
template <int CTRL> __device__ __forceinline__ float dpp_mov(float v) { return __builtin_bit_cast(float, __builtin_amdgcn_update_dpp(0, __builtin_bit_cast(int, v), CTRL, 0xf, 0xf, true)); }
__device__ __forceinline__ float rowsum8(float v) { v += dpp_mov<0xB1>(v); v += dpp_mov<0x4E>(v); v += dpp_mov<0x141>(v); return v; }
__device__ __forceinline__ float rowsum16(float v) { v = rowsum8(v); v += dpp_mov<0x140>(v); return v; }
__device__ __forceinline__ float rowmax16(float v) { v = fmaxf(v, dpp_mov<0xB1>(v)); v = fmaxf(v, dpp_mov<0x4E>(v)); v = fmaxf(v, dpp_mov<0x141>(v)); v = fmaxf(v, dpp_mov<0x140>(v)); return v; }
__device__ __forceinline__ float wave_sum(float v) { v = rowsum16(v); v += __shfl_xor(v, 16); v += __shfl_xor(v, 32); return v; }
__device__ __forceinline__ float sigmoidf_(float x) { return __builtin_amdgcn_rcpf(1.f + __expf(-x)); }
__device__ __forceinline__ float siluf_(float x) { return x * sigmoidf_(x); }
__device__ __forceinline__ float tanhf_(float x) { return 1.f - 2.f * __builtin_amdgcn_rcpf(1.f + __expf(2.f * x)); }
__device__ __forceinline__ float softplusf_(float x) { return fmaxf(x, 0.f) + log1pf(__expf(-fabsf(x))); }
__device__ __forceinline__ void row_info(int row, int& s, int& t) { if (row < MP) { s = row >> 13; t = row & 8191; } else { const int r = row - MP; s = 8 + (r >> 4); t = r & 15; } }
__device__ __forceinline__ int seq_row0(int s) { return s < 8 ? s * 8192 : MP + (s - 8) * 16; }
__device__ __forceinline__ int seq_T(int s) { return s < 8 ? 8192 : 16; }
#define LDS_WAIT() asm volatile("s_waitcnt lgkmcnt(0)" ::: "memory")

__device__ __forceinline__ f32x4 mma_tile(const LAS bf16_t* A, int lda, const LAS bf16_t* B, int ldb, int K, f32x4 acc, int lane) {
    const LAS bf16_t* a = A + (lane & 15) * lda + (lane >> 4) * 8;
    const LAS bf16_t* b = B + (lane & 15) * ldb + (lane >> 4) * 8;
    for (int k = 0; k < K; k += 32) {
        const bf16x8 av = *(const LAS bf16x8*)(a + k), bv = *(const LAS bf16x8*)(b + k);
        acc = __builtin_amdgcn_mfma_f32_16x16x32_bf16(av, bv, acc, 0, 0, 0);
    }
    return acc;
}

struct EpiResid {
    static constexpr bool PERM = false;
    float* X; float scale;
    __device__ __forceinline__ void operator()(const f32x4 (&acc)[2][2][4][2], const pg8::Unit& u, int wr, int wc, int fr, int fq) const {
        const int row0 = u.pm * 256 + wr * 64 + fr, col0 = u.pn * 256 + wc * 32 + 4 * fq;
#pragma unroll
        for (int ai = 0; ai < 2; ++ai)
#pragma unroll
            for (int m = 0; m < 4; ++m) { float* rowp = X + (size_t)(row0 + ai * 128 + m * 16) * D + col0;
#pragma unroll
                for (int bj = 0; bj < 2; ++bj)
#pragma unroll
                    for (int n = 0; n < 2; ++n) { f32x4* p = (f32x4*)(rowp + bj * 128 + n * 16); *p = *p + acc[ai][bj][m][n] * scale; } }
    }
};
struct EpiSwiglu {
    static constexpr bool PERM = true;
    bf16_t* O;
    __device__ __forceinline__ void operator()(const f32x4 (&acc)[2][2][4][2], const pg8::Unit& u, int wr, int wc, int fr, int fq) const {
        const int row0 = u.pm * 256 + wr * 64 + fr, col0 = u.pn * 128 + wc * 32 + 8 * fq;
#pragma unroll
        for (int ai = 0; ai < 2; ++ai)
#pragma unroll
            for (int m = 0; m < 4; ++m) {
                float v[8];
#pragma unroll
                for (int n = 0; n < 2; ++n)
#pragma unroll
                    for (int j = 0; j < 4; ++j) v[4 * n + j] = siluf_(acc[ai][0][m][n][j]) * acc[ai][1][m][n][j];
                *(u32x4*)(O + (size_t)(row0 + ai * 128 + m * 16) * FF + col0) = pack8(v);
            }
    }
};
struct EpiBf16 {
    static constexpr bool PERM = true;
    bf16_t* O; int ldc;
    __device__ __forceinline__ void operator()(const f32x4 (&acc)[2][2][4][2], const pg8::Unit& u, int wr, int wc, int fr, int fq) const {
        const int row0 = u.pm * 256 + wr * 64 + fr, col0 = u.pn * 256 + wc * 32 + 8 * fq;
#pragma unroll
        for (int ai = 0; ai < 2; ++ai)
#pragma unroll
            for (int m = 0; m < 4; ++m) { bf16_t* rowp = O + (size_t)(row0 + ai * 128 + m * 16) * ldc + col0;
#pragma unroll
                for (int bj = 0; bj < 2; ++bj) { const f32x4 v0 = acc[ai][bj][m][0], v1 = acc[ai][bj][m][1];
                    u32x4 w; w.x = cvt_pk_bf16(v0[0], v0[1]); w.y = cvt_pk_bf16(v0[2], v0[3]); w.z = cvt_pk_bf16(v1[0], v1[1]); w.w = cvt_pk_bf16(v1[2], v1[3]);
                    *(u32x4*)(rowp + bj * 128) = w; } }
    }
};
struct EpiLR1 {
    static constexpr bool PERM = true;
    bf16_t* O; const float* w0; const float* a0;
    __device__ __forceinline__ void operator()(const f32x4 (&acc)[2][2][4][2], const pg8::Unit& u, int wr, int wc, int fr, int fq) const {
        const int row0 = u.pm * 256 + wr * 64 + fr, col0 = u.pn * 256 + wc * 32 + 8 * fq;
        const float* bias = (u.pn < 2) ? (w0 + col0) : (a0 + col0 - 512); const float sc = (u.pn < 2) ? -0.60653066f : 1.f;
#pragma unroll
        for (int bj = 0; bj < 2; ++bj) {
            const f32x4 b0 = *(const f32x4*)(bias + bj * 128), b1 = *(const f32x4*)(bias + bj * 128 + 4);
#pragma unroll
            for (int ai = 0; ai < 2; ++ai)
#pragma unroll
                for (int m = 0; m < 4; ++m) {
                    float v[8];
#pragma unroll
                    for (int j = 0; j < 4; ++j) { v[j] = sc * sigmoidf_(acc[ai][bj][m][0][j] + b0[j]); v[4 + j] = sc * sigmoidf_(acc[ai][bj][m][1][j] + b1[j]); }
                    *(u32x4*)(O + (size_t)(row0 + ai * 128 + m * 16) * 1024 + col0 + bj * 128) = pack8(v);
                }
        }
    }
};
struct EpiMemKV {
    static constexpr bool PERM = false;
    float* PK;
    __device__ __forceinline__ void operator()(const f32x4 (&acc)[2][2][4][2], const pg8::Unit& u, int wr, int wc, int fr, int fq) const {
        const int t = u.pn >> 2; float* base = PK + (size_t)(t & 1) * (O_PMV - O_PMK) + (size_t)(t >> 1) * (8 * 256 * 1024);
        const int row0 = u.pm * 256 + wr * 64 + fr, col0 = (u.pn & 3) * 256 + wc * 32 + 4 * fq;
#pragma unroll
        for (int ai = 0; ai < 2; ++ai)
#pragma unroll
            for (int m = 0; m < 4; ++m) { float* rowp = base + (size_t)(row0 + ai * 128 + m * 16) * 1024 + col0;
#pragma unroll
                for (int bj = 0; bj < 2; ++bj)
#pragma unroll
                    for (int n = 0; n < 2; ++n) *(f32x4*)(rowp + bj * 128 + n * 16) = acc[ai][bj][m][n]; }
    }
};
template <class Epi> __device__ __forceinline__ void run_gemm(const int wv__, LAS unsigned char* lds, const bf16_t* A, const bf16_t* Bt, int M, int N, int K, const Epi& E) {
    pg8::Gemm g{A, Bt, M, N, K}; pg8::StaticOrder S; S.init(M, N, (int)gridDim.x, (int)blockIdx.x);
    pg8::gemm_phase<Epi>(wv__, lds, g, S, E);
}

__device__ __forceinline__ void cvt_item(const float* W, int ld, int c0, int k0, bf16_t* dst, int K, const float* ks, LAS float* scr, int lane) {
#pragma unroll 8
    for (int i = 0; i < 32; ++i) { const int kk = 2 * i + (lane >> 5); float v = W[(size_t)(k0 + kk) * ld + c0 + (lane & 31)]; if (ks) v *= ks[k0 + kk]; scr[kk * 33 + (lane & 31)] = v; }
    LDS_WAIT();
    const int c = lane & 7;
#pragma unroll
    for (int j = 0; j < 4; ++j) { const int n = (lane >> 3) + 8 * j; const LAS float* s = scr + (8 * c) * 33 + n;
        u32x4 o; o.x = cvt_pk_bf16(s[0 * 33], s[1 * 33]); o.y = cvt_pk_bf16(s[2 * 33], s[3 * 33]); o.z = cvt_pk_bf16(s[4 * 33], s[5 * 33]); o.w = cvt_pk_bf16(s[6 * 33], s[7 * 33]);
        *(u32x4*)(dst + (size_t)n * K + k0 + 8 * c) = o; }
    LDS_WAIT();
}
__device__ __forceinline__ void cvt_seg(const float* W, int ld, int c0, int nc, int K, bf16_t* dst, const float* ks, LAS float* scr, int lane, int gw, int NGW, int& cum) {
    const int nb = nc / 32, n = (K / 64) * nb;
    int it = (gw - (cum % NGW) + NGW) % NGW;
    for (; it < n; it += NGW) { const int kb = it / nb, b = it % nb; cvt_item(W, ld, c0 + 32 * b, 64 * kb, dst + (size_t)(32 * b) * K, K, ks, scr, lane); }
    cum += n;
}
__device__ __forceinline__ void cvt_ffn_up(const float* wg, const float* wu, bf16_t* dst, LAS float* scr, int lane, int gw, int NGW, int& cum) {
    const int n = 2 * 88 * 16;
    int it = (gw - (cum % NGW) + NGW) % NGW;
    for (; it < n; it += NGW) { const int kb = it / 176, r = it % 176, gu = r / 88, cb = r % 88;
        cvt_item(gu ? wu : wg, FF, 32 * cb, 64 * kb, dst + (size_t)((cb >> 2) * 256 + gu * 128 + (cb & 3) * 32) * D, D, nullptr, scr, lane); }
    cum += n;
}

template <bool FROM_INPUT, int NCOL>
__device__ __forceinline__ void norm_phase(const int wv__, const float* xp, const float* xs, float* X, bf16_t* H, const float* w, const float* Wsm, int ldw, int c0w, float* SC, LAS unsigned char* lds) {
    const int tid = otid(), lane = tid & 63, wave = tid >> 6;
    const int gw = blockIdx.x * 8 + wave, NGW = gridDim.x * 8;
    LAS float* lw = (LAS float*)lds;
    if (NCOL > 0) {
        for (int idx = tid; idx < 1024 * NCOL; idx += 512) { const int k = idx / NCOL, c = idx % NCOL; const int ln = (k >> 2) & 63, j = k >> 8, i = k & 3;
            lw[((((j * 4 + i) * (NCOL / 4) + (c >> 2)) * 64 + ln) << 2) + (c & 3)] = Wsm[(size_t)k * ldw + c0w + c]; }
        __syncthreads();
    }
    f32x4 wv[4];
#pragma unroll
    for (int j = 0; j < 4; ++j) wv[j] = *(const f32x4*)(w + (lane + 64 * j) * 4);
    for (int row = gw; row < MT; row += NGW) {
        const float* src = FROM_INPUT ? (row < MP ? xp + (size_t)row * D : xs + (size_t)(row - MP) * D) : X + (size_t)row * D;
        f32x4 v[4]; float ss = 0.f;
#pragma unroll
        for (int j = 0; j < 4; ++j) { v[j] = *(const f32x4*)(src + (lane + 64 * j) * 4); ss += (v[j][0] * v[j][0] + v[j][1] * v[j][1]) + (v[j][2] * v[j][2] + v[j][3] * v[j][3]); }
        const float rstd = rsqrtf(wave_sum(ss) * (1.f / D) + EPSF);
#pragma unroll
        for (int j = 0; j < 4; ++j) {
            if (FROM_INPUT) *(f32x4*)(X + (size_t)row * D + (lane + 64 * j) * 4) = v[j];
            v[j] = v[j] * rstd * wv[j];
            u32x2 o; o.x = cvt_pk_bf16(v[j][0], v[j][1]); o.y = cvt_pk_bf16(v[j][2], v[j][3]);
            *(u32x2*)(H + (size_t)row * D + (lane + 64 * j) * 4) = o;
        }
        if (NCOL > 0) {
            float part[NCOL > 0 ? NCOL : 1];
#pragma unroll
            for (int c = 0; c < NCOL; ++c) part[c] = 0.f;
#pragma unroll
            for (int j = 0; j < 4; ++j)
#pragma unroll
                for (int i = 0; i < 4; ++i)
#pragma unroll
                    for (int cq = 0; cq < NCOL / 4; ++cq) { const f32x4 ww = *(const LAS f32x4*)(lw + ((((j * 4 + i) * (NCOL / 4) + cq) * 64 + lane) << 2));
#pragma unroll
                        for (int e = 0; e < 4; ++e) part[cq * 4 + e] += v[j][i] * ww[e]; if (cq == NCOL / 4 - 1) asm volatile("" ::: "memory"); }
            float mine = 0.f;
#pragma unroll
            for (int c = 0; c < NCOL; ++c) { const float s = wave_sum(part[c]); if (lane == c) mine = s; }
            if (lane < NCOL) SC[(size_t)row * 16 + lane] = mine;
        }
    }
}

__device__ __forceinline__ void rwkv_prep_phase(const int wv__, const bf16_t* P, bf16_t* AP) {
    const float* mu = inptr(18); const float* sh0 = inptr(3); float* outp = outptr();
    const int gt = blockIdx.x * 512 + otid(), NT = gridDim.x * 512;
    for (int it = gt; it < MT * 32; it += NT) {
        const int row = it >> 5, c8 = (it & 31) * 8; int s, t; row_info(row, s, t);
        float cur[8], prv[8], o[8];
        unpack8(*(const u32x4*)(P + (size_t)row * PE + 1536 + c8), cur);
        if (t > 0) unpack8(*(const u32x4*)(P + (size_t)(row - 1) * PE + 1536 + c8), prv);
        else {
#pragma unroll
            for (int i = 0; i < 8; ++i) prv[i] = (s >= 8) ? sh0[(size_t)(s - 8) * 1792 + 1536 + c8 + i] : 0.f; }
#pragma unroll
        for (int i = 0; i < 8; ++i) { const float x = cur[i] + (prv[i] - cur[i]) * mu[1536 + c8 + i]; o[i] = (c8 < 64) ? tanhf_(x) : ((c8 < 128) ? x : sigmoidf_(x)); }
        *(u32x4*)(AP + (size_t)row * 256 + c8) = pack8(o);
    }
    for (int it = gt; it < 24 * (1792 + 3 * 1536); it += NT) {
        const int s = it / 6400, r = it % 6400; const int T = seq_T(s), r0 = seq_row0(s);
        if (r < 1792) { const float v = bf2f(P[(size_t)(r0 + T - 1) * PE + r]); outp[(s < 8 ? O_PSHIFT + (size_t)s * 1792 : O_SSHIFT + (size_t)(s - 8) * 1792) + r] = v; }
        else { const int q = r - 1792, j = q / 1536, c = q % 1536; const float v = bf2f(P[(size_t)(r0 + T - 3 + j) * PE + 1792 + c]);
            outp[(s < 8 ? O_PCONV + (size_t)s * 4608 : O_SCONV + (size_t)(s - 8) * 4608) + q] = v; }
    }
}

__device__ __forceinline__ void rwkv_scan_phase(const int wv__, const bf16_t* P, const bf16_t* LREA, bf16_t* YC, float* BONUS, LAS unsigned char* lds) {
    const int tid = otid();
    LAS float* L = (LAS float*)lds;
    constexpr int BUFW = 10752;
    LAS float* YB = L + 2 * BUFW;
    const float* mu = inptr(18); const float* kkw = inptr(24); const float* kaw = inptr(25); const float* rkw = inptr(26);
    for (int item = blockIdx.x; item < 768; item += gridDim.x) {
        int s, h, q; if (item < 256) { const int bh = item >> 2; q = item & 3; s = bh >> 3; h = bh & 7; } else { const int i2 = item - 256, bh = i2 >> 2; q = i2 & 3; s = 8 + (bh >> 3); h = bh & 7; }
        const int T = seq_T(s), r0 = seq_row0(s), nch = (T + 31) >> 5;
        const bool comp = tid < 256;
        const int rl = (tid >> 4) & 15, li = tid & 15;
        const int pj = tid & 63, pw = (tid >> 6) & 3;
        f32x4 S = (f32x4){0.f, 0.f, 0.f, 0.f};
        float* stout = outptr() + (s < 8 ? O_PRWKV + ((size_t)(s * 8 + h) * 64 + 16 * q + rl) * 64 : O_SRWKV + ((size_t)((s - 8) * 8 + h) * 64 + 16 * q + rl) * 64) + 4 * li;
        if (comp && s >= 8) S = *(const f32x4*)(inptr(4) + ((size_t)((s - 8) * 8 + h) * 64 + 16 * q + rl) * 64 + 4 * li);
        float mur = 0.f, muk = 0.f, muv = 0.f, ckk = 0.f, cka = 0.f, crk = 0.f, sr = 0.f, sk = 0.f, sv = 0.f;
        if (!comp) { mur = mu[h * 64 + pj]; muk = mu[512 + h * 64 + pj]; muv = mu[1024 + h * 64 + pj]; ckk = kkw[h * 64 + pj]; cka = kaw[h * 64 + pj]; crk = rkw[h * 64 + pj];
            if (s >= 8) { const float* sh = inptr(3) + (size_t)(s - 8) * 1792; sr = sh[h * 64 + pj]; sk = sh[512 + h * 64 + pj]; sv = sh[1024 + h * 64 + pj]; } }
        for (int c = -1; c < nch; ++c) {
            if (!comp) {
                const int cn = c + 1;
                if (cn < nch) {
                    LAS float* B = L + (cn & 1) * BUFW;
                    const int tb = cn * 32 + pw * 8;
                    float rc[8], kc[8], vc[8], ee[8], aa[8], rp, kp, vp;
                    const bf16_t* pr = P + (size_t)(r0 + tb) * PE + h * 64 + pj;
                    const bf16_t* lr = LREA + (size_t)(r0 + tb) * 1024 + h * 64 + pj;
#pragma unroll
                    for (int i = 0; i < 8; ++i) { const bool ok = (tb + i) < T; const size_t o = (size_t)i * PE;
                        rc[i] = ok ? bf2f(pr[o]) : 0.f; kc[i] = ok ? bf2f(pr[o + 512]) : 0.f; vc[i] = ok ? bf2f(pr[o + 1024]) : 0.f;
                        ee[i] = ok ? bf2f(lr[(size_t)i * 1024]) : 0.f; aa[i] = ok ? bf2f(lr[(size_t)i * 1024 + 512]) : 0.f; }
                    if (tb > 0) { rp = bf2f(pr[-(ptrdiff_t)PE]); kp = bf2f(pr[-(ptrdiff_t)PE + 512]); vp = bf2f(pr[-(ptrdiff_t)PE + 1024]); } else { rp = sr; kp = sk; vp = sv; }
#pragma unroll
                    for (int i = 0; i < 8; ++i) {
                        const int tk = pw * 8 + i;
                        const float xr = rc[i] + (rp - rc[i]) * mur, xk = kc[i] + (kp - kc[i]) * muk, xv = vc[i] + (vp - vc[i]) * muv;
                        rp = rc[i]; kp = kc[i]; vp = vc[i];
                        const float kkv = xk * ckk; const float n2 = wave_sum(kkv * kkv); const float kk = kkv * rsqrtf(n2 + EPSF);
                        const float kpr = xk * (1.f + (aa[i] - 1.f) * cka);
                        const float bon = wave_sum(xr * kpr * crk);
                        B[tk * 64 + pj] = __expf(ee[i]); B[2048 + tk * 64 + pj] = kpr; B[4096 + tk * 64 + pj] = -kk; B[6144 + tk * 64 + pj] = kk * aa[i]; B[8192 + tk * 64 + pj] = xr;
                        if ((pj >> 4) == q) B[10240 + tk * 16 + (pj & 15)] = xv;
                        if (q == 0 && pj == 0 && (tb + i) < T) BONUS[(size_t)(r0 + tb + i) * 8 + h] = bon;
                    }
                }
            } else if (c >= 0) {
                const LAS float* B = L + (c & 1) * BUFW; LAS float* yb = YB + (c & 1) * 512;
                const int nv = min(32, T - c * 32);
                for (int tt = 0; tt < nv; ++tt) {
                    const f32x4 w = *(const LAS f32x4*)(B + tt * 64 + li * 4), kp = *(const LAS f32x4*)(B + 2048 + tt * 64 + li * 4), na = *(const LAS f32x4*)(B + 4096 + tt * 64 + li * 4),
                                bb = *(const LAS f32x4*)(B + 6144 + tt * 64 + li * 4), rr = *(const LAS f32x4*)(B + 8192 + tt * 64 + li * 4);
                    const float vv = B[10240 + tt * 16 + rl];
                    float sa = (S[0] * na[0] + S[1] * na[1]) + (S[2] * na[2] + S[3] * na[3]);
                    const f32x4 tS = S * w + vv * kp;
                    sa = rowsum16(sa);
                    S = tS + sa * bb;
                    float y = (S[0] * rr[0] + S[1] * rr[1]) + (S[2] * rr[2] + S[3] * rr[3]);
                    y = rowsum16(y);
                    if (li == 0) yb[tt * 16 + rl] = y;
                }
            }
            __syncthreads();
            if (comp && c >= 0) {
                const LAS float* yb = YB + (c & 1) * 512; const int tt = tid >> 3, pr2 = tid & 7; const int t = c * 32 + tt;
                if (t < T) *(unsigned*)(YC + (size_t)(r0 + t) * 1024 + h * 64 + 16 * q + 2 * pr2) = cvt_pk_bf16(yb[tt * 16 + 2 * pr2], yb[tt * 16 + 2 * pr2 + 1]);
            }
        }
        if (comp) *(f32x4*)stout = S;
        __syncthreads();
    }
}

__device__ __forceinline__ void rwkv_post_phase(const int wv__, const bf16_t* P, const bf16_t* GATE, const float* BONUS, bf16_t* YC) {
    const int lane = otid() & 63, wave = otid() >> 6, gw = blockIdx.x * 8 + wave, NGW = gridDim.x * 8;
    const float* mu = inptr(18); const float* lnw = inptr(27); const float* lnb = inptr(28); const float* sh0 = inptr(3);
    for (int row = gw; row < MT; row += NGW) {
        int s, t; row_info(row, s, t);
#pragma unroll 2
        for (int h = 0; h < 8; ++h) {
            const int c = h * 64 + lane;
            const float y = bf2f(YC[(size_t)row * 1024 + c]);
            const float mean = wave_sum(y) * (1.f / 64.f); const float d = y - mean; const float var = wave_sum(d * d) * (1.f / 64.f);
            const float yn = d * rsqrtf(var + 64e-5f) * lnw[c] + lnb[c];
            const float vc = bf2f(P[(size_t)row * PE + 1024 + c]);
            const float vp = (t > 0) ? bf2f(P[(size_t)(row - 1) * PE + 1024 + c]) : ((s >= 8) ? sh0[(size_t)(s - 8) * 1792 + 1024 + c] : 0.f);
            const float xv = vc + (vp - vc) * mu[1024 + c];
            const float o = (yn + BONUS[(size_t)row * 8 + h] * xv) * bf2f(GATE[(size_t)row * 512 + c]);
            YC[(size_t)row * 1024 + c] = f2bf(o);
        }
    }
}

__device__ __forceinline__ void delta_conv8(const float* cw, const float* cv0, const bf16_t* P, int s, int r0, int T, int t, int h, int part, int cg, float (&y)[8]) {
    const int ch = part * 512 + h * 128 + cg * 8;
    float acc[8];
#pragma unroll
    for (int i = 0; i < 8; ++i) acc[i] = 0.f;
    const bool ok = t < T;
#pragma unroll
    for (int j = 0; j < 4; ++j) {
        const int tt = t - 3 + j; float x[8];
        if (ok && tt >= 0) unpack8(*(const u32x4*)(P + (size_t)(r0 + tt) * PE + 1792 + ch), x);
        else if (ok && s >= 8) {
#pragma unroll
            for (int i = 0; i < 8; ++i) x[i] = cv0[((size_t)(s - 8) * 3 + (tt + 3)) * 1536 + ch + i]; }
        else {
#pragma unroll
            for (int i = 0; i < 8; ++i) x[i] = 0.f; }
        const f32x4 w0 = *(const f32x4*)(cw + j * 1536 + ch), w1 = *(const f32x4*)(cw + j * 1536 + ch + 4);
#pragma unroll
        for (int i = 0; i < 4; ++i) { acc[i] += x[i] * w0[i]; acc[4 + i] += x[4 + i] * w1[i]; }
    }
    float ss = 0.f;
#pragma unroll
    for (int i = 0; i < 8; ++i) { y[i] = ok ? siluf_(acc[i]) : 0.f; ss += y[i] * y[i]; }
    if (part < 2) { ss = rowsum16(ss); const float sc = rsqrtf(ss + EPSF) * (part == 0 ? 0.08838834764831845f : 1.f);
#pragma unroll
        for (int i = 0; i < 8; ++i) y[i] *= sc; }
}
__device__ __forceinline__ void delta_gates(const int wv__, float nA, float dtb, const float* SC, int r0, int T, int t0, int h, LAS float* GS) {
    const int lane = otid();
    const int t = t0 + lane; float g = 0.f, be = 0.f;
    if (t < T) { const float* sc = SC + (size_t)(r0 + t) * 16; g = nA * softplusf_(sc[h] + dtb); be = sigmoidf_(sc[4 + h]); }
#pragma unroll
    for (int d = 1; d < 64; d <<= 1) { const float o = __shfl_up(g, d); if (lane >= d) g += o; }
    GS[lane] = g; GS[64 + lane] = __expf(g); GS[128 + lane] = be;
}
__device__ __forceinline__ void delta_prep_phase(const int wv__, const bf16_t* P, const float* SC, bf16_t* VBWK, LAS unsigned char* lds) {
    const int tid = otid(), lane = tid & 63, wave = tid >> 6;
    LAS bf16_t* Ks = (LAS bf16_t*)lds;
    LAS bf16_t* Vs = Ks + 64 * 136;
    LAS float* Mm = (LAS float*)(lds + 2 * 64 * 136 * 2);
    LAS float* GS = Mm + 64 * 68;
    LAS float* SOL = GS + 192;
    const float* cw = inptr(29); const float* cv0 = inptr(5); const float* Alog = inptr(30); const float* dtbp = inptr(31);
    for (int task = blockIdx.x; task < 4160; task += gridDim.x) {
        int s, h, t0; if (task < 4096) { s = task >> 9; h = (task >> 7) & 3; t0 = (task & 127) * 64; } else { const int q = task - 4096; s = 8 + (q >> 2); h = q & 3; t0 = 0; }
        const int T = seq_T(s), r0 = seq_row0(s); const float nA = -__expf(Alog[h]), dtb = dtbp[h];
        if (tid < 64) delta_gates(wv__, nA, dtb, SC, r0, T, t0, h, GS);
#pragma unroll
        for (int it = 0; it < 2; ++it) { const int item = tid + 512 * it, tk = item >> 4, cg = item & 15; float y[8];
            delta_conv8(cw, cv0, P, s, r0, T, t0 + tk, h, 1, cg, y); *(LAS u32x4*)(Ks + tk * 136 + cg * 8) = pack8(y);
            delta_conv8(cw, cv0, P, s, r0, T, t0 + tk, h, 2, cg, y); *(LAS u32x4*)(Vs + tk * 136 + cg * 8) = pack8(y); }
        __syncthreads();
#pragma unroll
        for (int i = 0; i < 2; ++i) { const int tile = wave + 8 * i, mi = tile >> 2, ni = tile & 3;
            f32x4 acc = mma_tile(Ks + mi * 16 * 136, 136, Ks + ni * 16 * 136, 136, 128, (f32x4){0.f, 0.f, 0.f, 0.f}, lane);
            const int m = ni * 16 + (lane & 15);
#pragma unroll
            for (int j = 0; j < 4; ++j) { const int l = mi * 16 + (lane >> 4) * 4 + j; Mm[l * 68 + m] = (l > m) ? GS[128 + l] * acc[j] * __expf(GS[l] - GS[m]) : 0.f; } }
        __syncthreads();
        if (tid < 256) {
            const int c = tid;
            for (int l = 0; l < 64; ++l) {
                float r = (c < 128) ? GS[128 + l] * bf2f(Vs[l * 136 + c]) : GS[128 + l] * GS[64 + l] * bf2f(Ks[l * 136 + (c - 128)]);
                const LAS float* Mr = Mm + l * 68;
                int m = 0;
                for (; m + 4 <= l; m += 4) { const f32x4 mv = *(const LAS f32x4*)(Mr + m);
                    r -= (mv[0] * SOL[m * 256 + c] + mv[1] * SOL[(m + 1) * 256 + c]) + (mv[2] * SOL[(m + 2) * 256 + c] + mv[3] * SOL[(m + 3) * 256 + c]); }
                for (; m < l; ++m) r -= Mr[m] * SOL[m * 256 + c];
                SOL[l * 256 + c] = r;
            }
            bf16_t* o = VBWK + (size_t)task * (64 * 256) + c;
            for (int l = 0; l < 64; ++l) o[l * 256] = f2bf(SOL[l * 256 + c]);
        }
        __syncthreads();
    }
}
__device__ __forceinline__ void delta_scan_phase(const int wv__, const bf16_t* P, const float* SC, const bf16_t* VBWK, bf16_t* YC, LAS unsigned char* lds) {
    const int tid = otid(), lane = tid & 63, wave = tid >> 6;
    LAS bf16_t* ST = (LAS bf16_t*)lds;
    LAS bf16_t* Qs = ST + 128 * 136;
    LAS bf16_t* Ks = Qs + 64 * 136;
    LAS bf16_t* Wk = Ks + 64 * 136;
    LAS bf16_t* Vb = Wk + 64 * 136;
    LAS bf16_t* KdT = Vb + 64 * 136;
    LAS bf16_t* UT = KdT + 128 * 72;
    LAS bf16_t* QKm = UT + 128 * 72;
    LAS float* GS = (LAS float*)(QKm + 64 * 72);
    LAS float* Ob = (LAS float*)Wk;
    const int r16 = lane & 15, q4 = (lane >> 4) * 4;
    const float* cw = inptr(29); const float* cv0 = inptr(5); const float* Alog = inptr(30); const float* dtbp = inptr(31); const float* dnw = inptr(32); const float* dst0 = inptr(6); float* outp = outptr();
    for (int task = blockIdx.x; task < 96; task += gridDim.x) {
        const int s = task < 32 ? (task >> 2) : 8 + ((task - 32) >> 2), h = task & 3;
        const int T = seq_T(s), r0 = seq_row0(s), nch = (T + 63) >> 6; const float nA = -__expf(Alog[h]), dtb = dtbp[h];
        f32x4 accS[8];
        const float* st0 = dst0 + (size_t)((s - 8) * 4 + h) * 128 * 128;
#pragma unroll
        for (int i = 0; i < 8; ++i) {
            accS[i] = (s >= 8) ? *(const f32x4*)(st0 + (size_t)(wave * 16 + r16) * 128 + i * 16 + q4) : (f32x4){0.f, 0.f, 0.f, 0.f};
#pragma unroll
            for (int j = 0; j < 4; ++j) ST[(i * 16 + q4 + j) * 136 + wave * 16 + r16] = f2bf(accS[i][j]);
        }
        for (int c = 0; c < nch; ++c) {
            const int t0 = c * 64; const int vtask = s < 8 ? (s * 4 + h) * 128 + c : 4096 + (s - 8) * 4 + h;
            if (tid < 64) delta_gates(wv__, nA, dtb, SC, r0, T, t0, h, GS);
            { const bf16_t* src = VBWK + (size_t)vtask * (64 * 256);
#pragma unroll
              for (int it = 0; it < 4; ++it) { const int idx = tid + 512 * it, l = idx >> 5, ch = idx & 31; const u32x4 v = *(const u32x4*)(src + l * 256 + ch * 8);
                  if (ch < 16) *(LAS u32x4*)(Vb + l * 136 + ch * 8) = v; else *(LAS u32x4*)(Wk + l * 136 + (ch - 16) * 8) = v; } }
            __syncthreads();
            const float Glast = GS[63];
#pragma unroll
            for (int it = 0; it < 2; ++it) { const int item = tid + 512 * it, tk = item >> 4, cg = item & 15; float y[8];
                delta_conv8(cw, cv0, P, s, r0, T, t0 + tk, h, 0, cg, y); *(LAS u32x4*)(Qs + tk * 136 + cg * 8) = pack8(y);
                delta_conv8(cw, cv0, P, s, r0, T, t0 + tk, h, 1, cg, y); *(LAS u32x4*)(Ks + tk * 136 + cg * 8) = pack8(y);
                const float kd = __expf(Glast - GS[tk]);
#pragma unroll
                for (int i = 0; i < 8; ++i) KdT[(cg * 8 + i) * 72 + tk] = f2bf(y[i] * kd); }
            __syncthreads();
            f32x4 accO[4];
#pragma unroll
            for (int i = 0; i < 4; ++i) {
                const f32x4 ws = mma_tile(Wk + i * 16 * 136, 136, ST + wave * 16 * 136, 136, 128, (f32x4){0.f, 0.f, 0.f, 0.f}, lane);
                accO[i] = mma_tile(Qs + i * 16 * 136, 136, ST + wave * 16 * 136, 136, 128, (f32x4){0.f, 0.f, 0.f, 0.f}, lane);
                const int dv = wave * 16 + r16; float u[4];
#pragma unroll
                for (int j = 0; j < 4; ++j) { const int l = i * 16 + q4 + j; u[j] = bf2f(Vb[l * 136 + dv]) - ws[j]; accO[i][j] *= GS[64 + l]; }
                u32x2 w; w.x = cvt_pk_bf16(u[0], u[1]); w.y = cvt_pk_bf16(u[2], u[3]);
                *(LAS u32x2*)(UT + dv * 72 + i * 16 + q4) = w;
                __builtin_amdgcn_sched_barrier(0);
            }
#pragma unroll
            for (int i = 0; i < 2; ++i) { const int tile = wave + 8 * i, mi = tile >> 2, ni = tile & 3;
                const f32x4 qk = mma_tile(Qs + mi * 16 * 136, 136, Ks + ni * 16 * 136, 136, 128, (f32x4){0.f, 0.f, 0.f, 0.f}, lane);
                const int m = ni * 16 + r16;
#pragma unroll
                for (int j = 0; j < 4; ++j) { const int l = mi * 16 + q4 + j; QKm[l * 72 + m] = f2bf((m <= l) ? qk[j] * __expf(GS[l] - GS[m]) : 0.f); }
                __builtin_amdgcn_sched_barrier(0); }
            __syncthreads();
            const float gl = __expf(Glast);
#pragma unroll
            for (int i = 0; i < 4; ++i) { accO[i] = mma_tile(QKm + i * 16 * 72, 72, UT + wave * 16 * 72, 72, 64, accO[i], lane); __builtin_amdgcn_sched_barrier(0); }
#pragma unroll
            for (int i = 0; i < 8; ++i) { accS[i] = mma_tile(UT + i * 16 * 72, 72, KdT + wave * 16 * 72, 72, 64, accS[i] * gl, lane);
#pragma unroll
                for (int j = 0; j < 4; ++j) ST[(i * 16 + q4 + j) * 136 + wave * 16 + r16] = f2bf(accS[i][j]);
                __builtin_amdgcn_sched_barrier(0); }
            __syncthreads();
#pragma unroll
            for (int i = 0; i < 4; ++i)
#pragma unroll
                for (int j = 0; j < 4; ++j) Ob[(i * 16 + q4 + j) * 132 + wave * 16 + r16] = accO[i][j];
            __syncthreads();
            { const int l = tid >> 3, cb = (tid & 7) * 16, t = t0 + l; float o[16], ss = 0.f;
#pragma unroll
              for (int i = 0; i < 4; ++i) { const f32x4 v = *(const LAS f32x4*)(Ob + l * 132 + cb + 4 * i); o[4 * i] = v[0]; o[4 * i + 1] = v[1]; o[4 * i + 2] = v[2]; o[4 * i + 3] = v[3]; ss += (v[0] * v[0] + v[1] * v[1]) + (v[2] * v[2] + v[3] * v[3]); }
              ss = rowsum8(ss); const float rstd = rsqrtf(ss * (1.f / 128.f) + EPSF);
              if (t < T) { const size_t row = (size_t)(r0 + t); float z[16];
                  unpack8(*(const u32x4*)(P + row * PE + 3328 + h * 128 + cb), *(float(*)[8])&z[0]); unpack8(*(const u32x4*)(P + row * PE + 3328 + h * 128 + cb + 8), *(float(*)[8])&z[8]);
                  float r[16];
#pragma unroll
                  for (int i = 0; i < 16; ++i) r[i] = o[i] * rstd * dnw[cb + i] * siluf_(z[i]);
                  *(u32x4*)(YC + row * 1024 + 512 + h * 128 + cb) = pack8(*(float(*)[8])&r[0]); *(u32x4*)(YC + row * 1024 + 512 + h * 128 + cb + 8) = pack8(*(float(*)[8])&r[8]); } }
            __syncthreads();
        }
        float* so = outp + (s < 8 ? O_PDELTA + (size_t)(s * 4 + h) * 16384 : O_SDELTA + (size_t)((s - 8) * 4 + h) * 16384);
#pragma unroll
        for (int i = 0; i < 8; ++i) *(f32x4*)(so + (size_t)(wave * 16 + r16) * 128 + i * 16 + q4) = accS[i];
        __syncthreads();
    }
}

template <int DK, bool RET>
__device__ __forceinline__ void lin_scan_task(const int wv__, const bf16_t* P, const float* SC, bf16_t* YC, LAS unsigned char* lds, int s, int h) {
    const int tid = otid(), lane = tid & 63, wave = tid >> 6;
    constexpr int LQ = DK + 8, NTK = DK / 16, NS = (8 * NTK) / 8;
    LAS bf16_t* ST = (LAS bf16_t*)lds;
    LAS bf16_t* Qi = ST + 128 * LQ;
    LAS bf16_t* Ki = Qi + 64 * LQ;
    LAS bf16_t* KoT = Ki + 64 * LQ;
    LAS bf16_t* VT = KoT + DK * 72;
    LAS bf16_t* Sc = VT + 128 * 72;
    LAS float* Ob = (LAS float*)(Sc + 64 * 72);
    LAS float* TOT = Ob + 64 * 132;
    LAS float* DEC = TOT + 512;
    const int r16 = lane & 15, q4 = (lane >> 4) * 4;
    const int T = seq_T(s), r0 = seq_row0(s), nch = (T + 63) >> 6;
    const float* gnw = inptr(37);
    const int qoff = RET ? 1536 + h * 128 : h * 64, koff = RET ? 2048 + h * 128 : 256 + h * 64, voff = RET ? 2560 + h * 128 : 512 + h * 128, goff = RET ? 3072 + h * 128 : 1024 + h * 128;
    f32x4 accS[NS];
    const float* st0 = (RET ? inptr(8) : inptr(7)) + (size_t)((s - 8) * 4 + h) * DK * 128;
#pragma unroll
    for (int i = 0; i < NS; ++i) { const int tile = wave + 8 * i, mi = tile / NTK, ni = tile % NTK;
        accS[i] = (s >= 8) ? *(const f32x4*)(st0 + (size_t)(ni * 16 + r16) * 128 + mi * 16 + q4) : (f32x4){0.f, 0.f, 0.f, 0.f};
#pragma unroll
        for (int j = 0; j < 4; ++j) ST[(mi * 16 + q4 + j) * LQ + ni * 16 + r16] = f2bf(accS[i][j]); }
    float a2c[16]; float abias = 0.f;
    if (!RET) { const int ch = tid & 63;
        const float* a2p = inptr(35);
#pragma unroll
        for (int r = 0; r < 16; ++r) a2c[r] = a2p[r * 256 + h * 64 + ch];
        abias = inptr(36)[h * 64 + ch]; }
    const float lg = RET ? __logf(1.f - exp2f(-5.f - (float)h)) : 0.f;
    for (int c = 0; c < nch; ++c) {
        const int t0 = c * 64; const int nvalid = min(64, T - t0);
        { const int dv = tid & 127, tg = tid >> 7;
#pragma unroll 4
          for (int i = 0; i < 16; ++i) { const int tk = tg * 16 + i; VT[dv * 72 + tk] = (tk < nvalid) ? P[(size_t)(r0 + t0 + tk) * PO + voff + dv] : (bf16_t)0; } }
        if (!RET) {
            const int ch = tid & 63, tg = tid >> 6; float la[8], run = 0.f;
#pragma unroll
            for (int i = 0; i < 8; ++i) { const int tk = tg * 8 + i; float x = 0.f;
                if (tk < nvalid) { const float* sc = SC + (size_t)(r0 + t0 + tk) * 16; float z = abias;
#pragma unroll
                    for (int r = 0; r < 16; ++r) z += sc[r] * a2c[r];
                    x = -softplusf_(-z) * (1.f / 16.f); }
                run += x; la[i] = run; }
            TOT[tg * 64 + ch] = run;
            __syncthreads();
            float pre = 0.f, tot = 0.f;
#pragma unroll
            for (int g = 0; g < 8; ++g) { const float v = TOT[g * 64 + ch]; tot += v; if (g < tg) pre += v; }
            if (tg == 0) DEC[ch] = __expf(tot);
#pragma unroll
            for (int i = 0; i < 8; ++i) { const int tk = tg * 8 + i; const float cum = la[i] + pre; float qv = 0.f, kv = 0.f;
                if (tk < nvalid) { const bf16_t* p = P + (size_t)(r0 + t0 + tk) * PO; qv = bf2f(p[qoff + ch]) * 0.125f; kv = bf2f(p[koff + ch]); }
                Qi[tk * LQ + ch] = f2bf(qv * __expf(cum)); Ki[tk * LQ + ch] = f2bf(kv * __expf(-cum)); KoT[ch * 72 + tk] = f2bf(kv * __expf(tot - cum)); }
        } else {
            const int pi = tid & 63, tg = tid >> 6;
            const float inv = exp2f(-(float)pi * (13.287712379549449f / 64.f));
            const float tot = (float)nvalid * lg;
            if (tid < DK) DEC[tid] = __expf(tot);
#pragma unroll 2
            for (int i = 0; i < 8; ++i) { const int tk = tg * 8 + i; float q1 = 0.f, q2 = 0.f, k1 = 0.f, k2 = 0.f;
                const float cum = (float)min(tk + 1, nvalid) * lg;
                if (tk < nvalid) { const bf16_t* p = P + (size_t)(r0 + t0 + tk) * PO; const float x1 = bf2f(p[qoff + pi]), x2 = bf2f(p[qoff + 64 + pi]), y1 = bf2f(p[koff + pi]), y2 = bf2f(p[koff + 64 + pi]);
                    const float pos = (float)(t0 + tk + (s >= 8 ? 1024 : 0)); const float rev = pos * inv * 0.15915494309189535f; const float fr = rev - floorf(rev);
                    const float sn = __builtin_amdgcn_sinf(fr), cs = __builtin_amdgcn_cosf(fr);
                    q1 = x1 * cs - x2 * sn; q2 = x1 * sn + x2 * cs; k1 = (y1 * cs - y2 * sn) * 0.08838834764831845f; k2 = (y1 * sn + y2 * cs) * 0.08838834764831845f; }
                const float ei = __expf(cum), eo = __expf(-cum), ek = __expf(tot - cum);
                Qi[tk * LQ + pi] = f2bf(q1 * ei); Qi[tk * LQ + 64 + pi] = f2bf(q2 * ei); Ki[tk * LQ + pi] = f2bf(k1 * eo); Ki[tk * LQ + 64 + pi] = f2bf(k2 * eo);
                KoT[pi * 72 + tk] = f2bf(k1 * ek); KoT[(64 + pi) * 72 + tk] = f2bf(k2 * ek); }
        }
        __syncthreads();
        f32x4 accO[4];
#pragma unroll
        for (int i = 0; i < 4; ++i) accO[i] = mma_tile(Qi + i * 16 * LQ, LQ, ST + wave * 16 * LQ, LQ, DK, (f32x4){0.f, 0.f, 0.f, 0.f}, lane);
#pragma unroll
        for (int i = 0; i < 2; ++i) { const int tile = wave + 8 * i, mi = tile >> 2, ni = tile & 3;
            const f32x4 sc = mma_tile(Qi + mi * 16 * LQ, LQ, Ki + ni * 16 * LQ, LQ, DK, (f32x4){0.f, 0.f, 0.f, 0.f}, lane);
            const int m = ni * 16 + r16;
#pragma unroll
            for (int j = 0; j < 4; ++j) { const int l = mi * 16 + q4 + j; Sc[l * 72 + m] = f2bf((m <= l) ? sc[j] : 0.f); } }
        __syncthreads();
#pragma unroll
        for (int i = 0; i < 4; ++i) accO[i] = mma_tile(Sc + i * 16 * 72, 72, VT + wave * 16 * 72, 72, 64, accO[i], lane);
#pragma unroll
        for (int i = 0; i < NS; ++i) { const int tile = wave + 8 * i, mi = tile / NTK, ni = tile % NTK;
#ifdef DBG_NOSTATE
            accS[i] = (f32x4){0.f, 0.f, 0.f, 0.f};
#else
            accS[i] = mma_tile(VT + mi * 16 * 72, 72, KoT + ni * 16 * 72, 72, 64, accS[i] * DEC[ni * 16 + r16], lane);
#endif
#pragma unroll
            for (int j = 0; j < 4; ++j) ST[(mi * 16 + q4 + j) * LQ + ni * 16 + r16] = f2bf(accS[i][j]); }
#pragma unroll
        for (int i = 0; i < 4; ++i)
#pragma unroll
            for (int j = 0; j < 4; ++j) Ob[(i * 16 + q4 + j) * 132 + wave * 16 + r16] = accO[i][j];
        __syncthreads();
        { const int l = tid >> 3, cb = (tid & 7) * 16, t = t0 + l; float o[16], sm = 0.f;
#pragma unroll
          for (int i = 0; i < 4; ++i) { const f32x4 v = *(const LAS f32x4*)(Ob + l * 132 + cb + 4 * i); o[4 * i] = v[0]; o[4 * i + 1] = v[1]; o[4 * i + 2] = v[2]; o[4 * i + 3] = v[3]; sm += (v[0] + v[1]) + (v[2] + v[3]); }
          float mean = 0.f;
          if (RET) { mean = rowsum8(sm) * (1.f / 128.f); }
          float ss = 0.f;
#pragma unroll
          for (int i = 0; i < 16; ++i) { o[i] -= mean; ss += o[i] * o[i]; }
          ss = rowsum8(ss); const float rstd = rsqrtf(ss * (1.f / 128.f) + EPSF);
          if (t < T) { const size_t row = (size_t)(r0 + t); float z[16], r[16];
              unpack8(*(const u32x4*)(P + row * PO + goff + cb), *(float(*)[8])&z[0]); unpack8(*(const u32x4*)(P + row * PO + goff + cb + 8), *(float(*)[8])&z[8]);
#pragma unroll
              for (int i = 0; i < 16; ++i) r[i] = o[i] * rstd * (RET ? 1.f : gnw[cb + i]) * siluf_(z[i]);
              bf16_t* dst = YC + row * 1024 + (RET ? 512 : 0) + h * 128 + cb;
              *(u32x4*)dst = pack8(*(float(*)[8])&r[0]); *(u32x4*)(dst + 8) = pack8(*(float(*)[8])&r[8]); } }
        __syncthreads();
    }
    float* so = outptr() + (RET ? (s < 8 ? O_PRET + (size_t)(s * 4 + h) * 16384 : O_SRET + (size_t)((s - 8) * 4 + h) * 16384)
                             : (s < 8 ? O_PGLA + (size_t)(s * 4 + h) * 8192 : O_SGLA + (size_t)((s - 8) * 4 + h) * 8192));
#pragma unroll
    for (int i = 0; i < NS; ++i) { const int tile = wave + 8 * i, mi = tile / NTK, ni = tile % NTK; *(f32x4*)(so + (size_t)(ni * 16 + r16) * 128 + mi * 16 + q4) = accS[i]; }
    __syncthreads();
}
__device__ __forceinline__ void odd_scan_phase(const int wv__, const bf16_t* P, const float* SC, bf16_t* YC, LAS unsigned char* lds) {
    for (int task = blockIdx.x; task < 192; task += gridDim.x) {
        if (task < 32) lin_scan_task<128, true>(wv__, P, SC, YC, lds, task >> 2, task & 3);
        else if (task < 64) lin_scan_task<64, false>(wv__, P, SC, YC, lds, (task - 32) >> 2, task & 3);
        else if (task < 128) lin_scan_task<128, true>(wv__, P, SC, YC, lds, 8 + ((task - 64) >> 2), task & 3);
        else lin_scan_task<64, false>(wv__, P, SC, YC, lds, 8 + ((task - 128) >> 2), task & 3);
    }
}

__device__ __forceinline__ void kv_convert(const int wv__, int layer, bf16_t* KB, bf16_t* VTB) {
    const int gt = blockIdx.x * 512 + otid(), NT = gridDim.x * 512;
    const float* outp = outptr(); const float* ck = inptr(9); const float* cv = inptr(10);
    for (int it = gt; it < 96 * 256 * 256; it += NT) {
        const int sh = it >> 16, r = it & 65535; const int s = sh >> 2, h = sh & 3;
        const float* kb = s < 8 ? outp + O_PMK + (size_t)layer * 2097152 + (size_t)s * 262144 : ck + (size_t)layer * 4194304 + (size_t)(s - 8) * 262144;
        const float* vb = s < 8 ? outp + O_PMV + (size_t)layer * 2097152 + (size_t)s * 262144 : cv + (size_t)layer * 4194304 + (size_t)(s - 8) * 262144;
        { const int mem = r >> 8, hd = r & 255; KB[it] = f2bf(kb[(size_t)mem * 1024 + h * 256 + hd]); }
        { const int hd = r >> 8, mem = r & 255; VTB[it] = f2bf(vb[(size_t)mem * 1024 + h * 256 + hd]); }
    }
}
__device__ __forceinline__ void attn_phase(const int wv__, const bf16_t* Q, const bf16_t* KB, const bf16_t* VTB, bf16_t* O, LAS unsigned char* lds) {
    const int tid = otid(), lane = tid & 63, wave = tid >> 6, r16 = lane & 15, q4 = (lane >> 4) * 4;
    LAS bf16_t* QP = (LAS bf16_t*)lds;
    LAS bf16_t* KV = QP + 128 * 264;
    for (int unit = blockIdx.x; unit < 2112; unit += gridDim.x) {
        int s, h, row_base, nrows;
        if (unit < 2048) { s = unit >> 8; h = (unit >> 6) & 3; row_base = s * 8192 + (unit & 63) * 128; nrows = 128; } else { const int q = unit - 2048; s = 8 + (q >> 2); h = q & 3; row_base = MP + (s - 8) * 16; nrows = 16; }
        const bf16_t* kb = KB + (size_t)(s * 4 + h) * 65536; const bf16_t* vt = VTB + (size_t)(s * 4 + h) * 65536;
#pragma unroll
        for (int it = 0; it < 8; ++it) { const int idx = tid + 512 * it, r = idx >> 5, ch = idx & 31;
            u32x4 v = (u32x4){0u, 0u, 0u, 0u}; if (r < nrows) v = *(const u32x4*)(Q + (size_t)(row_base + r) * 1024 + h * 256 + ch * 8);
            *(LAS u32x4*)(QP + r * 264 + ch * 8) = v; }
        f32x4 accS[16];
#pragma unroll
        for (int hf = 0; hf < 2; ++hf) {
#pragma unroll
            for (int it = 0; it < 8; ++it) { const int idx = tid + 512 * it, r = idx >> 5, ch = idx & 31; *(LAS u32x4*)(KV + r * 264 + ch * 8) = *(const u32x4*)(kb + (size_t)(hf * 128 + r) * 256 + ch * 8); }
            __syncthreads();
#pragma unroll
            for (int ni = 0; ni < 8; ++ni) accS[hf * 8 + ni] = mma_tile(QP + wave * 16 * 264, 264, KV + ni * 16 * 264, 264, 256, (f32x4){0.f, 0.f, 0.f, 0.f}, lane);
            __syncthreads();
        }
        float mx[4], sm[4];
#pragma unroll
        for (int j = 0; j < 4; ++j) { float m = accS[0][j];
#pragma unroll
            for (int ni = 1; ni < 16; ++ni) m = fmaxf(m, accS[ni][j]);
            mx[j] = rowmax16(m); sm[j] = 0.f; }
#pragma unroll
        for (int ni = 0; ni < 16; ++ni)
#pragma unroll
            for (int j = 0; j < 4; ++j) { const float p = __expf((accS[ni][j] - mx[j]) * 0.0625f); accS[ni][j] = p; sm[j] += p; }
#pragma unroll
        for (int j = 0; j < 4; ++j) sm[j] = __builtin_amdgcn_rcpf(rowsum16(sm[j]));
#pragma unroll
        for (int ni = 0; ni < 16; ++ni)
#pragma unroll
            for (int j = 0; j < 4; ++j) QP[(wave * 16 + q4 + j) * 264 + ni * 16 + r16] = f2bf(accS[ni][j] * sm[j]);
        f32x4 accO[16];
#pragma unroll
        for (int ni = 0; ni < 16; ++ni) accO[ni] = (f32x4){0.f, 0.f, 0.f, 0.f};
#pragma unroll
        for (int hf = 0; hf < 2; ++hf) {
#pragma unroll
            for (int it = 0; it < 8; ++it) { const int idx = tid + 512 * it, r = idx >> 4, ch = idx & 15; *(LAS u32x4*)(KV + r * 136 + ch * 8) = *(const u32x4*)(vt + (size_t)r * 256 + hf * 128 + ch * 8); }
            __syncthreads();
#pragma unroll
            for (int ni = 0; ni < 16; ++ni) accO[ni] = mma_tile(QP + wave * 16 * 264 + hf * 128, 264, KV + ni * 16 * 136, 136, 128, accO[ni], lane);
            __syncthreads();
        }
#pragma unroll
        for (int ni = 0; ni < 16; ++ni)
#pragma unroll
            for (int j = 0; j < 4; ++j) { const int r = wave * 16 + q4 + j; if (r < nrows) O[(size_t)(row_base + r) * 1024 + h * 256 + ni * 16 + r16] = f2bf(accO[ni][j]); }
    }
}

__device__ __forceinline__ void prologue_phase(const int wv__, bf16_t* WT, bf16_t* AMEM, LAS unsigned char* lds) {
    const int tid = otid(), lane = tid & 63, wave = tid >> 6, gw = blockIdx.x * 8 + wave, NGW = gridDim.x * 8;
    LAS float* scr = (LAS float*)(lds + wave * 8704);
    int cum = 0;
    for (int l = 0; l < 2; ++l) {
        cvt_ffn_up(inptr(12) + (size_t)l * D * FF, inptr(13) + (size_t)l * D * FF, WT + E_F1U + (size_t)l * 5632 * 1024, scr, lane, gw, NGW, cum);
        cvt_seg(inptr(14) + (size_t)l * FF * D, D, 0, D, FF, WT + E_F1D + (size_t)l * 1024 * 2816, nullptr, scr, lane, gw, NGW, cum);
        cvt_ffn_up(inptr(45) + (size_t)l * D * FF, inptr(46) + (size_t)l * D * FF, WT + E_F2U + (size_t)l * 5632 * 1024, scr, lane, gw, NGW, cum);
        cvt_seg(inptr(47) + (size_t)l * FF * D, D, 0, D, FF, WT + E_F2D + (size_t)l * 1024 * 2816, nullptr, scr, lane, gw, NGW, cum);
        cvt_seg(inptr(40) + (size_t)l * D * D, D, 0, D, D, WT + E_WQ + (size_t)l * D * D, nullptr, scr, lane, gw, NGW, cum);
        cvt_seg(inptr(43) + (size_t)l * D * D, D, 0, D, D, WT + E_WO + (size_t)l * D * D, nullptr, scr, lane, gw, NGW, cum);
        cvt_seg(inptr(41) + (size_t)l * D * D, D, 0, D, D, WT + E_MKV + (size_t)(2 * l) * D * D, inptr(39) + l * D, scr, lane, gw, NGW, cum);
        cvt_seg(inptr(42) + (size_t)l * D * D, D, 0, D, D, WT + E_MKV + (size_t)(2 * l + 1) * D * D, inptr(39) + l * D, scr, lane, gw, NGW, cum);
    }
    cvt_seg(inptr(16), 3848, 0, 1792, D, WT + E_EIN, nullptr, scr, lane, gw, NGW, cum);
    cvt_seg(inptr(16), 3848, 1792, 1536, D, WT + E_EIN + 1792ull * D, nullptr, scr, lane, gw, NGW, cum);
    cvt_seg(inptr(16), 3848, 3336, 512, D, WT + E_EIN + 3328ull * D, nullptr, scr, lane, gw, NGW, cum);
    cvt_seg(inptr(17), D, 0, D, D, WT + E_EOUT, nullptr, scr, lane, gw, NGW, cum);
    cvt_seg(inptr(33), 3600, 0, 1024, D, WT + E_OIN, nullptr, scr, lane, gw, NGW, cum);
    cvt_seg(inptr(33), 3600, 1040, 2560, D, WT + E_OIN + 1024ull * D, nullptr, scr, lane, gw, NGW, cum);
    cvt_seg(inptr(34), D, 0, D, D, WT + E_OOUT, nullptr, scr, lane, gw, NGW, cum);
    const int gt = blockIdx.x * 512 + tid, NTH = gridDim.x * 512;
    const float* w2p = inptr(20); const float* a2p = inptr(22); const float* g2p = inptr(23);
    for (int i = gt; i < 1024 * 256; i += NTH) { const int n = i >> 8, k = i & 255; float v = 0.f;
        if (n < 512) { if (k < 64) v = w2p[(size_t)k * 512 + n]; } else { if (k >= 64 && k < 128) v = a2p[(size_t)(k - 64) * 512 + (n - 512)]; }
        WT[E_LR1 + i] = f2bf(v); }
    for (int i = gt; i < 512 * 256; i += NTH) { const int n = i >> 8, k = i & 255; WT[E_LR2 + i] = f2bf(k >= 128 ? g2p[(size_t)(k - 128) * 512 + n] : 0.f); }
    const float* memp = inptr(2);
    for (int row = gw; row < 2048; row += NGW) {
        const float* src = memp + (size_t)row * D; f32x4 v[4]; float ss = 0.f;
#pragma unroll
        for (int j = 0; j < 4; ++j) { v[j] = *(const f32x4*)(src + (lane + 64 * j) * 4); ss += (v[j][0] * v[j][0] + v[j][1] * v[j][1]) + (v[j][2] * v[j][2] + v[j][3] * v[j][3]); }
        const float rstd = rsqrtf(wave_sum(ss) * (1.f / D) + EPSF);
#pragma unroll
        for (int j = 0; j < 4; ++j) { u32x2 o; o.x = cvt_pk_bf16(v[j][0] * rstd, v[j][1] * rstd); o.y = cvt_pk_bf16(v[j][2] * rstd, v[j][3] * rstd); *(u32x2*)(AMEM + (size_t)row * D + (lane + 64 * j) * 4) = o; }
    }
}
__device__ __forceinline__ void final_norm_phase(const int wv__, float* X, const float* w) {
    const int lane = otid() & 63, wave = otid() >> 6, gw = blockIdx.x * 8 + wave, NGW = gridDim.x * 8;
    f32x4 wv[4];
#pragma unroll
    for (int j = 0; j < 4; ++j) wv[j] = *(const f32x4*)(w + (lane + 64 * j) * 4);
    for (int row = gw; row < MT; row += NGW) {
        float* p = X + (size_t)row * D; f32x4 v[4]; float ss = 0.f;
#pragma unroll
        for (int j = 0; j < 4; ++j) { v[j] = *(const f32x4*)(p + (lane + 64 * j) * 4); ss += (v[j][0] * v[j][0] + v[j][1] * v[j][1]) + (v[j][2] * v[j][2] + v[j][3] * v[j][3]); }
        const float rstd = rsqrtf(wave_sum(ss) * (1.f / D) + EPSF);
#pragma unroll
        for (int j = 0; j < 4; ++j) *(f32x4*)(p + (lane + 64 * j) * 4) = v[j] * rstd * wv[j];
    }
}

#define WT ((bf16_t*)(wsptr() + WS_WT))
#define AMEM ((bf16_t*)(wsptr() + WS_AMEM))
#define SC ((float*)(wsptr() + WS_SC))
#define BONUS ((float*)(wsptr() + WS_BONUS))
#define HY ((bf16_t*)(wsptr() + WS_HY))
#define BIG ((bf16_t*)(wsptr() + WS_BIG))
#define LREA ((bf16_t*)(wsptr() + WS_LREA))
#define VBWK ((bf16_t*)(wsptr() + WS_VBWK))
#define AP ((bf16_t*)(wsptr() + WS_AP))
#define KB ((bf16_t*)(wsptr() + WS_KB))
#define VTB ((bf16_t*)(wsptr() + WS_VTB))
#define X (outptr())
#ifndef SITE_MASK
#define SITE_MASK 0xffffffffffffffffull
#endif
#define PHASE(...) do { if (ph >= lo && ph < hi) { if (ph > lo) grid.sync(); { __VA_ARGS__ } } ++ph; } while (0)

template <int l> __device__ __forceinline__ void layer_phases(const int wv__, cg::grid_group& grid, int& ph, const int lo, const int hi, LAS unsigned char* lds, const int cbase) {
        if (l > 0) PHASE({ norm_phase<false, 0>(wv__, nullptr, nullptr, X, HY, inptr(11) + l * D, nullptr, 0, 0, nullptr, lds); });
        PHASE({ EpiSwiglu E{BIG}; run_gemm(wv__, lds, HY, WT + E_F1U + (size_t)l * 5632 * 1024, MT, 5632, D, E); });
        PHASE({ EpiResid E{X, 0.5f}; run_gemm(wv__, lds, BIG, WT + E_F1D + (size_t)l * 1024 * 2816, MT, D, FF, E); });
        if (l == 0) {
            PHASE({ norm_phase<false, 8>(wv__, nullptr, nullptr, X, HY, inptr(15), inptr(16), 3848, 3328, SC, lds); });
            PHASE({ EpiBf16 E{BIG, PE}; run_gemm(wv__, lds, HY, WT + E_EIN, MT, PE, D, E); });
            PHASE({ rwkv_prep_phase(wv__, BIG, AP); });
            PHASE({ EpiLR1 E{LREA, inptr(19), inptr(21)}; run_gemm(wv__, lds, AP, WT + E_LR1, MT, 1024, 256, E); });
            PHASE({ delta_prep_phase(wv__, BIG, SC, VBWK, lds); });
            PHASE({ rwkv_scan_phase(wv__, BIG, LREA, HY, BONUS, lds); });
            PHASE({ EpiBf16 E{LREA, 512}; run_gemm(wv__, lds, AP, WT + E_LR2, MT, 512, 256, E); });
            PHASE({ delta_scan_phase(wv__, BIG, SC, VBWK, HY, lds); });
            PHASE({ rwkv_post_phase(wv__, BIG, LREA, BONUS, HY); });
#ifdef DBG_DUMP
            PHASE({ const int gt = blockIdx.x * 512 + otid(); float* xo = X; const bf16_t* hy = HY; for (size_t i = gt; i < (size_t)MT * 1024; i += (size_t)gridDim.x * 512) { const int col = (int)(i & 1023); xo[i] = (col >= DBG_C0 && col < DBG_C1) ? bf2f(hy[i]) : 0.f; }
#ifdef DBG_P
 const bf16_t* pp = BIG; for (size_t i = gt; i < (size_t)MT * 1024; i += (size_t)gridDim.x * 512) { const size_t row = i >> 10; const int col = (int)(i & 1023); xo[i] = bf2f(pp[row * PE + DBG_P + col]); }
#endif
#ifdef DBG_VBWK
 const bf16_t* vb = VBWK; for (size_t i = gt; i < (size_t)MT * 1024; i += (size_t)gridDim.x * 512) xo[i] = bf2f(vb[i]);
#endif
 });
#else
            PHASE({ EpiResid E{X, 1.f}; run_gemm(wv__, lds, HY, WT + E_EOUT, MT, D, D, E); });
#endif
        } else {
            PHASE({ norm_phase<false, 16>(wv__, nullptr, nullptr, X, HY, inptr(15) + l * D, inptr(33), 3600, 1024, SC, lds); });
            PHASE({ EpiBf16 E{BIG, PO}; run_gemm(wv__, lds, HY, WT + E_OIN, MT, PO, D, E); });
            PHASE({ odd_scan_phase(wv__, BIG, SC, HY, lds); });
            PHASE({ EpiResid E{X, 1.f}; run_gemm(wv__, lds, HY, WT + E_OOUT, MT, D, D, E); });
        }
        PHASE({ norm_phase<false, 0>(wv__, nullptr, nullptr, X, HY, inptr(38) + l * D, nullptr, 0, 0, nullptr, lds); kv_convert(wv__, l, KB, VTB); });
        PHASE({ EpiBf16 E{BIG, 1024}; run_gemm(wv__, lds, HY, WT + E_WQ + (size_t)l * D * D, MT, D, D, E); });
        PHASE({ attn_phase(wv__, BIG, KB, VTB, HY, lds); });
        PHASE({ EpiResid E{X, 1.f}; run_gemm(wv__, lds, HY, WT + E_WO + (size_t)l * D * D, MT, D, D, E); });
        PHASE({ norm_phase<false, 0>(wv__, nullptr, nullptr, X, HY, inptr(44) + l * D, nullptr, 0, 0, nullptr, lds); });
        PHASE({ EpiSwiglu E{BIG}; run_gemm(wv__, lds, HY, WT + E_F2U + (size_t)l * 5632 * 1024, MT, 5632, D, E); });
        PHASE({ EpiResid E{X, 0.5f}; run_gemm(wv__, lds, BIG, WT + E_F2D + (size_t)l * 1024 * 2816, MT, D, FF, E); });

}
constexpr int NPHASE = 36;
__global__ void __launch_bounds__(512, 2) hybrid_fwd(Args a) {
    extern __shared__ __attribute__((aligned(16))) unsigned char lds_raw[];
    LAS unsigned char* lds = (LAS unsigned char*)lds_raw;
    cg::grid_group grid = cg::this_grid();
    const int wv__ = __builtin_amdgcn_readfirstlane((int)(threadIdx.x >> 6));
    const int lo = a.ph_lo, hi = a.ph_hi;
    int ph = 0;
    const int cbase = 0;
    PHASE({ prologue_phase(wv__, WT, AMEM, lds); __syncthreads(); norm_phase<true, 0>(wv__, inptr(0), inptr(1), X, HY, inptr(11), nullptr, 0, 0, nullptr, lds); });
#ifdef TEST_ORDER
    PHASE({ if (blockIdx.x == 0) { const long long t0 = wall_clock64(); while (wall_clock64() - t0 < 300000) __builtin_amdgcn_s_sleep(64);
            float* xo = X; for (int i = otid(); i < 1024; i += 512) xo[i] = 1.0f; } });
    PHASE({ float* xo = X; const float v = ((volatile float*)xo)[0] + 1.0f; const int gt = blockIdx.x * 512 + otid(); for (size_t i = 1024 + gt; i < (size_t)MT * 1024; i += (size_t)gridDim.x * 512) xo[i] = v; });
    return;
#endif
#ifdef TEST_ODD
    PHASE({ norm_phase<false, 16>(wv__, nullptr, nullptr, X, HY, inptr(15) + D, inptr(33), 3600, 1024, SC, lds); });
    PHASE({ EpiBf16 E{BIG, PO}; run_gemm(wv__, lds, HY, WT + E_OIN, MT, PO, D, E); });
    PHASE({ odd_scan_phase(wv__, BIG, SC, HY, lds); });
    PHASE({ const int gt = blockIdx.x * 512 + otid(); float* xo = X; const bf16_t* hy = HY; for (size_t i = gt; i < (size_t)MT * 1024; i += (size_t)gridDim.x * 512) { const int col = (int)(i & 1023); xo[i] = (col >= DBG_C0 && col < DBG_C1) ? bf2f(hy[i]) : 0.f; } });
    return;
#endif
    PHASE({ EpiMemKV E{outptr() + O_PMK}; run_gemm(wv__, lds, AMEM, WT + E_MKV, 2048, 4096, D, E); });
    layer_phases<0>(wv__, grid, ph, lo, hi, lds, cbase);
    layer_phases<1>(wv__, grid, ph, lo, hi, lds, cbase);
    PHASE({ final_norm_phase(wv__, X, inptr(48)); });
#undef PHASE
}

extern "C" void kernel_launch(void* const* d_in, const int* in_sizes, int n_in, void* d_out, int out_size, void* d_ws, size_t ws_size, hipStream_t stream) {
    static int grid = 0;
    if (grid == 0) {
        int dev = 0, cus = 0, per_cu = 0;
        hipGetDevice(&dev);
        hipDeviceGetAttribute(&cus, hipDeviceAttributeMultiprocessorCount, dev);
        if (hipFuncSetAttribute((const void*)hybrid_fwd, hipFuncAttributeMaxDynamicSharedMemorySize, LDS_BYTES) != hipSuccess) fprintf(stderr, "kernel_launch: hipFuncSetAttribute failed\n");
        if (hipOccupancyMaxActiveBlocksPerMultiprocessor(&per_cu, (const void*)hybrid_fwd, 512, LDS_BYTES) != hipSuccess || per_cu < 1) { fprintf(stderr, "kernel_launch: occupancy query says %d\n", per_cu); per_cu = 1; }
        (void)hipGetLastError();
        grid = cus > 0 ? cus : 256;
        if (n_in != 49 || (size_t)out_size != O_END || ws_size < WS_END) fprintf(stderr, "kernel_launch: unexpected sizes n_in %d out %d ws %zu (need %zu)\n", n_in, out_size, ws_size, (size_t)WS_END);
    }
#ifdef DBG_MEMSET
    (void)hipMemsetAsync(d_ws, 0, WS_END, stream);
#endif
    Args a{};
    for (int i = 0; i < 49; ++i) a.in[i] = (const float*)d_in[i];
    a.out = (float*)d_out; a.ws = (unsigned char*)d_ws;
#ifndef N_LAUNCH_PER_PHASE
    a.ph_lo = 0; a.ph_hi = NPHASE;
    void* args[] = {&a};
    hipError_t e = hipLaunchCooperativeKernel((const void*)hybrid_fwd, dim3(grid), dim3(512), args, LDS_BYTES, stream);
    if (e != hipSuccess) fprintf(stderr, "cooperative launch failed: %s (grid %d)\n", hipGetErrorString(e), grid);
#else
#ifndef PH_STOP
#define PH_STOP NPHASE
#endif
    for (int p = 0; p < PH_STOP; ++p) {
        a.ph_lo = p; a.ph_hi = p + 1;
        void* args[] = {&a};
        hipError_t e = hipLaunchCooperativeKernel((const void*)hybrid_fwd, dim3(grid), dim3(512), args, LDS_BYTES, stream);
        if (e != hipSuccess) { fprintf(stderr, "cooperative launch %d failed: %s (grid %d)\n", p, hipGetErrorString(e), grid); break; }
    }
#endif
}
```

```cpp
#include <hip/hip_runtime.h>
#include <hip/hip_cooperative_groups.h>
#include <cstdio>
#include <cstdint>
namespace cg = cooperative_groups;

#define LAS __attribute__((address_space(3)))
typedef unsigned short bf16_t;
typedef short bf16x8 __attribute__((ext_vector_type(8)));
typedef float f32x4 __attribute__((ext_vector_type(4)));
typedef float f32x2 __attribute__((ext_vector_type(2)));
typedef unsigned u32x4 __attribute__((ext_vector_type(4)));
typedef unsigned u32x2 __attribute__((ext_vector_type(2)));

#define otid() otid_(wv__)
__device__ __forceinline__ int otid_(int wv) { int t = (wv << 6) | (int)__builtin_amdgcn_mbcnt_hi(~0u, __builtin_amdgcn_mbcnt_lo(~0u, 0u)); asm volatile("" : "+v"(t)); return t; }
namespace pg8 {
constexpr int BM = 256, BK = 64, HALF = 128, HTB = HALF * BK * 2, STAGE_BYTES = 8 * HTB, NXCD = 8, WGM = 8;
__host__ __device__ __forceinline__ int lds_byte(int r, int c) { const int st = (r >> 4) * 2 + (c >> 5), rr = r & 15, cc = c & 31, ob = rr * 64 + cc * 2; return st * 1024 + (ob ^ (((ob >> 9) & 1) << 5)); }
__host__ __device__ __forceinline__ void stage_rc(int b, int& R, int& C) { const int st = b / 1024, sb = b % 1024, swz = sb ^ (((sb >> 9) & 1) << 5); R = (st >> 1) * 16 + swz / 64; C = (st & 1) * 32 + (swz % 64) / 2; }
__host__ __device__ __forceinline__ int perm32(int rho) { const int n = rho >> 4, i = rho & 15; return 8 * (i >> 2) + 4 * n + (i & 3); }
struct Unit { int pm, pn; };
struct Gemm { const bf16_t* A; const bf16_t* Bt; int M, N, K; };
struct StaticOrder {
    int nM, nN, nwg, G, c;
    __device__ void init(int M, int N, int G_, int c_) { nM = M / BM; nN = N / BM; nwg = nM * nN; G = G_; c = c_; }
    __device__ bool next(int i, Unit& u) const {
        const long L = (long)i * G + c; if (L >= nwg) return false;
        int wgid = (int)L; { const int q = nwg / NXCD, r = nwg % NXCD, xcd = wgid % NXCD, off = wgid / NXCD; wgid = (xcd < r ? xcd * (q + 1) : r * (q + 1) + (xcd - r) * q) + off; }
        const int nig = WGM * nN, gid = wgid / nig, fm = gid * WGM, gsz = (nM - fm) < WGM ? (nM - fm) : WGM;
        u.pm = fm + ((wgid % nig) % gsz); u.pn = (wgid % nig) / gsz; return true;
    }
};
typedef __bf16 bf16n2 __attribute__((ext_vector_type(2)));
typedef float f32n2 __attribute__((ext_vector_type(2)));
__device__ __forceinline__ unsigned cvt_pk_bf16(float lo, float hi) { const f32n2 v = {lo, hi}; const bf16n2 r = __builtin_convertvector(v, bf16n2); return __builtin_bit_cast(unsigned, r); }

template <class Epi>
__device__ __forceinline__ void gemm_phase(const int wv__, LAS unsigned char* lds, const Gemm g, const StaticOrder& S, const Epi& E) {
    const int tid = otid(), wid = __builtin_amdgcn_readfirstlane(tid >> 6), lane = tid & 63, wr = wid >> 2, wc = wid & 3, fr = lane & 15, fq = lane >> 4;
    const int K = g.K, nt = K / BK;
    unsigned voffA[2], voffB[2];
#pragma unroll
    for (int i = 0; i < 2; ++i) { int R, C; stage_rc(tid * 16 + i * 8192, R, C); const int Rb = Epi::PERM ? ((R & ~31) + perm32(R & 31)) : R;
        voffA[i] = (unsigned)(R * K + C) * 2u; voffB[i] = (unsigned)(Rb * K + C) * 2u; }
    const size_t kstep = (size_t)(BK * 2);
    const size_t hstep = (size_t)HALF * K * 2;
    const size_t tstep = 2 * hstep;
    const unsigned ldsw = (unsigned)wid * 1024u;
    const int aoff = lds_byte(wr * 64 + fr, fq * 8), boff = lds_byte(wc * 32 + fr, fq * 8);
#define PG8_SA(b, h) (((b) * 2 + (h)) * HTB)
#define PG8_SB(b, h) ((4 + (b) * 2 + (h)) * HTB)
#define PG8_STAGE(bufoff, gbase, voff) do { _Pragma("unroll") for (int _i = 0; _i < 2; ++_i) \
        __builtin_amdgcn_global_load_lds((const unsigned*)((const char*)(gbase) + (voff)[_i]), (LAS unsigned*)(lds + (bufoff) + ldsw + _i * 8192), 16, 0, 0); } while (0)
#define PG8_LDA(dst, b, h) do { _Pragma("unroll") for (int m = 0; m < 4; ++m) _Pragma("unroll") for (int k = 0; k < 2; ++k) dst[m][k] = *(const LAS bf16x8*)(lds + PG8_SA(b, h) + aoff + m * 2048 + k * 1024); } while (0)
#define PG8_LDB(dst, b, h) do { _Pragma("unroll") for (int n = 0; n < 2; ++n) _Pragma("unroll") for (int k = 0; k < 2; ++k) dst[n][k] = *(const LAS bf16x8*)(lds + PG8_SB(b, h) + boff + n * 2048 + k * 1024); } while (0)
#define PG8_MMA(ai, bj, At, Bt) do { __builtin_amdgcn_s_setprio(1); _Pragma("unroll") for (int m = 0; m < 4; ++m) _Pragma("unroll") for (int n = 0; n < 2; ++n) _Pragma("unroll") for (int k = 0; k < 2; ++k) \
        acc[ai][bj][m][n] = __builtin_amdgcn_mfma_f32_16x16x32_bf16(Bt[n][k], At[m][k], acc[ai][bj][m][n], 0, 0, 0); __builtin_amdgcn_s_setprio(0); } while (0)
#define PG8_WAIT_V(n) asm volatile("s_waitcnt vmcnt(" #n ")" ::: "memory")
#define PG8_WAIT_L(n) asm volatile("s_waitcnt lgkmcnt(" #n ")" ::: "memory")
#define PG8_BAR __builtin_amdgcn_s_barrier()
#define PG8_SCHED __builtin_amdgcn_sched_barrier(0)
    Unit cur, nxt; int ui = 0;
    if (!S.next(0, cur)) return;
    f32x4 acc[2][2][4][2];
#pragma unroll
    for (int a = 0; a < 2; ++a)
#pragma unroll
        for (int b = 0; b < 2; ++b)
#pragma unroll
            for (int m = 0; m < 4; ++m)
#pragma unroll
                for (int n = 0; n < 2; ++n) acc[a][b][m][n] = (f32x4){0.f, 0.f, 0.f, 0.f};
    bf16x8 At[4][2], B0[2][2], B1[2][2];
    const char* cA = (const char*)g.A + (size_t)cur.pm * tstep; const char* cB = (const char*)g.Bt + (size_t)cur.pn * tstep;
    PG8_STAGE(PG8_SB(0, 0), cB, voffB); PG8_STAGE(PG8_SA(0, 0), cA, voffA); PG8_STAGE(PG8_SB(0, 1), cB + hstep, voffB); PG8_STAGE(PG8_SA(0, 1), cA + hstep, voffA);
    if (wr == 1) PG8_BAR;
    PG8_WAIT_V(4); PG8_BAR;
    PG8_STAGE(PG8_SB(1, 0), cB + kstep, voffB); PG8_STAGE(PG8_SA(1, 0), cA + kstep, voffA); PG8_STAGE(PG8_SB(1, 1), cB + hstep + kstep, voffB);
    PG8_WAIT_V(6); PG8_BAR;
    for (;;) {
        const bool has_next = S.next(ui + 1, nxt);
        const char* nA = has_next ? (const char*)g.A + (size_t)nxt.pm * tstep : cA; const char* nB = has_next ? (const char*)g.Bt + (size_t)nxt.pn * tstep : cB;
#pragma unroll 1
        for (int t = 0; t < nt; t += 2) {
            const bool last = (t == nt - 2);
            const char* a1 = cA + (size_t)(t + 1) * kstep;
            const char* a2 = last ? nA : cA + (size_t)(t + 2) * kstep; const char* b2 = last ? nB : cB + (size_t)(t + 2) * kstep;
            const char* a3 = a2 + kstep; const char* b3 = b2 + kstep;
            PG8_LDB(B0, 0, 0); PG8_SCHED; PG8_LDA(At, 0, 0); PG8_STAGE(PG8_SA(1, 1), a1 + hstep, voffA);
            PG8_WAIT_L(8); PG8_BAR; PG8_WAIT_L(0); PG8_MMA(0, 0, At, B0); PG8_BAR; PG8_SCHED;
            PG8_LDB(B1, 0, 1); PG8_STAGE(PG8_SB(0, 0), b2, voffB);
            PG8_BAR; PG8_WAIT_L(0); PG8_MMA(0, 1, At, B1); PG8_BAR;
            PG8_LDA(At, 0, 1); PG8_STAGE(PG8_SA(0, 0), a2, voffA);
            PG8_BAR; PG8_WAIT_L(0); PG8_MMA(1, 0, At, B0); PG8_BAR; PG8_SCHED;
            PG8_STAGE(PG8_SB(0, 1), b2 + hstep, voffB);
            PG8_WAIT_V(6); PG8_BAR; PG8_MMA(1, 1, At, B1); PG8_BAR;
            PG8_LDB(B0, 1, 0); PG8_SCHED; PG8_LDA(At, 1, 0); PG8_STAGE(PG8_SA(0, 1), a2 + hstep, voffA);
            PG8_WAIT_L(8); PG8_BAR; PG8_WAIT_L(0); PG8_MMA(0, 0, At, B0); PG8_BAR; PG8_SCHED;
            PG8_LDB(B1, 1, 1); PG8_STAGE(PG8_SB(1, 0), b3, voffB);
            PG8_BAR; PG8_WAIT_L(0); PG8_MMA(0, 1, At, B1); PG8_BAR;
            PG8_LDA(At, 1, 1); PG8_STAGE(PG8_SA(1, 0), a3, voffA);
            PG8_BAR; PG8_WAIT_L(0); PG8_MMA(1, 0, At, B0); PG8_BAR; PG8_SCHED;
            PG8_STAGE(PG8_SB(1, 1), b3 + hstep, voffB);
            PG8_WAIT_V(6); PG8_BAR; PG8_MMA(1, 1, At, B1); PG8_BAR;
        }
        E(acc, cur, wr, wc, fr, fq);
        if (!has_next) break;
#pragma unroll
        for (int a = 0; a < 2; ++a)
#pragma unroll
            for (int b = 0; b < 2; ++b)
#pragma unroll
                for (int m = 0; m < 4; ++m)
#pragma unroll
                    for (int n = 0; n < 2; ++n) acc[a][b][m][n] = (f32x4){0.f, 0.f, 0.f, 0.f};
        cur = nxt; cA = nA; cB = nB; ++ui;
    }
    PG8_WAIT_V(0);
    if (wr == 0) PG8_BAR;
    PG8_BAR;
#undef PG8_SA
#undef PG8_SB
#undef PG8_STAGE
#undef PG8_LDA
#undef PG8_LDB
#undef PG8_MMA
#undef PG8_WAIT_V
#undef PG8_WAIT_L
#undef PG8_BAR
#undef PG8_SCHED
}
}
using pg8::cvt_pk_bf16;

constexpr int D = 1024, MP = 65536, MS = 256, MT = MP + MS, FF = 2816;
constexpr int PE = 3840, PO = 3584;
constexpr float EPSF = 1e-6f;
constexpr size_t O_Y = 0;
constexpr size_t O_PSHIFT = (size_t)MT * D;
constexpr size_t O_PRWKV = O_PSHIFT + 8 * 1792;
constexpr size_t O_PCONV = O_PRWKV + 8 * 8 * 64 * 64;
constexpr size_t O_PDELTA = O_PCONV + 8 * 3 * 1536;
constexpr size_t O_PGLA = O_PDELTA + 8 * 4 * 128 * 128;
constexpr size_t O_PRET = O_PGLA + 8 * 4 * 64 * 128;
constexpr size_t O_PMK = O_PRET + 8 * 4 * 128 * 128;
constexpr size_t O_PMV = O_PMK + 2 * 8 * 256 * 1024;
constexpr size_t O_SSHIFT = O_PMV + 2 * 8 * 256 * 1024;
constexpr size_t O_SRWKV = O_SSHIFT + 16 * 1792;
constexpr size_t O_SCONV = O_SRWKV + 16 * 8 * 64 * 64;
constexpr size_t O_SDELTA = O_SCONV + 16 * 3 * 1536;
constexpr size_t O_SGLA = O_SDELTA + 16 * 4 * 128 * 128;
constexpr size_t O_SRET = O_SGLA + 16 * 4 * 64 * 128;
constexpr size_t O_END = O_SRET + 16 * 4 * 128 * 128;
static_assert(O_END == 80631808, "output size");
constexpr size_t al256(size_t x) { return (x + 255) & ~(size_t)255; }
constexpr size_t E_F1U = 0;
constexpr size_t E_F1D = E_F1U + 2ull * 5632 * 1024;
constexpr size_t E_F2U = E_F1D + 2ull * 1024 * 2816;
constexpr size_t E_F2D = E_F2U + 2ull * 5632 * 1024;
constexpr size_t E_EIN = E_F2D + 2ull * 1024 * 2816;
constexpr size_t E_EOUT = E_EIN + 4096ull * 1024;
constexpr size_t E_OIN = E_EOUT + 1024ull * 1024;
constexpr size_t E_OOUT = E_OIN + 3840ull * 1024;
constexpr size_t E_WQ = E_OOUT + 1024ull * 1024;
constexpr size_t E_WO = E_WQ + 2ull * 1024 * 1024;
constexpr size_t E_MKV = E_WO + 2ull * 1024 * 1024;
constexpr size_t E_LR1 = E_MKV + 4096ull * 1024;
constexpr size_t E_LR2 = E_LR1 + 1024ull * 256;
constexpr size_t E_END = E_LR2 + 512ull * 256;
constexpr size_t WS_WT = 0;
constexpr size_t WS_AMEM = al256(WS_WT + E_END * 2);
constexpr size_t WS_SC = al256(WS_AMEM + 2048ull * 1024 * 2);
constexpr size_t WS_BONUS = al256(WS_SC + (size_t)MT * 16 * 4);
constexpr size_t WS_HY = al256(WS_BONUS + (size_t)MT * 8 * 4);
constexpr size_t WS_BIG = al256(WS_HY + (size_t)MT * 1024 * 2);
constexpr size_t WS_LREA = al256(WS_BIG + (size_t)MT * 3840 * 2);
constexpr size_t WS_VBWK = al256(WS_LREA + (size_t)MT * 1024 * 2);
constexpr size_t WS_AP = al256(WS_VBWK + 4160ull * 64 * 256 * 2);
constexpr size_t WS_BAR = al256(WS_AP + (size_t)MT * 256 * 2);
constexpr size_t WS_HALO = al256(WS_BAR + 3456 * 4);
constexpr size_t WS_END = al256(WS_HALO + 8ull * 128 * 3 * 1536 * 2);
constexpr size_t WS_KB = WS_BIG + (size_t)MT * 1024 * 2;
constexpr size_t WS_VTB = WS_KB + 96ull * 256 * 256 * 2;
static_assert(WS_END <= (1ull << 30), "workspace budget");
constexpr int LDS_BYTES = 155648;

struct Args { const float* in[49]; float* out; unsigned char* ws; int ph_lo, ph_hi; };
#define KAS __attribute__((address_space(4)))
__device__ __forceinline__ const float* inptr(int k) { const KAS char* kp = (const KAS char*)__builtin_amdgcn_kernarg_segment_ptr(); return *(const float* const volatile KAS*)(kp + 8 * k); }
__device__ __forceinline__ float* outptr() { const KAS char* kp = (const KAS char*)__builtin_amdgcn_kernarg_segment_ptr(); return *(float* const volatile KAS*)(kp + 8 * 49); }
__device__ __forceinline__ unsigned char* wsptr() { const KAS char* kp = (const KAS char*)__builtin_amdgcn_kernarg_segment_ptr(); return *(unsigned char* const volatile KAS*)(kp + 8 * 50); }

__device__ __forceinline__ float bf2f(bf16_t b) { return __uint_as_float((unsigned)b << 16); }
__device__ __forceinline__ bf16_t f2bf(float f) { return (bf16_t)(cvt_pk_bf16(f, 0.f) & 0xffffu); }
__device__ __forceinline__ float bflo(unsigned w) { return __uint_as_float(w << 16); }
__device__ __forceinline__ float bfhi(unsigned w) { return __uint_as_float(w & 0xffff0000u); }
__device__ __forceinline__ void unpack8(const u32x4 w, float (&f)[8]) { f[0] = bflo(w.x); f[1] = bfhi(w.x); f[2] = bflo(w.y); f[3] = bfhi(w.y); f[4] = bflo(w.z); f[5] = bfhi(w.z); f[6] = bflo(w.w); f[7] = bfhi(w.w); }
__device__ __forceinline__ u32x4 pack8(const float (&f)[8]) { u32x4 w; w.x = cvt_pk_bf16(f[0], f[1]); w.y = cvt_pk_bf16(f[2], f[3]); w.z = cvt_pk_bf16(f[4], f[5]); w.w = cvt_pk_bf16(f[6], f[7]); return w; }
template <int CTRL> __device__ __forceinline__ float dpp_mov(float v) { return __builtin_bit_cast(float, __builtin_amdgcn_update_dpp(0, __builtin_bit_cast(int, v), CTRL, 0xf, 0xf, true)); }
__device__ __forceinline__ float rowsum8(float v) { v += dpp_mov<0xB1>(v); v += dpp_mov<0x4E>(v); v += dpp_mov<0x141>(v); return v; }
__device__ __forceinline__ float rowsum16(float v) { v = rowsum8(v); v += dpp_mov<0x140>(v); return v; }
__device__ __forceinline__ float rowmax16(float v) { v = fmaxf(v, dpp_mov<0xB1>(v)); v = fmaxf(v, dpp_mov<0x4E>(v)); v = fmaxf(v, dpp_mov<0x141>(v)); v = fmaxf(v, dpp_mov<0x140>(v)); return v; }
__device__ __forceinline__ float wave_sum(float v) { v = rowsum16(v); v += __shfl_xor(v, 16); v += __shfl_xor(v, 32); return v; }
__device__ __forceinline__ float sigmoidf_(float x) { return __builtin_amdgcn_rcpf(1.f + __expf(-x)); }
__device__ __forceinline__ float siluf_(float x) { return x * sigmoidf_(x); }
__device__ __forceinline__ float tanhf_(float x) { return 1.f - 2.f * __builtin_amdgcn_rcpf(1.f + __expf(2.f * x)); }
__device__ __forceinline__ float softplusf_(float x) { return fmaxf(x, 0.f) + log1pf(__expf(-fabsf(x))); }
__device__ __forceinline__ void row_info(int row, int& s, int& t) { if (row < MP) { s = row >> 13; t = row & 8191; } else { const int r = row - MP; s = 8 + (r >> 4); t = r & 15; } }
__device__ __forceinline__ int seq_row0(int s) { return s < 8 ? s * 8192 : MP + (s - 8) * 16; }
__device__ __forceinline__ int seq_T(int s) { return s < 8 ? 8192 : 16; }
#define LDS_WAIT() asm volatile("s_waitcnt lgkmcnt(0)" ::: "memory")

__device__ __forceinline__ f32x4 mma_tile(const LAS bf16_t* A, int lda, const LAS bf16_t* B, int ldb, int K, f32x4 acc, int lane) {
    const LAS bf16_t* a = A + (lane & 15) * lda + (lane >> 4) * 8;
    const LAS bf16_t* b = B + (lane & 15) * ldb + (lane >> 4) * 8;
    for (int k = 0; k < K; k += 32) {
        const bf16x8 av = *(const LAS bf16x8*)(a + k), bv = *(const LAS bf16x8*)(b + k);
        acc = __builtin_amdgcn_mfma_f32_16x16x32_bf16(av, bv, acc, 0, 0, 0);
    }
    return acc;
}

struct EpiResid {
    static constexpr bool PERM = false;
    float* X; float scale; bf16_t* XB; bf16_t* RSP;
    __device__ __forceinline__ void operator()(const f32x4 (&acc)[2][2][4][2], const pg8::Unit& u, int wr, int wc, int fr, int fq) const {
        const int row0 = u.pm * 256 + wr * 64 + fr, col0 = u.pn * 256 + wc * 32 + 4 * fq;
#pragma unroll
        for (int ai = 0; ai < 2; ++ai)
#pragma unroll
            for (int m = 0; m < 4; ++m) { const size_t row = (size_t)(row0 + ai * 128 + m * 16); float* rowp = X + row * D + col0; bf16_t* xbp = XB + row * D + col0; float ss = 0.f;
#pragma unroll
                for (int bj = 0; bj < 2; ++bj)
#pragma unroll
                    for (int n = 0; n < 2; ++n) { f32x4* p = (f32x4*)(rowp + bj * 128 + n * 16); const f32x4 v = *p + acc[ai][bj][m][n] * scale; *p = v;
                        ss += (v[0] * v[0] + v[1] * v[1]) + (v[2] * v[2] + v[3] * v[3]);
                        u32x2 w; w.x = cvt_pk_bf16(v[0], v[1]); w.y = cvt_pk_bf16(v[2], v[3]); *(u32x2*)(xbp + bj * 128 + n * 16) = w; }
                ss += __shfl_xor(ss, 16); ss += __shfl_xor(ss, 32);
                if (fq == 0) RSP[row * 16 + u.pn * 4 + wc] = f2bf(ss); }
    }
};
__device__ __forceinline__ float row_rstd(const bf16_t* RSP, size_t row) {
    const u32x4 a = *(const u32x4*)(RSP + row * 16), b = *(const u32x4*)(RSP + row * 16 + 8);
    const float s = ((bflo(a.x) + bfhi(a.x)) + (bflo(a.y) + bfhi(a.y))) + ((bflo(a.z) + bfhi(a.z)) + (bflo(a.w) + bfhi(a.w)))
                  + ((bflo(b.x) + bfhi(b.x)) + (bflo(b.y) + bfhi(b.y))) + ((bflo(b.z) + bfhi(b.z)) + (bflo(b.w) + bfhi(b.w)));
    return rsqrtf(s * (1.f / D) + EPSF);
}
struct EpiSwiglu {
    static constexpr bool PERM = true;
    bf16_t* O; const bf16_t* RSP;
    __device__ __forceinline__ void operator()(const f32x4 (&acc)[2][2][4][2], const pg8::Unit& u, int wr, int wc, int fr, int fq) const {
        const int row0 = u.pm * 256 + wr * 64 + fr, col0 = u.pn * 128 + wc * 32 + 8 * fq;
        float rsv[2][4];
#pragma unroll
        for (int ai = 0; ai < 2; ++ai)
#pragma unroll
            for (int m = 0; m < 4; ++m) rsv[ai][m] = RSP ? row_rstd(RSP, (size_t)(row0 + ai * 128 + m * 16)) : 1.f;
#pragma unroll
        for (int ai = 0; ai < 2; ++ai)
#pragma unroll
            for (int m = 0; m < 4; ++m) {
                float v[8]; const float rs = rsv[ai][m];
#pragma unroll
                for (int n = 0; n < 2; ++n)
#pragma unroll
                    for (int j = 0; j < 4; ++j) v[4 * n + j] = siluf_(acc[ai][0][m][n][j] * rs) * (acc[ai][1][m][n][j] * rs);
                *(u32x4*)(O + (size_t)(row0 + ai * 128 + m * 16) * FF + col0) = pack8(v);
            }
    }
};
struct EpiBf16 {
    static constexpr bool PERM = true;
    bf16_t* O; int ldc; const bf16_t* RSP; float* SCp; int thin_pn;
    __device__ __forceinline__ void operator()(const f32x4 (&acc)[2][2][4][2], const pg8::Unit& u, int wr, int wc, int fr, int fq) const {
        const int row0 = u.pm * 256 + wr * 64 + fr, col0 = u.pn * 256 + wc * 32 + 8 * fq;
        const bool thin = (u.pn == thin_pn);
        float rsv[2][4];
#pragma unroll
        for (int ai = 0; ai < 2; ++ai)
#pragma unroll
            for (int m = 0; m < 4; ++m) rsv[ai][m] = RSP ? row_rstd(RSP, (size_t)(row0 + ai * 128 + m * 16)) : 1.f;
#pragma unroll
        for (int ai = 0; ai < 2; ++ai)
#pragma unroll
            for (int m = 0; m < 4; ++m) { const size_t row = (size_t)(row0 + ai * 128 + m * 16); const float rs = rsv[ai][m];
                if (thin) { if (wc == 0 && fq < 2) { *(f32x4*)(SCp + row * 16 + 8 * fq) = acc[ai][0][m][0] * rs; *(f32x4*)(SCp + row * 16 + 8 * fq + 4) = acc[ai][0][m][1] * rs; } }
                else { bf16_t* rowp = O + row * ldc + col0;
#pragma unroll
                    for (int bj = 0; bj < 2; ++bj) { const f32x4 v0 = acc[ai][bj][m][0] * rs, v1 = acc[ai][bj][m][1] * rs;
                        u32x4 w; w.x = cvt_pk_bf16(v0[0], v0[1]); w.y = cvt_pk_bf16(v0[2], v0[3]); w.z = cvt_pk_bf16(v1[0], v1[1]); w.w = cvt_pk_bf16(v1[2], v1[3]);
                        *(u32x4*)(rowp + bj * 128) = w; } } }
    }
};
struct EpiLR1 {
    static constexpr bool PERM = true;
    bf16_t* O; const float* w0; const float* a0;
    __device__ __forceinline__ void operator()(const f32x4 (&acc)[2][2][4][2], const pg8::Unit& u, int wr, int wc, int fr, int fq) const {
        const int row0 = u.pm * 256 + wr * 64 + fr, col0 = u.pn * 256 + wc * 32 + 8 * fq;
        const float* bias = (u.pn < 2) ? (w0 + col0) : (a0 + col0 - 512); const float sc = (u.pn < 2) ? -0.60653066f : 1.f;
#pragma unroll
        for (int bj = 0; bj < 2; ++bj) {
            const f32x4 b0 = *(const f32x4*)(bias + bj * 128), b1 = *(const f32x4*)(bias + bj * 128 + 4);
#pragma unroll
            for (int ai = 0; ai < 2; ++ai)
#pragma unroll
                for (int m = 0; m < 4; ++m) {
                    float v[8];
#pragma unroll
                    for (int j = 0; j < 4; ++j) { v[j] = sc * sigmoidf_(acc[ai][bj][m][0][j] + b0[j]); v[4 + j] = sc * sigmoidf_(acc[ai][bj][m][1][j] + b1[j]); }
                    *(u32x4*)(O + (size_t)(row0 + ai * 128 + m * 16) * 1024 + col0 + bj * 128) = pack8(v);
                }
        }
    }
};
struct EpiMemKV {
    static constexpr bool PERM = false;
    float* PK;
    __device__ __forceinline__ void operator()(const f32x4 (&acc)[2][2][4][2], const pg8::Unit& u, int wr, int wc, int fr, int fq) const {
        const int t = u.pn >> 2; float* base = PK + (size_t)(t & 1) * (O_PMV - O_PMK) + (size_t)(t >> 1) * (8 * 256 * 1024);
        const int row0 = u.pm * 256 + wr * 64 + fr, col0 = (u.pn & 3) * 256 + wc * 32 + 4 * fq;
#pragma unroll
        for (int ai = 0; ai < 2; ++ai)
#pragma unroll
            for (int m = 0; m < 4; ++m) { float* rowp = base + (size_t)(row0 + ai * 128 + m * 16) * 1024 + col0;
#pragma unroll
                for (int bj = 0; bj < 2; ++bj)
#pragma unroll
                    for (int n = 0; n < 2; ++n) *(f32x4*)(rowp + bj * 128 + n * 16) = acc[ai][bj][m][n]; }
    }
};
template <class Epi> __device__ __forceinline__ void run_gemm(const int wv__, LAS unsigned char* lds, const bf16_t* A, const bf16_t* Bt, int M, int N, int K, const Epi& E) {
    pg8::Gemm g{A, Bt, M, N, K}; pg8::StaticOrder S; S.init(M, N, (int)gridDim.x, (int)blockIdx.x);
    pg8::gemm_phase<Epi>(wv__, lds, g, S, E);
}

__device__ __forceinline__ void cvt_item(const float* W, int ld, int c0, int k0, bf16_t* dst, int K, const float* ks, LAS float* scr, int lane) {
#pragma unroll 8
    for (int i = 0; i < 32; ++i) { const int kk = 2 * i + (lane >> 5); float v = W[(size_t)(k0 + kk) * ld + c0 + (lane & 31)]; if (ks) v *= ks[k0 + kk]; scr[kk * 33 + (lane & 31)] = v; }
    LDS_WAIT();
    const int c = lane & 7;
#pragma unroll
    for (int j = 0; j < 4; ++j) { const int n = (lane >> 3) + 8 * j; const LAS float* s = scr + (8 * c) * 33 + n;
        u32x4 o; o.x = cvt_pk_bf16(s[0 * 33], s[1 * 33]); o.y = cvt_pk_bf16(s[2 * 33], s[3 * 33]); o.z = cvt_pk_bf16(s[4 * 33], s[5 * 33]); o.w = cvt_pk_bf16(s[6 * 33], s[7 * 33]);
        *(u32x4*)(dst + (size_t)n * K + k0 + 8 * c) = o; }
    LDS_WAIT();
}
__device__ __forceinline__ void cvt_seg(const float* W, int ld, int c0, int nc, int K, bf16_t* dst, const float* ks, LAS float* scr, int lane, int gw, int NGW, int& cum) {
    const int nb = nc / 32, n = (K / 64) * nb;
    int it = (gw - (cum % NGW) + NGW) % NGW;
    for (; it < n; it += NGW) { const int kb = it / nb, b = it % nb; cvt_item(W, ld, c0 + 32 * b, 64 * kb, dst + (size_t)(32 * b) * K, K, ks, scr, lane); }
    cum += n;
}
__device__ __forceinline__ void cvt_ffn_up(const float* wg, const float* wu, const float* ks, bf16_t* dst, LAS float* scr, int lane, int gw, int NGW, int& cum) {
    const int n = 2 * 88 * 16;
    int it = (gw - (cum % NGW) + NGW) % NGW;
    for (; it < n; it += NGW) { const int kb = it / 176, r = it % 176, gu = r / 88, cb = r % 88;
        cvt_item(gu ? wu : wg, FF, 32 * cb, 64 * kb, dst + (size_t)((cb >> 2) * 256 + gu * 128 + (cb & 3) * 32) * D, D, ks, scr, lane); }
    cum += n;
}

template <bool FROM_INPUT, int NCOL>
__device__ __forceinline__ void norm_phase(const int wv__, const float* xp, const float* xs, float* X, bf16_t* H, const float* w, const float* Wsm, int ldw, int c0w, float* SC, LAS unsigned char* lds) {
    const int tid = otid(), lane = tid & 63, wave = tid >> 6;
    const int gw = blockIdx.x * 8 + wave, NGW = gridDim.x * 8;
    LAS float* lw = (LAS float*)lds;
    if (NCOL > 0) {
        for (int idx = tid; idx < 1024 * NCOL; idx += 512) { const int k = idx / NCOL, c = idx % NCOL; const int ln = (k >> 2) & 63, j = k >> 8, i = k & 3;
            lw[((((j * 4 + i) * (NCOL / 4) + (c >> 2)) * 64 + ln) << 2) + (c & 3)] = Wsm[(size_t)k * ldw + c0w + c]; }
        __syncthreads();
    }
    f32x4 wv[4];
#pragma unroll
    for (int j = 0; j < 4; ++j) wv[j] = *(const f32x4*)(w + (lane + 64 * j) * 4);
    for (int row = gw; row < MT; row += NGW) {
        const float* src = FROM_INPUT ? (row < MP ? xp + (size_t)row * D : xs + (size_t)(row - MP) * D) : X + (size_t)row * D;
        f32x4 v[4]; float ss = 0.f;
#pragma unroll
        for (int j = 0; j < 4; ++j) { v[j] = *(const f32x4*)(src + (lane + 64 * j) * 4); ss += (v[j][0] * v[j][0] + v[j][1] * v[j][1]) + (v[j][2] * v[j][2] + v[j][3] * v[j][3]); }
        const float rstd = rsqrtf(wave_sum(ss) * (1.f / D) + EPSF);
#pragma unroll
        for (int j = 0; j < 4; ++j) {
            if (FROM_INPUT) *(f32x4*)(X + (size_t)row * D + (lane + 64 * j) * 4) = v[j];
            v[j] = v[j] * rstd * wv[j];
            u32x2 o; o.x = cvt_pk_bf16(v[j][0], v[j][1]); o.y = cvt_pk_bf16(v[j][2], v[j][3]);
            *(u32x2*)(H + (size_t)row * D + (lane + 64 * j) * 4) = o;
        }
        if (NCOL > 0) {
            float part[NCOL > 0 ? NCOL : 1];
#pragma unroll
            for (int c = 0; c < NCOL; ++c) part[c] = 0.f;
#pragma unroll
            for (int j = 0; j < 4; ++j)
#pragma unroll
                for (int i = 0; i < 4; ++i)
#pragma unroll
                    for (int cq = 0; cq < NCOL / 4; ++cq) { const f32x4 ww = *(const LAS f32x4*)(lw + ((((j * 4 + i) * (NCOL / 4) + cq) * 64 + lane) << 2));
#pragma unroll
                        for (int e = 0; e < 4; ++e) part[cq * 4 + e] += v[j][i] * ww[e]; if (cq == NCOL / 4 - 1) asm volatile("" ::: "memory"); }
            float mine = 0.f;
#pragma unroll
            for (int c = 0; c < NCOL; ++c) { const float s = wave_sum(part[c]); if (lane == c) mine = s; }
            if (lane < NCOL) SC[(size_t)row * 16 + lane] = mine;
        }
    }
}

__device__ __forceinline__ void rwkv_prep_phase(const int wv__, const bf16_t* P, bf16_t* AP, bf16_t* HALO) {
    const float* mu = inptr(18); const float* sh0 = inptr(3); float* outp = outptr();
    const int gt = blockIdx.x * 512 + otid(), NT = gridDim.x * 512;
    for (int it = gt; it < MT * 32; it += NT) {
        const int row = it >> 5, c8 = (it & 31) * 8; int s, t; row_info(row, s, t);
        float cur[8], prv[8], o[8];
        unpack8(*(const u32x4*)(P + (size_t)row * PE + 1536 + c8), cur);
        if (t > 0) unpack8(*(const u32x4*)(P + (size_t)(row - 1) * PE + 1536 + c8), prv);
        else {
#pragma unroll
            for (int i = 0; i < 8; ++i) prv[i] = (s >= 8) ? sh0[(size_t)(s - 8) * 1792 + 1536 + c8 + i] : 0.f; }
#pragma unroll
        for (int i = 0; i < 8; ++i) { const float x = cur[i] + (prv[i] - cur[i]) * mu[1536 + c8 + i]; o[i] = (c8 < 64) ? tanhf_(x) : ((c8 < 128) ? x : sigmoidf_(x)); }
        *(u32x4*)(AP + (size_t)row * 256 + c8) = pack8(o);
    }
    for (int it = gt; it < 8 * 128 * 3 * 192; it += NT) { const int ch = it % 192, r = it / 192, j = r % 3, sc = r / 3, c = sc & 127, s = sc >> 7;
        if (c > 0) *(u32x4*)(HALO + (size_t)r * 1536 + ch * 8) = *(const u32x4*)(P + (size_t)(s * 8192 + c * 64 - 3 + j) * PE + 1792 + ch * 8); }
    for (int it = gt; it < 24 * (1792 + 3 * 1536); it += NT) {
        const int s = it / 6400, r = it % 6400; const int T = seq_T(s), r0 = seq_row0(s);
        if (r < 1792) { const float v = bf2f(P[(size_t)(r0 + T - 1) * PE + r]); outp[(s < 8 ? O_PSHIFT + (size_t)s * 1792 : O_SSHIFT + (size_t)(s - 8) * 1792) + r] = v; }
        else { const int q = r - 1792, j = q / 1536, c = q % 1536; const float v = bf2f(P[(size_t)(r0 + T - 3 + j) * PE + 1792 + c]);
            outp[(s < 8 ? O_PCONV + (size_t)s * 4608 : O_SCONV + (size_t)(s - 8) * 4608) + q] = v; }
    }
}

__device__ __forceinline__ void rwkv_scan_phase(const int wv__, const bf16_t* P, const bf16_t* LREA, bf16_t* YC, float* BONUS, LAS unsigned char* lds) {
    const int tid = otid();
    LAS float* L = (LAS float*)lds;
    constexpr int BUFW = 10752;
    LAS float* YB = L + 2 * BUFW;
    const float* mu = inptr(18); const float* kkw = inptr(24); const float* kaw = inptr(25); const float* rkw = inptr(26); const float* sh0 = inptr(3); const float* st_in = inptr(4); float* outp = outptr();
    for (int item = blockIdx.x; item < 768; item += gridDim.x) {
        int s, h, q; if (item < 256) { const int bh = item >> 2; q = item & 3; s = bh >> 3; h = bh & 7; } else { const int i2 = item - 256, bh = i2 >> 2; q = i2 & 3; s = 8 + (bh >> 3); h = bh & 7; }
        const int T = seq_T(s), r0 = seq_row0(s), nch = (T + 31) >> 5;
        const bool comp = tid < 256;
        const int rl = (tid >> 4) & 15, li = tid & 15;
        f32x4 S = (f32x4){0.f, 0.f, 0.f, 0.f};
        float* stout = outp + (s < 8 ? O_PRWKV + ((size_t)(s * 8 + h) * 64 + 16 * q + rl) * 64 : O_SRWKV + ((size_t)((s - 8) * 8 + h) * 64 + 16 * q + rl) * 64) + 4 * li;
        if (comp && s >= 8) S = *(const f32x4*)(st_in + ((size_t)((s - 8) * 8 + h) * 64 + 16 * q + rl) * 64 + 4 * li);
        f32x4 mur, muk, muv, ckk, cka, crk, shr, shk, shv;
        mur = muk = muv = ckk = cka = crk = shr = shk = shv = (f32x4){0.f, 0.f, 0.f, 0.f};
        const int c0 = h * 64 + 4 * li;
        if (!comp) { mur = *(const f32x4*)(mu + c0); muk = *(const f32x4*)(mu + 512 + c0); muv = *(const f32x4*)(mu + 1024 + c0); ckk = *(const f32x4*)(kkw + c0); cka = *(const f32x4*)(kaw + c0); crk = *(const f32x4*)(rkw + c0);
            if (s >= 8) { const float* sh = sh0 + (size_t)(s - 8) * 1792; shr = *(const f32x4*)(sh + c0); shk = *(const f32x4*)(sh + 512 + c0); shv = *(const f32x4*)(sh + 1024 + c0); } }
        u32x2 raw[2][8];
#define RWKV_PREFETCH(cn) do { _Pragma("unroll") for (int ps = 0; ps < 2; ++ps) { const int t = (cn) * 32 + ps * 16 + rl; const bool ok = t < T; const bf16_t* pr = P + (size_t)(r0 + t) * PE + c0; const bf16_t* lr = LREA + (size_t)(r0 + t) * 1024 + c0; \
            const u32x2 z2 = (u32x2){0u, 0u}; \
            raw[ps][0] = ok ? *(const u32x2*)pr : z2; raw[ps][1] = ok ? *(const u32x2*)(pr + 512) : z2; raw[ps][2] = ok ? *(const u32x2*)(pr + 1024) : z2; \
            const bool okp = ok && t > 0; \
            raw[ps][3] = okp ? *(const u32x2*)(pr - PE) : z2; raw[ps][4] = okp ? *(const u32x2*)(pr - PE + 512) : z2; raw[ps][5] = okp ? *(const u32x2*)(pr - PE + 1024) : z2; \
            raw[ps][6] = ok ? *(const u32x2*)lr : z2; raw[ps][7] = ok ? *(const u32x2*)(lr + 512) : z2; } } while (0)
        if (!comp) RWKV_PREFETCH(0);
        for (int c = -1; c < nch; ++c) {
            if (!comp) {
                const int cn = c + 1;
                if (cn < nch) {
                    LAS float* B = L + (cn & 1) * BUFW;
#pragma unroll
                    for (int ps = 0; ps < 2; ++ps) {
                        const int tk = ps * 16 + rl, t = cn * 32 + tk;
                        f32x4 rc, kc, vc, rp, kp, vp, ee, aa;
#define UNPK(dst, w) dst = (f32x4){bflo((w).x), bfhi((w).x), bflo((w).y), bfhi((w).y)}
                        UNPK(rc, raw[ps][0]); UNPK(kc, raw[ps][1]); UNPK(vc, raw[ps][2]); UNPK(rp, raw[ps][3]); UNPK(kp, raw[ps][4]); UNPK(vp, raw[ps][5]); UNPK(ee, raw[ps][6]); UNPK(aa, raw[ps][7]);
#undef UNPK
                        if (t == 0) { rp = shr; kp = shk; vp = shv; }
                        const f32x4 xr = rc + (rp - rc) * mur, xk = kc + (kp - kc) * muk, xv = vc + (vp - vc) * muv;
                        const f32x4 kkv = xk * ckk;
                        const float n2 = rowsum16((kkv[0] * kkv[0] + kkv[1] * kkv[1]) + (kkv[2] * kkv[2] + kkv[3] * kkv[3]));
                        const f32x4 kk = kkv * rsqrtf(n2 + EPSF);
                        const f32x4 kpr = xk * (1.f + (aa - 1.f) * cka);
                        const f32x4 bt = xr * kpr * crk;
                        const float bon = rowsum16((bt[0] + bt[1]) + (bt[2] + bt[3]));
                        const f32x4 w = (f32x4){__expf(ee[0]), __expf(ee[1]), __expf(ee[2]), __expf(ee[3])};
                        *(LAS f32x4*)(B + tk * 64 + 4 * li) = w; *(LAS f32x4*)(B + 2048 + tk * 64 + 4 * li) = kpr; *(LAS f32x4*)(B + 4096 + tk * 64 + 4 * li) = -kk;
                        *(LAS f32x4*)(B + 6144 + tk * 64 + 4 * li) = kk * aa; *(LAS f32x4*)(B + 8192 + tk * 64 + 4 * li) = xr;
                        if ((li >> 2) == q) *(LAS f32x4*)(B + 10240 + tk * 16 + 4 * (li & 3)) = xv;
                        if (q == 0 && li == 0 && t < T) BONUS[(size_t)(r0 + t) * 8 + h] = bon;
                    }
                    if (cn + 1 < nch) RWKV_PREFETCH(cn + 1);
                }
            } else if (c >= 0) {
                const LAS float* B = L + (c & 1) * BUFW; LAS float* yb = YB + (c & 1) * 8192;
                const int nv = min(32, T - c * 32);
#define RWKV_STEP(tt) do { \
                    const f32x4 w = *(const LAS f32x4*)(B + (tt) * 64 + li * 4), kp = *(const LAS f32x4*)(B + 2048 + (tt) * 64 + li * 4), na = *(const LAS f32x4*)(B + 4096 + (tt) * 64 + li * 4), \
                                bb = *(const LAS f32x4*)(B + 6144 + (tt) * 64 + li * 4), rr = *(const LAS f32x4*)(B + 8192 + (tt) * 64 + li * 4); \
                    const float vv = B[10240 + (tt) * 16 + rl]; \
                    float sa = (S[0] * na[0] + S[1] * na[1]) + (S[2] * na[2] + S[3] * na[3]); \
                    const f32x4 tS = S * w + vv * kp; \
                    sa = rowsum16(sa); \
                    S = tS + sa * bb; \
                    yb[((tt) * 16 + rl) * 16 + li] = (S[0] * rr[0] + S[1] * rr[1]) + (S[2] * rr[2] + S[3] * rr[3]); } while (0)
                __builtin_amdgcn_s_setprio(2);
                if (nv == 32) {
#pragma unroll
                    for (int tt = 0; tt < 32; ++tt) RWKV_STEP(tt);
                } else {
                    for (int tt = 0; tt < nv; ++tt) RWKV_STEP(tt);
                }
                __builtin_amdgcn_s_setprio(0);
#undef RWKV_STEP
            }
            __syncthreads();
            if (!comp && c >= 0) {
                const LAS float* yb = YB + (c & 1) * 8192; const int tt = (tid >> 3) & 31, pr2 = tid & 7; const int t = c * 32 + tt;
                if (t < T) { const LAS f32x4* p = (const LAS f32x4*)(yb + (tt * 16 + 2 * pr2) * 16);
                    const f32x4 a0 = p[0], a1 = p[1], a2 = p[2], a3 = p[3], b0 = p[4], b1 = p[5], b2 = p[6], b3 = p[7];
                    const f32x4 sa_ = (a0 + a1) + (a2 + a3), sb_ = (b0 + b1) + (b2 + b3);
                    *(unsigned*)(YC + (size_t)(r0 + t) * 1024 + h * 64 + 16 * q + 2 * pr2) = cvt_pk_bf16((sa_[0] + sa_[1]) + (sa_[2] + sa_[3]), (sb_[0] + sb_[1]) + (sb_[2] + sb_[3])); }
            }
        }
#undef RWKV_PREFETCH
        if (comp) *(f32x4*)stout = S;
        __syncthreads();
    }
}

__device__ __forceinline__ void rwkv_post_phase(const int wv__, const bf16_t* P, const bf16_t* GATE, const float* BONUS, bf16_t* YC) {
    const int lane = otid() & 63, wave = otid() >> 6, gw = blockIdx.x * 8 + wave, NGW = gridDim.x * 8;
    const float* mu = inptr(18); const float* lnw = inptr(27); const float* lnb = inptr(28); const float* sh0 = inptr(3);
    for (int row = gw; row < MT; row += NGW) {
        int s, t; row_info(row, s, t);
#pragma unroll 2
        for (int h = 0; h < 8; ++h) {
            const int c = h * 64 + lane;
            const float y = bf2f(YC[(size_t)row * 1024 + c]);
            const float mean = wave_sum(y) * (1.f / 64.f); const float d = y - mean; const float var = wave_sum(d * d) * (1.f / 64.f);
            const float yn = d * rsqrtf(var + 64e-5f) * lnw[c] + lnb[c];
            const float vc = bf2f(P[(size_t)row * PE + 1024 + c]);
            const float vp = (t > 0) ? bf2f(P[(size_t)(row - 1) * PE + 1024 + c]) : ((s >= 8) ? sh0[(size_t)(s - 8) * 1792 + 1024 + c] : 0.f);
            const float xv = vc + (vp - vc) * mu[1024 + c];
            const float o = (yn + BONUS[(size_t)row * 8 + h] * xv) * bf2f(GATE[(size_t)row * 1024 + c]);
            YC[(size_t)row * 1024 + c] = f2bf(o);
        }
    }
}

__device__ __forceinline__ void delta_conv8(const float* cw, const float* cv0, const bf16_t* P, const bf16_t* HALO, int s, int r0, int T, int t0, int t, int h, int part, int cg, float (&y)[8]) {
    const int ch = part * 512 + h * 128 + cg * 8;
    float acc[8];
#pragma unroll
    for (int i = 0; i < 8; ++i) acc[i] = 0.f;
    const bool ok = t < T;
#pragma unroll
    for (int j = 0; j < 4; ++j) {
        const int tt = t - 3 + j; float x[8];
        if (ok && tt >= t0) unpack8(*(const u32x4*)(P + (size_t)(r0 + tt) * PE + 1792 + ch), x);
        else if (ok && tt >= 0) unpack8(*(const u32x4*)(HALO + ((size_t)(s * 128 + (t0 >> 6)) * 3 + (tt - t0 + 3)) * 1536 + ch), x);
        else if (ok && s >= 8) {
#pragma unroll
            for (int i = 0; i < 8; ++i) x[i] = cv0[((size_t)(s - 8) * 3 + (tt + 3)) * 1536 + ch + i]; }
        else {
#pragma unroll
            for (int i = 0; i < 8; ++i) x[i] = 0.f; }
        const f32x4 w0 = *(const f32x4*)(cw + j * 1536 + ch), w1 = *(const f32x4*)(cw + j * 1536 + ch + 4);
#pragma unroll
        for (int i = 0; i < 4; ++i) { acc[i] += x[i] * w0[i]; acc[4 + i] += x[4 + i] * w1[i]; }
    }
    float ss = 0.f;
#pragma unroll
    for (int i = 0; i < 8; ++i) { y[i] = ok ? siluf_(acc[i]) : 0.f; ss += y[i] * y[i]; }
    if (part < 2) { ss = rowsum16(ss); const float sc = rsqrtf(ss + EPSF) * (part == 0 ? 0.08838834764831845f : 1.f);
#pragma unroll
        for (int i = 0; i < 8; ++i) y[i] *= sc; }
}
__device__ __forceinline__ void delta_gates(const int wv__, float nA, float dtb, float* SC, int r0, int T, int t0, int h, LAS float* GS) {
    const int lane = otid();
    const int t = t0 + lane; float g = 0.f, be = 0.f;
    if (t < T) { const float* sc = SC + (size_t)(r0 + t) * 16; g = nA * softplusf_(sc[h] + dtb); be = sigmoidf_(sc[4 + h]); }
#pragma unroll
    for (int d = 1; d < 64; d <<= 1) { const float o = __shfl_up(g, d); if (lane >= d) g += o; }
    GS[lane] = g; GS[64 + lane] = __expf(g); GS[128 + lane] = be;
    if (t < T) { SC[(size_t)(r0 + t) * 16 + 8 + h] = g; SC[(size_t)(r0 + t) * 16 + 12 + h] = be; }
}
__device__ __forceinline__ void delta_prep_phase(const int wv__, bf16_t* P, const bf16_t* HALO, float* SC, bf16_t* VBWK, LAS unsigned char* lds) {
    const int tid = otid(), lane = tid & 63, wave = tid >> 6;
    LAS bf16_t* Ks = (LAS bf16_t*)lds;
    LAS bf16_t* Vs = Ks + 64 * 136;
    LAS float* Mm = (LAS float*)(lds + 2 * 64 * 136 * 2);
    LAS float* GS = Mm + 64 * 68;
    LAS float* SOL = GS + 192;
    LAS bf16_t* Qs = (LAS bf16_t*)(SOL + 64 * 256);
    const float* cw = inptr(29); const float* cv0 = inptr(5); const float* Alog = inptr(30); const float* dtbp = inptr(31);
    for (int task = blockIdx.x; task < 4160; task += gridDim.x) {
        int s, h, t0; if (task < 4096) { s = task >> 9; h = (task >> 7) & 3; t0 = (task & 127) * 64; } else { const int q = task - 4096; s = 8 + (q >> 2); h = q & 3; t0 = 0; }
        const int T = seq_T(s), r0 = seq_row0(s); const float nA = -__expf(Alog[h]), dtb = dtbp[h];
        if (tid < 64) delta_gates(wv__, nA, dtb, SC, r0, T, t0, h, GS);
#pragma unroll
        for (int it = 0; it < 2; ++it) { const int item = tid + 512 * it, tk = item >> 4, cg = item & 15; float y[8];
            delta_conv8(cw, cv0, P, HALO, s, r0, T, t0, t0 + tk, h, 0, cg, y); *(LAS u32x4*)(Qs + tk * 136 + cg * 8) = pack8(y);
            delta_conv8(cw, cv0, P, HALO, s, r0, T, t0, t0 + tk, h, 1, cg, y); *(LAS u32x4*)(Ks + tk * 136 + cg * 8) = pack8(y);
            delta_conv8(cw, cv0, P, HALO, s, r0, T, t0, t0 + tk, h, 2, cg, y); *(LAS u32x4*)(Vs + tk * 136 + cg * 8) = pack8(y); }
        __syncthreads();
#pragma unroll
        for (int it = 0; it < 2; ++it) { const int item = tid + 512 * it, tk = item >> 4, cg = item & 15;
            if (t0 + tk < T) { bf16_t* pr = P + (size_t)(r0 + t0 + tk) * PE + 1792 + h * 128 + cg * 8;
                *(u32x4*)pr = *(const LAS u32x4*)(Qs + tk * 136 + cg * 8); *(u32x4*)(pr + 512) = *(const LAS u32x4*)(Ks + tk * 136 + cg * 8); } }
#pragma unroll
        for (int i = 0; i < 2; ++i) { const int tile = wave + 8 * i, mi = tile >> 2, ni = tile & 3;
            f32x4 acc = mma_tile(Ks + mi * 16 * 136, 136, Ks + ni * 16 * 136, 136, 128, (f32x4){0.f, 0.f, 0.f, 0.f}, lane);
            const int m = ni * 16 + (lane & 15);
#pragma unroll
            for (int j = 0; j < 4; ++j) { const int l = mi * 16 + (lane >> 4) * 4 + j; Mm[l * 68 + m] = (l > m) ? GS[128 + l] * acc[j] * __expf(GS[l] - GS[m]) : 0.f; } }
        __syncthreads();
        if (tid < 256) {
            const int c = tid;
            for (int l = 0; l < 64; ++l) {
                float r = (c < 128) ? GS[128 + l] * bf2f(Vs[l * 136 + c]) : GS[128 + l] * GS[64 + l] * bf2f(Ks[l * 136 + (c - 128)]);
                const LAS float* Mr = Mm + l * 68;
                int m = 0;
                for (; m + 4 <= l; m += 4) { const f32x4 mv = *(const LAS f32x4*)(Mr + m);
                    r -= (mv[0] * SOL[m * 256 + c] + mv[1] * SOL[(m + 1) * 256 + c]) + (mv[2] * SOL[(m + 2) * 256 + c] + mv[3] * SOL[(m + 3) * 256 + c]); }
                for (; m < l; ++m) r -= Mr[m] * SOL[m * 256 + c];
                SOL[l * 256 + c] = r;
            }
            bf16_t* o = VBWK + (size_t)task * (64 * 256) + c;
            for (int l = 0; l < 64; ++l) o[l * 256] = f2bf(SOL[l * 256 + c]);
        }
        __syncthreads();
    }
}
__device__ __forceinline__ void delta_seq_phase(const int wv__, const bf16_t* P, const float* SC, const bf16_t* VBWK, bf16_t* SLOT, LAS unsigned char* lds) {
    const int tid = otid(), lane = tid & 63, wave = tid >> 6;
    LAS bf16_t* ST = (LAS bf16_t*)lds;
    LAS bf16_t* Wk = ST + 32 * 136;
    LAS bf16_t* Vb = Wk + 64 * 136;
    LAS bf16_t* KdT = Vb + 64 * 40;
    LAS bf16_t* UT = KdT + 128 * 72;
    LAS float* GS = (LAS float*)(UT + 32 * 72);
    const int r16 = lane & 15, q4 = (lane >> 4) * 4;
    const float* Alog = inptr(30); const float* dtbp = inptr(31); const float* dst0 = inptr(6); float* outp = outptr();
    for (int task = blockIdx.x; task < 384; task += gridDim.x) {
        const int hv = task & 3, sh = task >> 2;
        const int s = sh < 32 ? (sh >> 2) : 8 + ((sh - 32) >> 2), h = sh & 3;
        const int T = seq_T(s), r0 = seq_row0(s), nch = (T + 63) >> 6; const float nA = -__expf(Alog[h]), dtb = dtbp[h];
        f32x4 accS[2];
        const float* st0 = dst0 + (size_t)((s - 8) * 4 + h) * 128 * 128;
#pragma unroll
        for (int i = 0; i < 2; ++i) {
#pragma unroll
            for (int j = 0; j < 4; ++j) accS[i][j] = (s >= 8) ? st0[(size_t)(wave * 16 + q4 + j) * 128 + hv * 32 + i * 16 + r16] : 0.f;
            { u32x2 w; w.x = cvt_pk_bf16(accS[i][0], accS[i][1]); w.y = cvt_pk_bf16(accS[i][2], accS[i][3]); *(LAS u32x2*)(ST + (i * 16 + r16) * 136 + wave * 16 + q4) = w; }
        }
        u32x4 Rk[2], vbr[3]; float gsc = 0.f, bsc = 0.f;
#define DQ_LOAD(cc) do { const int t0n = (cc) * 64; const int vt_ = s < 8 ? (s * 4 + h) * 128 + (cc) : 4096 + (s - 8) * 4 + h; \
            _Pragma("unroll") for (int it = 0; it < 2; ++it) { const int item = tid + 512 * it, tk = item & 63, cg = item >> 6; \
                Rk[it] = (t0n + tk < T) ? *(const u32x4*)(P + (size_t)(r0 + t0n + tk) * PE + 1792 + 512 + h * 128 + cg * 8) : (u32x4){0u, 0u, 0u, 0u}; } \
            { const bf16_t* src = VBWK + (size_t)vt_ * (64 * 256); _Pragma("unroll") for (int it = 0; it < 3; ++it) { const int idx = tid + 512 * it, l = idx / 20, ch = idx % 20; \
                if (idx < 1280) vbr[it] = *(const u32x4*)(src + l * 256 + (ch < 4 ? hv * 4 + ch : 12 + ch) * 8); } } \
            if (tid < 64) { const int t = t0n + tid; gsc = 0.f; bsc = 0.f; if (t < T) { const float* sc = SC + (size_t)(r0 + t) * 16; gsc = sc[8 + h]; bsc = sc[12 + h]; } } \
            } while (0)
        DQ_LOAD(0);
        __syncthreads();
        for (int c = 0; c < nch; ++c) {
            const int tid = otid(), lane = tid & 63, wave = tid >> 6, r16 = lane & 15, q4 = (lane >> 4) * 4;
            if (tid < 64) {
                const int nv = min(64, T - c * 64); float g = gsc; const float gl_ = __shfl(g, nv - 1); if (tid >= nv) g = gl_;
                GS[tid] = g; GS[64 + tid] = __expf(g); GS[128 + tid] = bsc;
            }
#pragma unroll
            for (int it = 0; it < 3; ++it) { const int idx = tid + 512 * it, l = idx / 20, ch = idx % 20;
                if (idx < 1280) { if (ch < 4) *(LAS u32x4*)(Vb + l * 40 + ch * 8) = vbr[it]; else *(LAS u32x4*)(Wk + l * 136 + (ch - 4) * 8) = vbr[it]; } }
            if (s < 8) { bf16_t* dst = SLOT + (size_t)((s * 4 + h) * 128 + c) * 16384 + (size_t)(hv * 32) * 128;
                const int r = tid >> 4, ch = tid & 15; *(u32x4*)(dst + r * 128 + ch * 8) = *(const LAS u32x4*)(ST + r * 136 + ch * 8); }
            __syncthreads();
            const float Glast = GS[63];
#pragma unroll
            for (int it = 0; it < 2; ++it) { const int item = tid + 512 * it, tk = item & 63, cg = item >> 6; float y[8]; unpack8(Rk[it], y);
                const float kd = __expf(Glast - GS[tk]);
#pragma unroll
                for (int i = 0; i < 8; ++i) KdT[(cg * 8 + i) * 72 + tk] = f2bf(y[i] * kd); }
            if (c + 1 < nch) DQ_LOAD(c + 1);
            { const int mi = wave >> 1, ni = wave & 1;
                const f32x4 wst = mma_tile(Wk + mi * 16 * 136, 136, ST + ni * 16 * 136, 136, 128, (f32x4){0.f, 0.f, 0.f, 0.f}, lane);
                const int dv = ni * 16 + r16; float u[4];
#pragma unroll
                for (int j = 0; j < 4; ++j) { const int l = mi * 16 + q4 + j; u[j] = bf2f(Vb[l * 40 + dv]) - wst[j]; }
                u32x2 w; w.x = cvt_pk_bf16(u[0], u[1]); w.y = cvt_pk_bf16(u[2], u[3]);
                *(LAS u32x2*)(UT + dv * 72 + mi * 16 + q4) = w; }
            __syncthreads();
            const float gl = __expf(Glast);
#pragma unroll
            for (int i = 0; i < 2; ++i) accS[i] = mma_tile(KdT + wave * 16 * 72, 72, UT + i * 16 * 72, 72, 64, accS[i] * gl, lane);
#pragma unroll
            for (int i = 0; i < 2; ++i) { u32x2 w; w.x = cvt_pk_bf16(accS[i][0], accS[i][1]); w.y = cvt_pk_bf16(accS[i][2], accS[i][3]); *(LAS u32x2*)(ST + (i * 16 + r16) * 136 + wave * 16 + q4) = w; }
            __syncthreads();
        }
#undef DQ_LOAD
        float* so = outp + (s < 8 ? O_PDELTA + (size_t)(s * 4 + h) * 16384 : O_SDELTA + (size_t)((s - 8) * 4 + h) * 16384);
#pragma unroll
        for (int i = 0; i < 2; ++i)
#pragma unroll
            for (int j = 0; j < 4; ++j) so[(size_t)(wave * 16 + q4 + j) * 128 + hv * 32 + i * 16 + r16] = accS[i][j];
        __syncthreads();
    }
}
__device__ __forceinline__ void delta_out_phase(const int wv__, const bf16_t* P, const float* SC, const bf16_t* VBWK, const bf16_t* SLOT, bf16_t* YC, LAS unsigned char* lds) {
    LAS bf16_t* ST = (LAS bf16_t*)lds;
    LAS bf16_t* Qs = ST + 128 * 136;
    LAS bf16_t* Ks = Qs + 64 * 136;
    LAS bf16_t* Wk = Ks + 64 * 136;
    LAS bf16_t* Vb = Wk + 64 * 136;
    LAS bf16_t* UT = Vb + 64 * 136;
    LAS bf16_t* QKm = UT + 128 * 72;
    LAS float* GS = (LAS float*)(QKm + 64 * 72);
    LAS float* Ob = (LAS float*)Wk;
    const float* Alog = inptr(30); const float* dtbp = inptr(31); const float* dnw = inptr(32); const float* dst0 = inptr(6);
    for (int task = blockIdx.x; task < 4160; task += gridDim.x) {
        const int tid = otid(), lane = tid & 63, wave = tid >> 6, r16 = lane & 15, q4 = (lane >> 4) * 4, el = tid >> 3, ecb = (tid & 7) * 16;
        int s, h, c; if (task < 4096) { s = task >> 9; h = (task >> 7) & 3; c = task & 127; } else { const int q = task - 4096; s = 8 + (q >> 2); h = q & 3; c = 0; }
        const int T = seq_T(s), r0 = seq_row0(s), t0 = c * 64; const float nA = -__expf(Alog[h]), dtb = dtbp[h];
        u32x4 zr0 = (u32x4){0u, 0u, 0u, 0u}, zr1 = zr0;
        { const int t = t0 + el; if (t < T) { const bf16_t* p = P + (size_t)(r0 + t) * PE + 3328 + h * 128 + ecb; zr0 = *(const u32x4*)p; zr1 = *(const u32x4*)(p + 8); } }
        if (s < 8) { const bf16_t* src = SLOT + (size_t)task * 16384;
#pragma unroll
            for (int it = 0; it < 4; ++it) { const int idx = tid + 512 * it, r = idx >> 4, ch = idx & 15; *(LAS u32x4*)(ST + r * 136 + ch * 8) = *(const u32x4*)(src + r * 128 + ch * 8); } }
        else { const float* st0 = dst0 + (size_t)((s - 8) * 4 + h) * 128 * 128;
            for (int idx = tid; idx < 128 * 128; idx += 512) { const int dk = idx >> 7, dv = idx & 127; ST[dv * 136 + dk] = f2bf(st0[idx]); } }
#pragma unroll
        for (int it = 0; it < 2; ++it) { const int item = tid + 512 * it, tk = item >> 4, cg = item & 15; const bool ok = t0 + tk < T;
            const bf16_t* pr = P + (size_t)(r0 + t0 + tk) * PE + 1792 + h * 128 + cg * 8;
            *(LAS u32x4*)(Qs + tk * 136 + cg * 8) = ok ? *(const u32x4*)pr : (u32x4){0u, 0u, 0u, 0u}; *(LAS u32x4*)(Ks + tk * 136 + cg * 8) = ok ? *(const u32x4*)(pr + 512) : (u32x4){0u, 0u, 0u, 0u}; }
        { const bf16_t* src = VBWK + (size_t)task * (64 * 256);
#pragma unroll
          for (int it = 0; it < 4; ++it) { const int idx = tid + 512 * it, l = idx >> 5, ch = idx & 31; const u32x4 v = *(const u32x4*)(src + l * 256 + ch * 8);
              if (ch < 16) *(LAS u32x4*)(Vb + l * 136 + ch * 8) = v; else *(LAS u32x4*)(Wk + l * 136 + (ch - 16) * 8) = v; } }
        if (tid < 64) {
            const int t = t0 + tid; float g = 0.f, be = 0.f; const int nv = min(64, T - t0);
            if (t < T) { const float* sc = SC + (size_t)(r0 + t) * 16; g = sc[8 + h]; be = sc[12 + h]; }
            const float gl_ = __shfl(g, nv - 1); if (tid >= nv) g = gl_;
            GS[tid] = g; GS[64 + tid] = __expf(g); GS[128 + tid] = be;
        }
        __syncthreads();
        f32x4 accO[4], wst[4], qkt[2];
#pragma unroll
        for (int i = 0; i < 4; ++i) {
            wst[i] = mma_tile(Wk + i * 16 * 136, 136, ST + wave * 16 * 136, 136, 128, (f32x4){0.f, 0.f, 0.f, 0.f}, lane);
            accO[i] = mma_tile(Qs + i * 16 * 136, 136, ST + wave * 16 * 136, 136, 128, (f32x4){0.f, 0.f, 0.f, 0.f}, lane); }
#pragma unroll
        for (int i = 0; i < 2; ++i) { const int tile = wave + 8 * i, mi = tile >> 2, ni = tile & 3;
            qkt[i] = mma_tile(Qs + mi * 16 * 136, 136, Ks + ni * 16 * 136, 136, 128, (f32x4){0.f, 0.f, 0.f, 0.f}, lane); }
#pragma unroll
        for (int i = 0; i < 4; ++i) {
            const int dv = wave * 16 + r16; float u[4];
#pragma unroll
            for (int j = 0; j < 4; ++j) { const int l = i * 16 + q4 + j; u[j] = bf2f(Vb[l * 136 + dv]) - wst[i][j]; accO[i][j] *= GS[64 + l]; }
            u32x2 w; w.x = cvt_pk_bf16(u[0], u[1]); w.y = cvt_pk_bf16(u[2], u[3]);
            *(LAS u32x2*)(UT + dv * 72 + i * 16 + q4) = w;
        }
#pragma unroll
        for (int i = 0; i < 2; ++i) { const int tile = wave + 8 * i, mi = tile >> 2, ni = tile & 3; const int m = ni * 16 + r16;
#pragma unroll
            for (int j = 0; j < 4; ++j) { const int l = mi * 16 + q4 + j; QKm[l * 72 + m] = f2bf((m <= l) ? qkt[i][j] * __expf(GS[l] - GS[m]) : 0.f); } }
        __syncthreads();
#pragma unroll
        for (int i = 0; i < 4; ++i) accO[i] = mma_tile(QKm + i * 16 * 72, 72, UT + wave * 16 * 72, 72, 64, accO[i], lane);
#pragma unroll
        for (int i = 0; i < 4; ++i)
#pragma unroll
            for (int j = 0; j < 4; ++j) Ob[(i * 16 + q4 + j) * 132 + wave * 16 + r16] = accO[i][j];
        __syncthreads();
        { const int l = el, cb = ecb, t = t0 + l; float o[16], ss = 0.f;
#pragma unroll
          for (int i = 0; i < 4; ++i) { const f32x4 v = *(const LAS f32x4*)(Ob + l * 132 + cb + 4 * i); o[4 * i] = v[0]; o[4 * i + 1] = v[1]; o[4 * i + 2] = v[2]; o[4 * i + 3] = v[3]; ss += (v[0] * v[0] + v[1] * v[1]) + (v[2] * v[2] + v[3] * v[3]); }
          ss = rowsum8(ss); const float rstd = rsqrtf(ss * (1.f / 128.f) + EPSF);
          if (t < T) { const size_t row = (size_t)(r0 + t); float z[16], r[16];
              unpack8(zr0, *(float(*)[8])&z[0]); unpack8(zr1, *(float(*)[8])&z[8]);
#pragma unroll
              for (int i = 0; i < 16; ++i) r[i] = o[i] * rstd * dnw[cb + i] * siluf_(z[i]);
              *(u32x4*)(YC + row * 1024 + 512 + h * 128 + cb) = pack8(*(float(*)[8])&r[0]); *(u32x4*)(YC + row * 1024 + 512 + h * 128 + cb + 8) = pack8(*(float(*)[8])&r[8]); } }
        __syncthreads();
    }
}

template <int DK, bool RET, int MODE>
__device__ __forceinline__ void lin_chunk_task(const int wv__, const bf16_t* P, const float* SC, bf16_t* YC, bf16_t* SBUF, float* DECB, LAS unsigned char* lds, int s, int h, int c) {
    const int tid = otid(), lane = tid & 63, wave = tid >> 6;
    constexpr int LQ = DK + 8, NTK = DK / 16, NS = (8 * NTK) / 8;
    LAS bf16_t* ST = (LAS bf16_t*)lds;
    LAS bf16_t* Qi = ST + 128 * LQ;
    LAS bf16_t* Ki = Qi + 64 * LQ;
    LAS bf16_t* KoT = Ki + 64 * LQ;
    LAS bf16_t* VT = KoT + DK * 72;
    LAS bf16_t* Sc = VT + 128 * 72;
    LAS float* Ob = (LAS float*)(Sc + 64 * 72);
    LAS float* TOT = Ob + 64 * 132;
    const int r16 = lane & 15, q4 = (lane >> 4) * 4;
    const int T = seq_T(s), r0 = seq_row0(s);
    const int slot = s < 8 ? (s * 4 + h) * 128 + c : 4096 + (s - 8) * 4 + h;
    bf16_t* sb = SBUF + (size_t)slot * (DK * 128);
    const int qoff = RET ? 1536 + h * 128 : h * 64, koff = RET ? 2048 + h * 128 : 256 + h * 64, voff = RET ? 2560 + h * 128 : 512 + h * 128, goff = RET ? 3072 + h * 128 : 1024 + h * 128;
    const float lg = RET ? __logf(1.f - exp2f(-5.f - (float)h)) : 0.f;
    const int pc = tid & 63, tg = tid >> 6;
    const int vdv = tid & 127, vtg = tid >> 7;
    const int t0 = c * 64; const int nvalid = min(64, T - t0);
    unsigned qr[8], kr[8], vr[8];
#pragma unroll
    for (int i = 0; i < 8; ++i) { const int tk = tg * 8 + i; unsigned a_ = 0u, b_ = 0u;
        if (tk < nvalid) { const bf16_t* p = P + (size_t)(r0 + t0 + tk) * PO;
            if (RET) { if (MODE == 3) a_ = (unsigned)p[qoff + pc] | ((unsigned)p[qoff + 64 + pc] << 16); b_ = (unsigned)p[koff + pc] | ((unsigned)p[koff + 64 + pc] << 16); }
            else { a_ = (MODE == 3 ? (unsigned)p[qoff + pc] : 0u) | ((unsigned)p[koff + pc] << 16); } }
        qr[i] = a_; kr[i] = b_; }
#pragma unroll
    for (int i = 0; i < 8; ++i) { const int tk = vtg * 16 + 2 * i; unsigned a_ = 0u;
        if (tk < nvalid) a_ = (unsigned)P[(size_t)(r0 + t0 + tk) * PO + voff + vdv];
        if (tk + 1 < nvalid) a_ |= (unsigned)P[(size_t)(r0 + t0 + tk + 1) * PO + voff + vdv] << 16;
        vr[i] = a_; }
    if (MODE == 3) {
#pragma unroll
        for (int it = 0; it < (128 * DK / 8) / 512; ++it) { const int idx = tid + 512 * it, r = idx / (DK / 8), ch = idx % (DK / 8);
            *(LAS u32x4*)(ST + r * LQ + ch * 8) = *(const u32x4*)(sb + r * DK + ch * 8); }
    }
    *(LAS u32x4*)(VT + vdv * 72 + vtg * 16) = (u32x4){vr[0], vr[1], vr[2], vr[3]}; *(LAS u32x4*)(VT + vdv * 72 + vtg * 16 + 8) = (u32x4){vr[4], vr[5], vr[6], vr[7]};
    if (!RET) {
        const int ch = pc; float la[8], run = 0.f;
        const float* a2p = inptr(35); const float abias = inptr(36)[h * 64 + ch];
        float a2c[16];
#pragma unroll
        for (int r = 0; r < 16; ++r) a2c[r] = a2p[r * 256 + h * 64 + ch];
#pragma unroll
        for (int i = 0; i < 8; ++i) { const int tk = tg * 8 + i; float x = 0.f;
            if (tk < nvalid) { const float* sc = SC + (size_t)(r0 + t0 + tk) * 16; float z = abias;
#pragma unroll
                for (int r4 = 0; r4 < 4; ++r4) { const f32x4 sv = *(const f32x4*)(sc + r4 * 4); z += (sv[0] * a2c[r4 * 4] + sv[1] * a2c[r4 * 4 + 1]) + (sv[2] * a2c[r4 * 4 + 2] + sv[3] * a2c[r4 * 4 + 3]); }
                x = -softplusf_(-z) * (1.f / 16.f); }
            run += x; la[i] = run; }
        TOT[tg * 64 + ch] = run;
        __syncthreads();
        float pre = 0.f, tot = 0.f;
#pragma unroll
        for (int g = 0; g < 8; ++g) { const float v = TOT[g * 64 + ch]; tot += v; if (g < tg) pre += v; }
        if (MODE == 1 && tg == 0) DECB[(size_t)slot * 64 + ch] = __expf(tot);
        float ko[8];
#pragma unroll
        for (int i = 0; i < 8; ++i) { const int tk = tg * 8 + i; const float cum = la[i] + pre; const float qv = bflo(qr[i]) * 0.125f, kv = bfhi(qr[i]);
            if (MODE == 3) { Qi[tk * LQ + ch] = f2bf(qv * __expf(cum)); Ki[tk * LQ + ch] = f2bf(kv * __expf(-cum)); }
            else ko[i] = kv * __expf(tot - cum); }
        if (MODE == 1) *(LAS u32x4*)(KoT + ch * 72 + tg * 8) = pack8(ko);
    } else {
        const int pi = pc;
        const float inv = exp2f(-(float)pi * (13.287712379549449f / 64.f));
        const float tot = (float)nvalid * lg;
        float ko1[8], ko2[8];
#pragma unroll
        for (int i = 0; i < 8; ++i) { const int tk = tg * 8 + i;
            const float cum = (float)min(tk + 1, nvalid) * lg;
            const float x1 = bflo(qr[i]), x2 = bfhi(qr[i]), y1 = bflo(kr[i]), y2 = bfhi(kr[i]);
            const float pos = (float)(t0 + tk + (s >= 8 ? 1024 : 0)); const float rev = pos * inv * 0.15915494309189535f; const float fr = rev - floorf(rev);
            const float sn = __builtin_amdgcn_sinf(fr), cs = __builtin_amdgcn_cosf(fr);
            const float k1 = (y1 * cs - y2 * sn) * 0.08838834764831845f, k2 = (y1 * sn + y2 * cs) * 0.08838834764831845f;
            if (MODE == 3) { const float q1 = x1 * cs - x2 * sn, q2 = x1 * sn + x2 * cs; const float ei = __expf(cum), eo = __expf(-cum);
                Qi[tk * LQ + pi] = f2bf(q1 * ei); Qi[tk * LQ + 64 + pi] = f2bf(q2 * ei); Ki[tk * LQ + pi] = f2bf(k1 * eo); Ki[tk * LQ + 64 + pi] = f2bf(k2 * eo); }
            else { const float ek = __expf(tot - cum); ko1[i] = k1 * ek; ko2[i] = k2 * ek; } }
        if (MODE == 1) { *(LAS u32x4*)(KoT + pi * 72 + tg * 8) = pack8(ko1); *(LAS u32x4*)(KoT + (64 + pi) * 72 + tg * 8) = pack8(ko2); }
    }
    __syncthreads();
    if (MODE == 1) {
        f32x4 accS[NS];
#pragma unroll
        for (int i = 0; i < NS; ++i) { const int tile = wave + 8 * i, mi = tile / NTK, ni = tile % NTK;
            accS[i] = mma_tile(KoT + ni * 16 * 72, 72, VT + mi * 16 * 72, 72, 64, (f32x4){0.f, 0.f, 0.f, 0.f}, lane); }
#pragma unroll
        for (int i = 0; i < NS; ++i) { const int tile = wave + 8 * i, mi = tile / NTK, ni = tile % NTK;
            u32x2 w; w.x = cvt_pk_bf16(accS[i][0], accS[i][1]); w.y = cvt_pk_bf16(accS[i][2], accS[i][3]);
            *(u32x2*)(sb + (mi * 16 + r16) * DK + ni * 16 + q4) = w; }
        __syncthreads();
        return;
    }
    const int el = tid >> 3, ecb = (tid & 7) * 16;
    u32x4 zr0 = (u32x4){0u, 0u, 0u, 0u}, zr1 = zr0;
    { const int t = t0 + el; if (t < T) { const bf16_t* p = P + (size_t)(r0 + t) * PO + goff + ecb; zr0 = *(const u32x4*)p; zr1 = *(const u32x4*)(p + 8); } }
    f32x4 accO[4];
#pragma unroll
    for (int i = 0; i < 4; ++i) accO[i] = mma_tile(Qi + i * 16 * LQ, LQ, ST + wave * 16 * LQ, LQ, DK, (f32x4){0.f, 0.f, 0.f, 0.f}, lane);
    f32x4 sct[2];
#pragma unroll
    for (int i = 0; i < 2; ++i) { const int tile = wave + 8 * i, mi = tile >> 2, ni = tile & 3;
        sct[i] = mma_tile(Qi + mi * 16 * LQ, LQ, Ki + ni * 16 * LQ, LQ, DK, (f32x4){0.f, 0.f, 0.f, 0.f}, lane); }
#pragma unroll
    for (int i = 0; i < 2; ++i) { const int tile = wave + 8 * i, mi = tile >> 2, ni = tile & 3; const int m = ni * 16 + r16;
#pragma unroll
        for (int j = 0; j < 4; ++j) { const int l = mi * 16 + q4 + j; Sc[l * 72 + m] = f2bf((m <= l) ? sct[i][j] : 0.f); } }
    __syncthreads();
#pragma unroll
    for (int i = 0; i < 4; ++i) accO[i] = mma_tile(Sc + i * 16 * 72, 72, VT + wave * 16 * 72, 72, 64, accO[i], lane);
#pragma unroll
    for (int i = 0; i < 4; ++i)
#pragma unroll
        for (int j = 0; j < 4; ++j) Ob[(i * 16 + q4 + j) * 132 + wave * 16 + r16] = accO[i][j];
    __syncthreads();
    { const int l = el, cb = ecb, t = t0 + l; float o[16], sm = 0.f;
#pragma unroll
      for (int i = 0; i < 4; ++i) { const f32x4 v = *(const LAS f32x4*)(Ob + l * 132 + cb + 4 * i); o[4 * i] = v[0]; o[4 * i + 1] = v[1]; o[4 * i + 2] = v[2]; o[4 * i + 3] = v[3]; sm += (v[0] + v[1]) + (v[2] + v[3]); }
      float mean = 0.f;
      if (RET) { mean = rowsum8(sm) * (1.f / 128.f); }
      float ss = 0.f;
#pragma unroll
      for (int i = 0; i < 16; ++i) { o[i] -= mean; ss += o[i] * o[i]; }
      ss = rowsum8(ss); const float rstd = rsqrtf(ss * (1.f / 128.f) + EPSF);
      if (t < T) { const size_t row = (size_t)(r0 + t); float z[16], r[16]; const float* gnw = inptr(37);
          unpack8(zr0, *(float(*)[8])&z[0]); unpack8(zr1, *(float(*)[8])&z[8]);
#pragma unroll
          for (int i = 0; i < 16; ++i) r[i] = o[i] * rstd * (RET ? 1.f : gnw[cb + i]) * siluf_(z[i]);
          bf16_t* dst = YC + row * 1024 + (RET ? 512 : 0) + h * 128 + cb;
          *(u32x4*)dst = pack8(*(float(*)[8])&r[0]); *(u32x4*)(dst + 8) = pack8(*(float(*)[8])&r[8]); } }
    __syncthreads();
}
template <int MODE>
__device__ __forceinline__ void odd_chunk_phase(const int wv__, const bf16_t* P, const float* SC, bf16_t* YC, bf16_t* SR, bf16_t* SG, float* DECB, LAS unsigned char* lds) {
    for (int task = blockIdx.x; task < 8320; task += gridDim.x) {
        if (task < 4096) lin_chunk_task<128, true, MODE>(wv__, P, SC, YC, SR, DECB, lds, task >> 9, (task >> 7) & 3, task & 127);
        else if (task < 8192) { const int q = task - 4096; lin_chunk_task<64, false, MODE>(wv__, P, SC, YC, SG, DECB, lds, q >> 9, (q >> 7) & 3, q & 127); }
        else if (task < 8256) { const int q = task - 8192; lin_chunk_task<128, true, MODE>(wv__, P, SC, YC, SR, DECB, lds, 8 + (q >> 2), q & 3, 0); }
        else { const int q = task - 8256; lin_chunk_task<64, false, MODE>(wv__, P, SC, YC, SG, DECB, lds, 8 + (q >> 2), q & 3, 0); }
    }
}
__device__ __forceinline__ void lin_state_scan(const int wv__, bf16_t* SR, bf16_t* SG, const float* DECB) {
    const int gt = blockIdx.x * 512 + otid(), NT = gridDim.x * 512;
    const float* gin = inptr(7); const float* rin = inptr(8); float* outp = outptr();
    for (int it = gt; it < 96 * 2048 + 96 * 1024; it += NT) {
        const bool ret = it < 96 * 2048; const int q = ret ? it : it - 96 * 2048;
        const int DKc = ret ? 128 : 64, per = ret ? 2048 : 1024;
        const int sh = q / per, e = q % per; const int dv = e / (DKc / 8), dk0 = (e % (DKc / 8)) * 8;
        const int s = sh < 32 ? (sh >> 2) : 8 + ((sh - 32) >> 2), h = sh & 3;
        const int nch = s < 8 ? 128 : 1;
        const int slot0 = s < 8 ? (s * 4 + h) * 128 : 4096 + (s - 8) * 4 + h;
        bf16_t* sb = (ret ? SR : SG) + (size_t)slot0 * (DKc * 128) + dv * DKc + dk0;
        float S[8];
        if (s >= 8) { const float* st = (ret ? rin : gin) + (size_t)((s - 8) * 4 + h) * DKc * 128;
#pragma unroll
            for (int i = 0; i < 8; ++i) S[i] = st[(size_t)(dk0 + i) * 128 + dv]; }
        else {
#pragma unroll
            for (int i = 0; i < 8; ++i) S[i] = 0.f; }
        const float dret = ret ? __expf(64.f * __logf(1.f - exp2f(-5.f - (float)h))) : 0.f;
        const float dret1 = ret ? __expf(16.f * __logf(1.f - exp2f(-5.f - (float)h))) : 0.f;
        for (int c0 = 0; c0 < nch; c0 += 8) {
            u32x4 d[8]; f32x4 dcA[8], dcB[8];
#pragma unroll
            for (int u = 0; u < 8; ++u) if (c0 + u < nch) { d[u] = *(const u32x4*)(sb + (size_t)(c0 + u) * (DKc * 128));
                if (!ret) { const float* dp = DECB + (size_t)(slot0 + c0 + u) * 64 + dk0; dcA[u] = *(const f32x4*)dp; dcB[u] = *(const f32x4*)(dp + 4); } }
#pragma unroll
            for (int u = 0; u < 8; ++u) if (c0 + u < nch) {
                float dd[8]; unpack8(d[u], dd);
                *(u32x4*)(sb + (size_t)(c0 + u) * (DKc * 128)) = pack8(S);
#pragma unroll
                for (int i = 0; i < 8; ++i) { const float dec = ret ? (s < 8 ? dret : dret1) : (i < 4 ? dcA[u][i] : dcB[u][i - 4]); S[i] = S[i] * dec + dd[i]; } }
        }
        float* so = outp + (ret ? (s < 8 ? O_PRET + (size_t)(s * 4 + h) * 16384 : O_SRET + (size_t)((s - 8) * 4 + h) * 16384)
                                : (s < 8 ? O_PGLA + (size_t)(s * 4 + h) * 8192 : O_SGLA + (size_t)((s - 8) * 4 + h) * 8192));
#pragma unroll
        for (int i = 0; i < 8; ++i) so[(size_t)(dk0 + i) * 128 + dv] = S[i];
    }
}

__device__ __forceinline__ void kv_convert(const int wv__, int layer, bf16_t* KB, bf16_t* VTB, LAS unsigned char* lds) {
    const int tid = otid(), lane = tid & 63, wave = tid >> 6;
    const int gt = blockIdx.x * 512 + tid, NT = gridDim.x * 512;
    const float* outp = outptr(); const float* ck = inptr(9); const float* cv = inptr(10);
    for (int it = gt; it < 96 * 256 * 256; it += NT) {
        const int sh = it >> 16, r = it & 65535; const int s = sh >> 2, h = sh & 3;
        const float* kb = s < 8 ? outp + O_PMK + (size_t)layer * 2097152 + (size_t)s * 262144 : ck + (size_t)layer * 4194304 + (size_t)(s - 8) * 262144;
        const int mem = r >> 8, hd = r & 255; KB[it] = f2bf(kb[(size_t)mem * 1024 + h * 256 + hd]);
    }
    LAS float* scr = (LAS float*)(lds + wave * 8704);
    const int gw = blockIdx.x * 8 + wave, NGW = gridDim.x * 8;
    for (int it = gw; it < 96 * 32; it += NGW) { const int sh = it >> 5, r = it & 31, kb = r >> 3, nb = r & 7; const int s = sh >> 2, h = sh & 3;
        const float* vb = (s < 8 ? outp + O_PMV + (size_t)layer * 2097152 + (size_t)s * 262144 : cv + (size_t)layer * 4194304 + (size_t)(s - 8) * 262144) + h * 256;
        cvt_item(vb, 1024, 32 * nb, 64 * kb, VTB + (size_t)sh * 65536 + (size_t)(32 * nb) * 256, 256, nullptr, scr, lane); }
}
__device__ __forceinline__ void attn_phase(const int wv__, const bf16_t* Q, const bf16_t* KB, const bf16_t* VTB, bf16_t* O, LAS unsigned char* lds) {
    const int tid = otid(), lane = tid & 63, wave = tid >> 6, r16 = lane & 15, q4 = (lane >> 4) * 4;
    LAS bf16_t* QP = (LAS bf16_t*)lds;
    LAS bf16_t* KV = QP + 128 * 264;
    for (int unit = blockIdx.x; unit < 2112; unit += gridDim.x) {
        int s, h, row_base, nrows;
        if (unit < 2048) { s = unit >> 8; h = (unit >> 6) & 3; row_base = s * 8192 + (unit & 63) * 128; nrows = 128; } else { const int q = unit - 2048; s = 8 + (q >> 2); h = q & 3; row_base = MP + (s - 8) * 16; nrows = 16; }
        const bf16_t* kb = KB + (size_t)(s * 4 + h) * 65536; const bf16_t* vt = VTB + (size_t)(s * 4 + h) * 65536;
#pragma unroll
        for (int it = 0; it < 8; ++it) { const int idx = tid + 512 * it, r = idx >> 5, ch = idx & 31;
            u32x4 v = (u32x4){0u, 0u, 0u, 0u}; if (r < nrows) v = *(const u32x4*)(Q + (size_t)(row_base + r) * 1024 + h * 256 + ch * 8);
            *(LAS u32x4*)(QP + r * 264 + ch * 8) = v; }
        f32x4 accS[16];
#pragma unroll
        for (int hf = 0; hf < 2; ++hf) {
#pragma unroll
            for (int it = 0; it < 8; ++it) { const int idx = tid + 512 * it, r = idx >> 5, ch = idx & 31; *(LAS u32x4*)(KV + r * 264 + ch * 8) = *(const u32x4*)(kb + (size_t)(hf * 128 + r) * 256 + ch * 8); }
            __syncthreads();
#pragma unroll
            for (int ni = 0; ni < 8; ++ni) accS[hf * 8 + ni] = mma_tile(QP + wave * 16 * 264, 264, KV + ni * 16 * 264, 264, 256, (f32x4){0.f, 0.f, 0.f, 0.f}, lane);
            __syncthreads();
        }
        float mx[4], sm[4];
#pragma unroll
        for (int j = 0; j < 4; ++j) { float m = accS[0][j];
#pragma unroll
            for (int ni = 1; ni < 16; ++ni) m = fmaxf(m, accS[ni][j]);
            mx[j] = rowmax16(m); sm[j] = 0.f; }
#pragma unroll
        for (int ni = 0; ni < 16; ++ni)
#pragma unroll
            for (int j = 0; j < 4; ++j) { const float p = __expf((accS[ni][j] - mx[j]) * 0.0625f); accS[ni][j] = p; sm[j] += p; }
#pragma unroll
        for (int j = 0; j < 4; ++j) sm[j] = __builtin_amdgcn_rcpf(rowsum16(sm[j]));
#pragma unroll
        for (int ni = 0; ni < 16; ++ni)
#pragma unroll
            for (int j = 0; j < 4; ++j) QP[(wave * 16 + q4 + j) * 264 + ni * 16 + r16] = f2bf(accS[ni][j] * sm[j]);
        f32x4 accO[16];
#pragma unroll
        for (int ni = 0; ni < 16; ++ni) accO[ni] = (f32x4){0.f, 0.f, 0.f, 0.f};
#pragma unroll
        for (int hf = 0; hf < 2; ++hf) {
#pragma unroll
            for (int it = 0; it < 8; ++it) { const int idx = tid + 512 * it, r = idx >> 4, ch = idx & 15; *(LAS u32x4*)(KV + r * 136 + ch * 8) = *(const u32x4*)(vt + (size_t)r * 256 + hf * 128 + ch * 8); }
            __syncthreads();
#pragma unroll
            for (int ni = 0; ni < 16; ++ni) accO[ni] = mma_tile(QP + wave * 16 * 264 + hf * 128, 264, KV + ni * 16 * 136, 136, 128, accO[ni], lane);
            __syncthreads();
        }
#pragma unroll
        for (int ni = 0; ni < 16; ++ni)
#pragma unroll
            for (int j = 0; j < 4; ++j) { const int r = wave * 16 + q4 + j; if (r < nrows) O[(size_t)(row_base + r) * 1024 + h * 256 + ni * 16 + r16] = f2bf(accO[ni][j]); }
    }
}

__device__ __forceinline__ void prologue_phase(const int wv__, bf16_t* WT, bf16_t* AMEM, LAS unsigned char* lds) {
    const int tid = otid(), lane = tid & 63, wave = tid >> 6, gw = blockIdx.x * 8 + wave, NGW = gridDim.x * 8;
    LAS float* scr = (LAS float*)(lds + wave * 8704);
    int cum = 0;
    for (int l = 0; l < 2; ++l) {
        cvt_ffn_up(inptr(12) + (size_t)l * D * FF, inptr(13) + (size_t)l * D * FF, nullptr, WT + E_F1U + (size_t)l * 5632 * 1024, scr, lane, gw, NGW, cum);
        cvt_seg(inptr(14) + (size_t)l * FF * D, D, 0, D, FF, WT + E_F1D + (size_t)l * 1024 * 2816, nullptr, scr, lane, gw, NGW, cum);
        cvt_ffn_up(inptr(45) + (size_t)l * D * FF, inptr(46) + (size_t)l * D * FF, nullptr, WT + E_F2U + (size_t)l * 5632 * 1024, scr, lane, gw, NGW, cum);
        cvt_seg(inptr(47) + (size_t)l * FF * D, D, 0, D, FF, WT + E_F2D + (size_t)l * 1024 * 2816, nullptr, scr, lane, gw, NGW, cum);
        cvt_seg(inptr(40) + (size_t)l * D * D, D, 0, D, D, WT + E_WQ + (size_t)l * D * D, inptr(38) + l * D, scr, lane, gw, NGW, cum);
        cvt_seg(inptr(43) + (size_t)l * D * D, D, 0, D, D, WT + E_WO + (size_t)l * D * D, nullptr, scr, lane, gw, NGW, cum);
        cvt_seg(inptr(41) + (size_t)l * D * D, D, 0, D, D, WT + E_MKV + (size_t)(2 * l) * D * D, inptr(39) + l * D, scr, lane, gw, NGW, cum);
        cvt_seg(inptr(42) + (size_t)l * D * D, D, 0, D, D, WT + E_MKV + (size_t)(2 * l + 1) * D * D, inptr(39) + l * D, scr, lane, gw, NGW, cum);
    }
    cvt_seg(inptr(16), 3848, 0, 1792, D, WT + E_EIN, inptr(15), scr, lane, gw, NGW, cum);
    cvt_seg(inptr(16), 3848, 1792, 1536, D, WT + E_EIN + 1792ull * D, inptr(15), scr, lane, gw, NGW, cum);
    cvt_seg(inptr(16), 3848, 3336, 512, D, WT + E_EIN + 3328ull * D, inptr(15), scr, lane, gw, NGW, cum);
    cvt_seg(inptr(17), D, 0, D, D, WT + E_EOUT, nullptr, scr, lane, gw, NGW, cum);
    cvt_seg(inptr(33), 3600, 0, 1024, D, WT + E_OIN, inptr(15) + D, scr, lane, gw, NGW, cum);
    cvt_seg(inptr(33), 3600, 1040, 2560, D, WT + E_OIN + 1024ull * D, inptr(15) + D, scr, lane, gw, NGW, cum);
    cvt_seg(inptr(34), D, 0, D, D, WT + E_OOUT, nullptr, scr, lane, gw, NGW, cum);
    const int gt = blockIdx.x * 512 + tid, NTH = gridDim.x * 512;
    const float* w2p = inptr(20); const float* a2p = inptr(22); const float* g2p = inptr(23);
    for (int i = gt; i < 1024 * 256; i += NTH) { const int n = i >> 8, k = i & 255; float v = 0.f;
        if (n < 512) { if (k < 64) v = w2p[(size_t)k * 512 + n]; } else { if (k >= 64 && k < 128) v = a2p[(size_t)(k - 64) * 512 + (n - 512)]; }
        WT[E_LR1 + i] = f2bf(v); }
    for (int i = gt; i < 512 * 256; i += NTH) { const int n = i >> 8, k = i & 255; WT[E_LR2 + i] = f2bf(k >= 128 ? g2p[(size_t)(k - 128) * 512 + n] : 0.f); }
    { const float* we = inptr(16); const float* wo = inptr(33); const float* nm = inptr(15);
      for (int i = gt; i < 256 * 1024; i += NTH) { const int n = i >> 10, k = i & 1023;
          WT[E_EIN + 3840ull * D + i] = f2bf(n < 8 ? we[(size_t)k * 3848 + 3328 + n] * nm[k] : 0.f);
          WT[E_OIN + 3584ull * D + i] = f2bf(n < 16 ? wo[(size_t)k * 3600 + 1024 + n] * nm[D + k] : 0.f); } }
    const float* memp = inptr(2);
    for (int row = gw; row < 2048; row += NGW) {
        const float* src = memp + (size_t)row * D; f32x4 v[4]; float ss = 0.f;
#pragma unroll
        for (int j = 0; j < 4; ++j) { v[j] = *(const f32x4*)(src + (lane + 64 * j) * 4); ss += (v[j][0] * v[j][0] + v[j][1] * v[j][1]) + (v[j][2] * v[j][2] + v[j][3] * v[j][3]); }
        const float rstd = rsqrtf(wave_sum(ss) * (1.f / D) + EPSF);
#pragma unroll
        for (int j = 0; j < 4; ++j) { u32x2 o; o.x = cvt_pk_bf16(v[j][0] * rstd, v[j][1] * rstd); o.y = cvt_pk_bf16(v[j][2] * rstd, v[j][3] * rstd); *(u32x2*)(AMEM + (size_t)row * D + (lane + 64 * j) * 4) = o; }
    }
}
__device__ __forceinline__ void norm_xb_phase(const int wv__, const bf16_t* XBp, const bf16_t* RSPp, bf16_t* H, const float* w) {
    const int lane = otid() & 63, wave = otid() >> 6, gw = blockIdx.x * 8 + wave, NGW = gridDim.x * 8;
    f32x4 wv[4];
#pragma unroll
    for (int j = 0; j < 4; ++j) wv[j] = *(const f32x4*)(w + lane * 16 + j * 4);
    for (int row = gw; row < MT; row += NGW) {
        const u32x4 a = *(const u32x4*)(XBp + (size_t)row * D + lane * 16), b = *(const u32x4*)(XBp + (size_t)row * D + lane * 16 + 8);
        const float rs = row_rstd(RSPp, (size_t)row);
        float x[16], o[16]; unpack8(a, *(float(*)[8])&x[0]); unpack8(b, *(float(*)[8])&x[8]);
#pragma unroll
        for (int i = 0; i < 16; ++i) o[i] = x[i] * rs * wv[i >> 2][i & 3];
        *(u32x4*)(H + (size_t)row * D + lane * 16) = pack8(*(float(*)[8])&o[0]); *(u32x4*)(H + (size_t)row * D + lane * 16 + 8) = pack8(*(float(*)[8])&o[8]);
    }
}
__device__ __forceinline__ void final_norm_phase(const int wv__, float* X, const float* w) {
    const int lane = otid() & 63, wave = otid() >> 6, gw = blockIdx.x * 8 + wave, NGW = gridDim.x * 8;
    f32x4 wv[4];
#pragma unroll
    for (int j = 0; j < 4; ++j) wv[j] = *(const f32x4*)(w + (lane + 64 * j) * 4);
    for (int row = gw; row < MT; row += NGW) {
        float* p = X + (size_t)row * D; f32x4 v[4]; float ss = 0.f;
#pragma unroll
        for (int j = 0; j < 4; ++j) { v[j] = *(const f32x4*)(p + (lane + 64 * j) * 4); ss += (v[j][0] * v[j][0] + v[j][1] * v[j][1]) + (v[j][2] * v[j][2] + v[j][3] * v[j][3]); }
        const float rstd = rsqrtf(wave_sum(ss) * (1.f / D) + EPSF);
#pragma unroll
        for (int j = 0; j < 4; ++j) *(f32x4*)(p + (lane + 64 * j) * 4) = v[j] * rstd * wv[j];
    }
}

#define XB_TMO      128
#define XB_XCNT(j)  (256  + 64 * (j))
#define XB_XSUB(j)  (1280 + 64 * (j))
#define XB_XGEN(j)  (2304 + 64 * (j))
#define XB_TOP      3328
#define XB_TOPGEN   3392
#define XCD_BAR_WORDS 3456
#define XB_SPIN_CAP (1u << 21)

__device__ __forceinline__ unsigned xb_ld(unsigned* p)              { return __hip_atomic_load(p, __ATOMIC_RELAXED, __HIP_MEMORY_SCOPE_AGENT); }
__device__ __forceinline__ unsigned xb_add(unsigned* p, unsigned v) { return __hip_atomic_fetch_add(p, v, __ATOMIC_RELAXED, __HIP_MEMORY_SCOPE_AGENT); }
__device__ __forceinline__ unsigned xb_xcc_id() { return (unsigned)__builtin_amdgcn_s_getreg((3 << 11) | 20) & 0xFu; }
#define XB_SPIN(cond, bar) do { unsigned _sp = 0; while (cond) { __builtin_amdgcn_s_sleep(4); \
    if ((++_sp & 255u) == 0u) { if (xb_ld(&(bar)[XB_TMO])) break; if (_sp > XB_SPIN_CAP) { atomicAdd(&(bar)[XB_TMO], 1u); break; } } } } while (0)

struct XcdBarrier {
    unsigned* bar; unsigned x;
    volatile LAS unsigned* st;
};

__device__ __forceinline__ XcdBarrier xcd_barrier_post(unsigned* bar, volatile LAS unsigned* st) {
    XcdBarrier b; b.bar = bar; b.x = xb_xcc_id(); b.st = st;
    if (threadIdx.x == 0) (void)xb_add(&bar[XB_XCNT(b.x)], 1u);
    return b;
}
__device__ __forceinline__ void xcd_barrier_complete(unsigned* bar, unsigned x, unsigned& nloc, unsigned& nx) {
    const unsigned G = gridDim.x * gridDim.y * gridDim.z;
    unsigned sum, cnt, mine, sp = 0u;
    for (;;) {
        sum = 0u; cnt = 0u; mine = 0u;
#pragma unroll
        for (unsigned j = 0; j < 16; ++j) { const unsigned c = xb_ld(&bar[XB_XCNT(j)]); sum += c; cnt += (c > 0u) ? 1u : 0u; mine = (j == x) ? c : mine; }
        if (sum == G) break;
        __builtin_amdgcn_s_sleep(4);
        if ((++sp & 255u) == 0u) { if (xb_ld(&bar[XB_TMO])) break; if (sp > XB_SPIN_CAP) { atomicAdd(&bar[XB_TMO], 1u); break; } }
    }
    nloc = mine > 0u ? mine : 1u; nx = cnt > 0u ? cnt : 1u;
}

__device__ __forceinline__ void xcd_barrier(const XcdBarrier& b) {
    asm volatile("s_waitcnt vmcnt(0)" ::: "memory");
    __syncthreads();
    if (threadIdx.x == 0) {
        unsigned* bar = b.bar;
        __builtin_amdgcn_s_waitcnt(0);
        unsigned nloc = b.st[0], nx = b.st[1];
        if (nloc == 0u) { xcd_barrier_complete(bar, b.x, nloc, nx); b.st[0] = nloc; b.st[1] = nx; }
        const unsigned old = xb_add(&bar[XB_XSUB(b.x)], 1u);
        const unsigned gen = old / nloc;
        if (old + 1u == (gen + 1u) * nloc) {
            __builtin_amdgcn_fence(__ATOMIC_RELEASE, "agent");
            asm volatile("s_waitcnt vmcnt(0)" ::: "memory");
            const unsigned og = xb_add(&bar[XB_TOP], 1u);
            const unsigned tg = og / nx;
            if (og + 1u == (tg + 1u) * nx) xb_add(&bar[XB_TOPGEN], 1u);
            else XB_SPIN(xb_ld(&bar[XB_TOPGEN]) == tg, bar);
            __builtin_amdgcn_fence(__ATOMIC_ACQUIRE, "agent");
            xb_add(&bar[XB_XGEN(b.x)], 1u);
            asm volatile("s_waitcnt vmcnt(0)" ::: "memory");
        } else {
            XB_SPIN(xb_ld(&bar[XB_XGEN(b.x)]) == gen, bar);
            __builtin_amdgcn_fence(__ATOMIC_ACQUIRE, "agent");
            asm volatile("s_waitcnt vmcnt(0)" ::: "memory");
        }
    }
    __syncthreads();
}

#define WT ((bf16_t*)(wsptr() + WS_WT))
#define AMEM ((bf16_t*)(wsptr() + WS_AMEM))
#define SC ((float*)(wsptr() + WS_SC))
#define BONUS ((float*)(wsptr() + WS_BONUS))
#define HY ((bf16_t*)(wsptr() + WS_HY))
#define BIG ((bf16_t*)(wsptr() + WS_BIG))
#define LREA ((bf16_t*)(wsptr() + WS_LREA))
#define VBWK ((bf16_t*)(wsptr() + WS_VBWK))
#define AP ((bf16_t*)(wsptr() + WS_AP))
#define KB ((bf16_t*)(wsptr() + WS_KB))
#define VTB ((bf16_t*)(wsptr() + WS_VTB))
#define X (outptr())
#ifndef SITE_MASK
#define SITE_MASK 0xffffffffffffffffull
#endif
#ifndef DUP_MASK
#define DUP_MASK 0ull
#endif
#define GSYNC() do { if (ph == lo + 1) { grid.sync(); bar = xcd_barrier_post((unsigned*)(wsptr() + WS_BAR), (volatile LAS unsigned*)(lds + LDS_BYTES - 16)); } else xcd_barrier(bar); } while (0)
#define PHASE(...) do { if (ph >= lo && ph < hi) { if (ph > lo) GSYNC(); { __VA_ARGS__ } if ((DUP_MASK >> ph) & 1ull) { xcd_barrier(bar); { __VA_ARGS__ } } } ++ph; } while (0)

#define XB LREA
#define RSP ((bf16_t*)(wsptr() + WS_BONUS))
template <int l> __device__ __forceinline__ void layer_phases(const int wv__, cg::grid_group& grid, XcdBarrier& bar, int& ph, const int lo, const int hi, LAS unsigned char* lds) {
        if (l == 0) PHASE({ { EpiMemKV E{outptr() + O_PMK}; run_gemm(wv__, lds, AMEM, WT + E_MKV, 2048, 4096, D, E); }
                            EpiSwiglu E{BIG, nullptr}; run_gemm(wv__, lds, HY, WT + E_F1U, MT, 5632, D, E); });
        else { PHASE({ norm_xb_phase(wv__, XB, RSP, HY, inptr(11) + l * D); });
               PHASE({ EpiSwiglu E{BIG, nullptr}; run_gemm(wv__, lds, HY, WT + E_F1U + (size_t)l * 5632 * 1024, MT, 5632, D, E); }); }
        PHASE({ EpiResid E{X, 0.5f, XB, RSP}; run_gemm(wv__, lds, BIG, WT + E_F1D + (size_t)l * 1024 * 2816, MT, D, FF, E); });
        if (l == 0) {
            PHASE({ EpiBf16 E{BIG, PE, RSP, SC, 15}; run_gemm(wv__, lds, XB, WT + E_EIN, MT, PE + 256, D, E); });
            PHASE({ rwkv_prep_phase(wv__, BIG, AP, (bf16_t*)(wsptr() + WS_HALO)); });
            PHASE({ { EpiLR1 E{LREA, inptr(19), inptr(21)}; run_gemm(wv__, lds, AP, WT + E_LR1, MT, 1024, 256, E); }
                    { EpiBf16 E{HY + 512, 1024, nullptr, nullptr, -1}; run_gemm(wv__, lds, AP, WT + E_LR2, MT, 512, 256, E); }
                    delta_prep_phase(wv__, BIG, (const bf16_t*)(wsptr() + WS_HALO), SC, VBWK, lds); });
            PHASE({ rwkv_scan_phase(wv__, BIG, LREA, HY, BONUS, lds); });
            PHASE({ rwkv_post_phase(wv__, BIG, HY + 512, BONUS, HY); delta_seq_phase(wv__, BIG, SC, VBWK, LREA, lds); });
            PHASE({ delta_out_phase(wv__, BIG, SC, VBWK, LREA, HY, lds); });
            PHASE({ EpiResid E{X, 1.f, XB, RSP}; run_gemm(wv__, lds, HY, WT + E_EOUT, MT, D, D, E); });
        } else {
            PHASE({ EpiBf16 E{BIG, PO, RSP, SC, 14}; run_gemm(wv__, lds, XB, WT + E_OIN, MT, PO + 256, D, E); });
            PHASE({ odd_chunk_phase<1>(wv__, BIG, SC, HY, VBWK, LREA, (float*)AP, lds); });
            PHASE({ lin_state_scan(wv__, VBWK, LREA, (const float*)AP); });
            PHASE({ odd_chunk_phase<3>(wv__, BIG, SC, HY, VBWK, LREA, (float*)AP, lds); });
            PHASE({ EpiResid E{X, 1.f, XB, RSP}; run_gemm(wv__, lds, HY, WT + E_OOUT, MT, D, D, E); });
        }
        PHASE({ kv_convert(wv__, l, KB, VTB, lds); __syncthreads(); EpiBf16 E{BIG, 1024, RSP, nullptr, -1}; run_gemm(wv__, lds, XB, WT + E_WQ + (size_t)l * D * D, MT, D, D, E); });
        PHASE({ attn_phase(wv__, BIG, KB, VTB, HY, lds); });
        PHASE({ EpiResid E{X, 1.f, XB, RSP}; run_gemm(wv__, lds, HY, WT + E_WO + (size_t)l * D * D, MT, D, D, E); });
        PHASE({ norm_xb_phase(wv__, XB, RSP, HY, inptr(44) + l * D); });
        PHASE({ EpiSwiglu E{BIG, nullptr}; run_gemm(wv__, lds, HY, WT + E_F2U + (size_t)l * 5632 * 1024, MT, 5632, D, E); });
        PHASE({ EpiResid E{X, 0.5f, XB, RSP}; run_gemm(wv__, lds, BIG, WT + E_F2D + (size_t)l * 1024 * 2816, MT, D, FF, E); });
}
constexpr int NPHASE = 31;
__global__ void __launch_bounds__(512, 2) hybrid_fwd(Args a) {
    extern __shared__ __attribute__((aligned(16))) unsigned char lds_raw[];
    LAS unsigned char* lds = (LAS unsigned char*)lds_raw;
    cg::grid_group grid = cg::this_grid();
    const int wv__ = __builtin_amdgcn_readfirstlane((int)(threadIdx.x >> 6));
    const int lo = a.ph_lo, hi = a.ph_hi;
    int ph = 0;
    if (threadIdx.x < 4) ((LAS unsigned*)(lds + LDS_BYTES - 16))[threadIdx.x] = 0u;
    if (blockIdx.x == 0) { unsigned* bw = (unsigned*)(wsptr() + WS_BAR); for (int i = threadIdx.x; i < 3456; i += 512) bw[i] = 0u; }
    __syncthreads();
    XcdBarrier bar; bar.bar = nullptr; bar.x = 0; bar.st = nullptr;
    PHASE({ prologue_phase(wv__, WT, AMEM, lds); __syncthreads(); norm_phase<true, 0>(wv__, inptr(0), inptr(1), X, HY, inptr(11), nullptr, 0, 0, nullptr, lds); });
#ifdef TEST_ORDER
    PHASE({ if (blockIdx.x == 0) { const long long t0 = wall_clock64(); while (wall_clock64() - t0 < 300000) __builtin_amdgcn_s_sleep(64);
            float* xo = X; for (int i = otid(); i < 1024; i += 512) xo[i] = 1.0f; } });
    PHASE({ float* xo = X; const float v = ((volatile float*)xo)[0] + 1.0f; const int gt = blockIdx.x * 512 + otid(); for (size_t i = 1024 + gt; i < (size_t)MT * 1024; i += (size_t)gridDim.x * 512) xo[i] = v; });
    return;
#endif
    layer_phases<0>(wv__, grid, bar, ph, lo, hi, lds);
    layer_phases<1>(wv__, grid, bar, ph, lo, hi, lds);
#ifdef EXTRA_SYNCS
    for (int i = 0; i < EXTRA_SYNCS; ++i) grid.sync();
#endif
    PHASE({ final_norm_phase(wv__, X, inptr(48)); });
#undef PHASE
}

extern "C" void kernel_launch(void* const* d_in, const int* in_sizes, int n_in, void* d_out, int out_size, void* d_ws, size_t ws_size, hipStream_t stream) {
    static int grid = 0;
    if (grid == 0) {
        int dev = 0, cus = 0, per_cu = 0;
        hipGetDevice(&dev);
        hipDeviceGetAttribute(&cus, hipDeviceAttributeMultiprocessorCount, dev);
        if (hipFuncSetAttribute((const void*)hybrid_fwd, hipFuncAttributeMaxDynamicSharedMemorySize, LDS_BYTES) != hipSuccess) fprintf(stderr, "kernel_launch: hipFuncSetAttribute failed\n");
        if (hipOccupancyMaxActiveBlocksPerMultiprocessor(&per_cu, (const void*)hybrid_fwd, 512, LDS_BYTES) != hipSuccess || per_cu < 1) { fprintf(stderr, "kernel_launch: occupancy query says %d\n", per_cu); per_cu = 1; }
        (void)hipGetLastError();
        grid = cus > 0 ? cus : 256;
        if (n_in != 49 || (size_t)out_size != O_END || ws_size < WS_END) fprintf(stderr, "kernel_launch: unexpected sizes n_in %d out %d ws %zu (need %zu)\n", n_in, out_size, ws_size, (size_t)WS_END);
    }
#ifdef DBG_MEMSET
    (void)hipMemsetAsync(d_ws, 0, WS_END, stream);
#endif
    Args a{};
    for (int i = 0; i < 49; ++i) a.in[i] = (const float*)d_in[i];
    a.out = (float*)d_out; a.ws = (unsigned char*)d_ws;
#ifndef N_LAUNCH_PER_PHASE
    a.ph_lo = 0; a.ph_hi = NPHASE;
    void* args[] = {&a};
    hipError_t e = hipLaunchCooperativeKernel((const void*)hybrid_fwd, dim3(grid), dim3(512), args, LDS_BYTES, stream);
    if (e != hipSuccess) fprintf(stderr, "cooperative launch failed: %s (grid %d)\n", hipGetErrorString(e), grid);
#else
#ifndef PH_STOP
#define PH_STOP NPHASE
#endif
    for (int p = 0; p < PH_STOP; ++p) {
        a.ph_lo = p; a.ph_hi = p + 1;
        void* args[] = {&a};
        hipError_t e = hipLaunchCooperativeKernel((const void*)hybrid_fwd, dim3(grid), dim3(512), args, LDS_BYTES, stream);
        if (e != hipSuccess) { fprintf(stderr, "cooperative launch %d failed: %s (grid %d)\n", p, hipGetErrorString(e), grid); break; }
    }
#endif
}
```

```cpp
#include <hip/hip_runtime.h>
#include <hip/hip_cooperative_groups.h>
#include <cstdio>
#include <cstdint>
namespace cg = cooperative_groups;

#define LAS __attribute__((address_space(3)))
typedef unsigned short bf16_t;
typedef short bf16x8 __attribute__((ext_vector_type(8)));
typedef float f32x4 __attribute__((ext_vector_type(4)));
typedef float f32x2 __attribute__((ext_vector_type(2)));
typedef unsigned u32x4 __attribute__((ext_vector_type(4)));
typedef unsigned u32x2 __attribute__((ext_vector_type(2)));

#define otid() otid_(wv__)
__device__ __forceinline__ int otid_(int wv) { int t = (wv << 6) | (int)__builtin_amdgcn_mbcnt_hi(~0u, __builtin_amdgcn_mbcnt_lo(~0u, 0u)); asm volatile("" : "+v"(t)); return t; }
namespace pg8 {
constexpr int BM = 256, BK = 64, HALF = 128, HTB = HALF * BK * 2, STAGE_BYTES = 8 * HTB, NXCD = 8, WGM = 8;
__host__ __device__ __forceinline__ int lds_byte(int r, int c) { const int st = (r >> 4) * 2 + (c >> 5), rr = r & 15, cc = c & 31, ob = rr * 64 + cc * 2; return st * 1024 + (ob ^ (((ob >> 9) & 1) << 5)); }
__host__ __device__ __forceinline__ void stage_rc(int b, int& R, int& C) { const int st = b / 1024, sb = b % 1024, swz = sb ^ (((sb >> 9) & 1) << 5); R = (st >> 1) * 16 + swz / 64; C = (st & 1) * 32 + (swz % 64) / 2; }
__host__ __device__ __forceinline__ int perm32(int rho) { const int n = rho >> 4, i = rho & 15; return 8 * (i >> 2) + 4 * n + (i & 3); }
struct Unit { int pm, pn; };
struct Gemm { const bf16_t* A; const bf16_t* Bt; int M, N, K; };
struct StaticOrder {
    int nM, nN, nwg, G, c;
    __device__ void init(int M, int N, int G_, int c_) { nM = M / BM; nN = N / BM; nwg = nM * nN; G = G_; c = c_; }
    __device__ bool next(int i, Unit& u) const {
        const long L = (long)i * G + c; if (L >= nwg) return false;
        int wgid = (int)L; { const int q = nwg / NXCD, r = nwg % NXCD, xcd = wgid % NXCD, off = wgid / NXCD; wgid = (xcd < r ? xcd * (q + 1) : r * (q + 1) + (xcd - r) * q) + off; }
        const int nig = WGM * nN, gid = wgid / nig, fm = gid * WGM, gsz = (nM - fm) < WGM ? (nM - fm) : WGM;
        u.pm = fm + ((wgid % nig) % gsz); u.pn = (wgid % nig) / gsz; return true;
    }
};
typedef __bf16 bf16n2 __attribute__((ext_vector_type(2)));
typedef float f32n2 __attribute__((ext_vector_type(2)));
__device__ __forceinline__ unsigned cvt_pk_bf16(float lo, float hi) { const f32n2 v = {lo, hi}; const bf16n2 r = __builtin_convertvector(v, bf16n2); return __builtin_bit_cast(unsigned, r); }

template <class Epi>
__device__ __forceinline__ void gemm_phase(const int wv__, LAS unsigned char* lds, const Gemm g, const StaticOrder& S, const Epi& E) {
    const int tid = otid(), wid = __builtin_amdgcn_readfirstlane(tid >> 6), lane = tid & 63, wr = wid >> 2, wc = wid & 3, fr = lane & 15, fq = lane >> 4;
    const int K = g.K, nt = K / BK;
    unsigned voffA[2], voffB[2];
#pragma unroll
    for (int i = 0; i < 2; ++i) { int R, C; stage_rc(tid * 16 + i * 8192, R, C); const int Rb = Epi::PERM ? ((R & ~31) + perm32(R & 31)) : R;
        voffA[i] = (unsigned)(R * K + C) * 2u; voffB[i] = (unsigned)(Rb * K + C) * 2u; }
    const size_t kstep = (size_t)(BK * 2);
    const size_t hstep = (size_t)HALF * K * 2;
    const size_t tstep = 2 * hstep;
    const unsigned ldsw = (unsigned)wid * 1024u;
    const int aoff = lds_byte(wr * 64 + fr, fq * 8), boff = lds_byte(wc * 32 + fr, fq * 8);
#define PG8_SA(b, h) (((b) * 2 + (h)) * HTB)
#define PG8_SB(b, h) ((4 + (b) * 2 + (h)) * HTB)
#define PG8_STAGE(bufoff, gbase, voff) do { _Pragma("unroll") for (int _i = 0; _i < 2; ++_i) \
        __builtin_amdgcn_global_load_lds((const unsigned*)((const char*)(gbase) + (voff)[_i]), (LAS unsigned*)(lds + (bufoff) + ldsw + _i * 8192), 16, 0, 0); } while (0)
#define PG8_LDA(dst, b, h) do { _Pragma("unroll") for (int m = 0; m < 4; ++m) _Pragma("unroll") for (int k = 0; k < 2; ++k) dst[m][k] = *(const LAS bf16x8*)(lds + PG8_SA(b, h) + aoff + m * 2048 + k * 1024); } while (0)
#define PG8_LDB(dst, b, h) do { _Pragma("unroll") for (int n = 0; n < 2; ++n) _Pragma("unroll") for (int k = 0; k < 2; ++k) dst[n][k] = *(const LAS bf16x8*)(lds + PG8_SB(b, h) + boff + n * 2048 + k * 1024); } while (0)
#define PG8_MMA(ai, bj, At, Bt) do { __builtin_amdgcn_s_setprio(1); _Pragma("unroll") for (int m = 0; m < 4; ++m) _Pragma("unroll") for (int n = 0; n < 2; ++n) _Pragma("unroll") for (int k = 0; k < 2; ++k) \
        acc[ai][bj][m][n] = __builtin_amdgcn_mfma_f32_16x16x32_bf16(Bt[n][k], At[m][k], acc[ai][bj][m][n], 0, 0, 0); __builtin_amdgcn_s_setprio(0); } while (0)
#define PG8_WAIT_V(n) asm volatile("s_waitcnt vmcnt(" #n ")" ::: "memory")
#define PG8_WAIT_L(n) asm volatile("s_waitcnt lgkmcnt(" #n ")" ::: "memory")
#define PG8_BAR __builtin_amdgcn_s_barrier()
#define PG8_SCHED __builtin_amdgcn_sched_barrier(0)
    Unit cur, nxt; int ui = 0;
    if (!S.next(0, cur)) return;
    f32x4 acc[2][2][4][2];
#pragma unroll
    for (int a = 0; a < 2; ++a)
#pragma unroll
        for (int b = 0; b < 2; ++b)
#pragma unroll
            for (int m = 0; m < 4; ++m)
#pragma unroll
                for (int n = 0; n < 2; ++n) acc[a][b][m][n] = (f32x4){0.f, 0.f, 0.f, 0.f};
    bf16x8 At[4][2], B0[2][2], B1[2][2];
    const char* cA = (const char*)g.A + (size_t)cur.pm * tstep; const char* cB = (const char*)g.Bt + (size_t)cur.pn * tstep;
    PG8_STAGE(PG8_SB(0, 0), cB, voffB); PG8_STAGE(PG8_SA(0, 0), cA, voffA); PG8_STAGE(PG8_SB(0, 1), cB + hstep, voffB); PG8_STAGE(PG8_SA(0, 1), cA + hstep, voffA);
    if (wr == 1) PG8_BAR;
    PG8_WAIT_V(4); PG8_BAR;
    PG8_STAGE(PG8_SB(1, 0), cB + kstep, voffB); PG8_STAGE(PG8_SA(1, 0), cA + kstep, voffA); PG8_STAGE(PG8_SB(1, 1), cB + hstep + kstep, voffB);
    PG8_WAIT_V(6); PG8_BAR;
    for (;;) {
        const bool has_next = S.next(ui + 1, nxt);
        const char* nA = has_next ? (const char*)g.A + (size_t)nxt.pm * tstep : cA; const char* nB = has_next ? (const char*)g.Bt + (size_t)nxt.pn * tstep : cB;
#pragma unroll 1
        for (int t = 0; t < nt; t += 2) {
            const bool last = (t == nt - 2);
            const char* a1 = cA + (size_t)(t + 1) * kstep;
            const char* a2 = last ? nA : cA + (size_t)(t + 2) * kstep; const char* b2 = last ? nB : cB + (size_t)(t + 2) * kstep;
            const char* a3 = a2 + kstep; const char* b3 = b2 + kstep;
            PG8_LDB(B0, 0, 0); PG8_SCHED; PG8_LDA(At, 0, 0); PG8_STAGE(PG8_SA(1, 1), a1 + hstep, voffA);
            PG8_WAIT_L(8); PG8_BAR; PG8_WAIT_L(0); PG8_MMA(0, 0, At, B0); PG8_BAR; PG8_SCHED;
            PG8_LDB(B1, 0, 1); PG8_STAGE(PG8_SB(0, 0), b2, voffB);
            PG8_BAR; PG8_WAIT_L(0); PG8_MMA(0, 1, At, B1); PG8_BAR;
            PG8_LDA(At, 0, 1); PG8_STAGE(PG8_SA(0, 0), a2, voffA);
            PG8_BAR; PG8_WAIT_L(0); PG8_MMA(1, 0, At, B0); PG8_BAR; PG8_SCHED;
            PG8_STAGE(PG8_SB(0, 1), b2 + hstep, voffB);
            PG8_WAIT_V(6); PG8_BAR; PG8_MMA(1, 1, At, B1); PG8_BAR;
            PG8_LDB(B0, 1, 0); PG8_SCHED; PG8_LDA(At, 1, 0); PG8_STAGE(PG8_SA(0, 1), a2 + hstep, voffA);
            PG8_WAIT_L(8); PG8_BAR; PG8_WAIT_L(0); PG8_MMA(0, 0, At, B0); PG8_BAR; PG8_SCHED;
            PG8_LDB(B1, 1, 1); PG8_STAGE(PG8_SB(1, 0), b3, voffB);
            PG8_BAR; PG8_WAIT_L(0); PG8_MMA(0, 1, At, B1); PG8_BAR;
            PG8_LDA(At, 1, 1); PG8_STAGE(PG8_SA(1, 0), a3, voffA);
            PG8_BAR; PG8_WAIT_L(0); PG8_MMA(1, 0, At, B0); PG8_BAR; PG8_SCHED;
            PG8_STAGE(PG8_SB(1, 1), b3 + hstep, voffB);
            PG8_WAIT_V(6); PG8_BAR; PG8_MMA(1, 1, At, B1); PG8_BAR;
        }
        E(acc, cur, wr, wc, fr, fq);
        if (!has_next) break;
#pragma unroll
        for (int a = 0; a < 2; ++a)
#pragma unroll
            for (int b = 0; b < 2; ++b)
#pragma unroll
                for (int m = 0; m < 4; ++m)
#pragma unroll
                    for (int n = 0; n < 2; ++n) acc[a][b][m][n] = (f32x4){0.f, 0.f, 0.f, 0.f};
        cur = nxt; cA = nA; cB = nB; ++ui;
    }
    PG8_WAIT_V(0);
    if (wr == 0) PG8_BAR;
    PG8_BAR;
#undef PG8_SA
#undef PG8_SB
#undef PG8_STAGE
#undef PG8_LDA
#undef PG8_LDB
#undef PG8_MMA
#undef PG8_WAIT_V
#undef PG8_WAIT_L
#undef PG8_BAR
#undef PG8_SCHED
}
}
using pg8::cvt_pk_bf16;

constexpr int D = 1024, MP = 65536, MS = 256, MT = MP + MS, FF = 2816;
constexpr int PE = 3840, PO = 3584;
constexpr float EPSF = 1e-6f;
constexpr size_t O_Y = 0;
constexpr size_t O_PSHIFT = (size_t)MT * D;
constexpr size_t O_PRWKV = O_PSHIFT + 8 * 1792;
constexpr size_t O_PCONV = O_PRWKV + 8 * 8 * 64 * 64;
constexpr size_t O_PDELTA = O_PCONV + 8 * 3 * 1536;
constexpr size_t O_PGLA = O_PDELTA + 8 * 4 * 128 * 128;
constexpr size_t O_PRET = O_PGLA + 8 * 4 * 64 * 128;
constexpr size_t O_PMK = O_PRET + 8 * 4 * 128 * 128;
constexpr size_t O_PMV = O_PMK + 2 * 8 * 256 * 1024;
constexpr size_t O_SSHIFT = O_PMV + 2 * 8 * 256 * 1024;
constexpr size_t O_SRWKV = O_SSHIFT + 16 * 1792;
constexpr size_t O_SCONV = O_SRWKV + 16 * 8 * 64 * 64;
constexpr size_t O_SDELTA = O_SCONV + 16 * 3 * 1536;
constexpr size_t O_SGLA = O_SDELTA + 16 * 4 * 128 * 128;
constexpr size_t O_SRET = O_SGLA + 16 * 4 * 64 * 128;
constexpr size_t O_END = O_SRET + 16 * 4 * 128 * 128;
static_assert(O_END == 80631808, "output size");
constexpr size_t al256(size_t x) { return (x + 255) & ~(size_t)255; }
constexpr size_t E_F1U = 0;
constexpr size_t E_F1D = E_F1U + 2ull * 5632 * 1024;
constexpr size_t E_F2U = E_F1D + 2ull * 1024 * 2816;
constexpr size_t E_F2D = E_F2U + 2ull * 5632 * 1024;
constexpr size_t E_EIN = E_F2D + 2ull * 1024 * 2816;
constexpr size_t E_EOUT = E_EIN + 4096ull * 1024;
constexpr size_t E_OIN = E_EOUT + 1024ull * 1024;
constexpr size_t E_OOUT = E_OIN + 3840ull * 1024;
constexpr size_t E_WQ = E_OOUT + 1024ull * 1024;
constexpr size_t E_WO = E_WQ + 2ull * 1024 * 1024;
constexpr size_t E_MKV = E_WO + 2ull * 1024 * 1024;
constexpr size_t E_LR1 = E_MKV + 4096ull * 1024;
constexpr size_t E_LR2 = E_LR1 + 1024ull * 256;
constexpr size_t E_END = E_LR2 + 512ull * 256;
constexpr size_t WS_WT = 0;
constexpr size_t WS_AMEM = al256(WS_WT + E_END * 2);
constexpr size_t WS_SC = al256(WS_AMEM + 2048ull * 1024 * 2);
constexpr size_t WS_BONUS = al256(WS_SC + (size_t)MT * 16 * 4);
constexpr size_t WS_HY = al256(WS_BONUS + (size_t)MT * 8 * 4);
constexpr size_t WS_BIG = al256(WS_HY + (size_t)MT * 1024 * 2);
constexpr size_t WS_LREA = al256(WS_BIG + (size_t)MT * 3840 * 2);
constexpr size_t WS_VBWK = al256(WS_LREA + (size_t)MT * 1024 * 2);
constexpr size_t WS_AP = al256(WS_VBWK + 4160ull * 64 * 256 * 2);
constexpr size_t WS_BAR = al256(WS_AP + (size_t)MT * 256 * 2);
constexpr size_t WS_HALO = al256(WS_BAR + 3456 * 4);
constexpr size_t WS_END = al256(WS_HALO + 8ull * 128 * 3 * 1536 * 2);
constexpr size_t WS_KB = WS_BIG + (size_t)MT * 1024 * 2;
constexpr size_t WS_VTB = WS_KB + 96ull * 256 * 256 * 2;
static_assert(WS_END <= (1ull << 30), "workspace budget");
constexpr int LDS_BYTES = 155648;

struct Args { const float* in[49]; float* out; unsigned char* ws; int ph_lo, ph_hi; };
#define KAS __attribute__((address_space(4)))
__device__ __forceinline__ const float* inptr(int k) { const KAS char* kp = (const KAS char*)__builtin_amdgcn_kernarg_segment_ptr(); return *(const float* const volatile KAS*)(kp + 8 * k); }
__device__ __forceinline__ float* outptr() { const KAS char* kp = (const KAS char*)__builtin_amdgcn_kernarg_segment_ptr(); return *(float* const volatile KAS*)(kp + 8 * 49); }
__device__ __forceinline__ unsigned char* wsptr() { const KAS char* kp = (const KAS char*)__builtin_amdgcn_kernarg_segment_ptr(); return *(unsigned char* const volatile KAS*)(kp + 8 * 50); }

__device__ __forceinline__ float bf2f(bf16_t b) { return __uint_as_float((unsigned)b << 16); }
__device__ __forceinline__ bf16_t f2bf(float f) { return (bf16_t)(cvt_pk_bf16(f, 0.f) & 0xffffu); }
__device__ __forceinline__ float bflo(unsigned w) { return __uint_as_float(w << 16); }
__device__ __forceinline__ float bfhi(unsigned w) { return __uint_as_float(w & 0xffff0000u); }
__device__ __forceinline__ void unpack8(const u32x4 w, float (&f)[8]) { f[0] = bflo(w.x); f[1] = bfhi(w.x); f[2] = bflo(w.y); f[3] = bfhi(w.y); f[4] = bflo(w.z); f[5] = bfhi(w.z); f[6] = bflo(w.w); f[7] = bfhi(w.w); }
__device__ __forceinline__ u32x4 pack8(const float (&f)[8]) { u32x4 w; w.x = cvt_pk_bf16(f[0], f[1]); w.y = cvt_pk_bf16(f[2], f[3]); w.z = cvt_pk_bf16(f[4], f[5]); w.w = cvt_pk_bf16(f[6], f[7]); return w; }
template <int CTRL> __device__ __forceinline__ float dpp_mov(float v) { return __builtin_bit_cast(float, __builtin_amdgcn_update_dpp(0, __builtin_bit_cast(int, v), CTRL, 0xf, 0xf, true)); }
__device__ __forceinline__ float rowsum8(float v) { v += dpp_mov<0xB1>(v); v += dpp_mov<0x4E>(v); v += dpp_mov<0x141>(v); return v; }
__device__ __forceinline__ float rowsum16(float v) { v = rowsum8(v); v += dpp_mov<0x140>(v); return v; }
__device__ __forceinline__ float rowmax16(float v) { v = fmaxf(v, dpp_mov<0xB1>(v)); v = fmaxf(v, dpp_mov<0x4E>(v)); v = fmaxf(v, dpp_mov<0x141>(v)); v = fmaxf(v, dpp_mov<0x140>(v)); return v; }
__device__ __forceinline__ float wave_sum(float v) { v = rowsum16(v); v += __shfl_xor(v, 16); v += __shfl_xor(v, 32); return v; }
__device__ __forceinline__ float sigmoidf_(float x) { return __builtin_amdgcn_rcpf(1.f + __expf(-x)); }
__device__ __forceinline__ float siluf_(float x) { return x * sigmoidf_(x); }
__device__ __forceinline__ float tanhf_(float x) { return 1.f - 2.f * __builtin_amdgcn_rcpf(1.f + __expf(2.f * x)); }
__device__ __forceinline__ float softplusf_(float x) { return fmaxf(x, 0.f) + log1pf(__expf(-fabsf(x))); }
__device__ __forceinline__ void row_info(int row, int& s, int& t) { if (row < MP) { s = row >> 13; t = row & 8191; } else { const int r = row - MP; s = 8 + (r >> 4); t = r & 15; } }
__device__ __forceinline__ int seq_row0(int s) { return s < 8 ? s * 8192 : MP + (s - 8) * 16; }
__device__ __forceinline__ int seq_T(int s) { return s < 8 ? 8192 : 16; }
#define LDS_WAIT() asm volatile("s_waitcnt lgkmcnt(0)" ::: "memory")

__device__ __forceinline__ f32x4 mma_tile(const LAS bf16_t* A, int lda, const LAS bf16_t* B, int ldb, int K, f32x4 acc, int lane) {
    const LAS bf16_t* a = A + (lane & 15) * lda + (lane >> 4) * 8;
    const LAS bf16_t* b = B + (lane & 15) * ldb + (lane >> 4) * 8;
    for (int k = 0; k < K; k += 32) {
        const bf16x8 av = *(const LAS bf16x8*)(a + k), bv = *(const LAS bf16x8*)(b + k);
        acc = __builtin_amdgcn_mfma_f32_16x16x32_bf16(av, bv, acc, 0, 0, 0);
    }
    return acc;
}

struct EpiResid {
    static constexpr bool PERM = false;
    float* X; float scale; bf16_t* XB; bf16_t* RSP;
    __device__ __forceinline__ void operator()(const f32x4 (&acc)[2][2][4][2], const pg8::Unit& u, int wr, int wc, int fr, int fq) const {
        const int row0 = u.pm * 256 + wr * 64 + fr, col0 = u.pn * 256 + wc * 32 + 4 * fq;
#pragma unroll
        for (int ai = 0; ai < 2; ++ai)
#pragma unroll
            for (int m = 0; m < 4; ++m) { const size_t row = (size_t)(row0 + ai * 128 + m * 16); float* rowp = X + row * D + col0; bf16_t* xbp = XB + row * D + col0; float ss = 0.f;
#pragma unroll
                for (int bj = 0; bj < 2; ++bj)
#pragma unroll
                    for (int n = 0; n < 2; ++n) { f32x4* p = (f32x4*)(rowp + bj * 128 + n * 16); const f32x4 v = *p + acc[ai][bj][m][n] * scale; *p = v;
                        ss += (v[0] * v[0] + v[1] * v[1]) + (v[2] * v[2] + v[3] * v[3]);
                        u32x2 w; w.x = cvt_pk_bf16(v[0], v[1]); w.y = cvt_pk_bf16(v[2], v[3]); *(u32x2*)(xbp + bj * 128 + n * 16) = w; }
                ss += __shfl_xor(ss, 16); ss += __shfl_xor(ss, 32);
                if (fq == 0) RSP[row * 16 + u.pn * 4 + wc] = f2bf(ss); }
    }
};
__device__ __forceinline__ float row_rstd(const bf16_t* RSP, size_t row) {
    const u32x4 a = *(const u32x4*)(RSP + row * 16), b = *(const u32x4*)(RSP + row * 16 + 8);
    const float s = ((bflo(a.x) + bfhi(a.x)) + (bflo(a.y) + bfhi(a.y))) + ((bflo(a.z) + bfhi(a.z)) + (bflo(a.w) + bfhi(a.w)))
                  + ((bflo(b.x) + bfhi(b.x)) + (bflo(b.y) + bfhi(b.y))) + ((bflo(b.z) + bfhi(b.z)) + (bflo(b.w) + bfhi(b.w)));
    return rsqrtf(s * (1.f / D) + EPSF);
}
struct EpiSwiglu {
    static constexpr bool PERM = true;
    bf16_t* O; const bf16_t* RSP;
    __device__ __forceinline__ void operator()(const f32x4 (&acc)[2][2][4][2], const pg8::Unit& u, int wr, int wc, int fr, int fq) const {
        const int row0 = u.pm * 256 + wr * 64 + fr, col0 = u.pn * 128 + wc * 32 + 8 * fq;
        float rsv[2][4];
#pragma unroll
        for (int ai = 0; ai < 2; ++ai)
#pragma unroll
            for (int m = 0; m < 4; ++m) rsv[ai][m] = RSP ? row_rstd(RSP, (size_t)(row0 + ai * 128 + m * 16)) : 1.f;
#pragma unroll
        for (int ai = 0; ai < 2; ++ai)
#pragma unroll
            for (int m = 0; m < 4; ++m) {
                float v[8]; const float rs = rsv[ai][m];
#pragma unroll
                for (int n = 0; n < 2; ++n)
#pragma unroll
                    for (int j = 0; j < 4; ++j) v[4 * n + j] = siluf_(acc[ai][0][m][n][j] * rs) * (acc[ai][1][m][n][j] * rs);
                *(u32x4*)(O + (size_t)(row0 + ai * 128 + m * 16) * FF + col0) = pack8(v);
            }
    }
};
struct EpiBf16 {
    static constexpr bool PERM = true;
    bf16_t* O; int ldc; const bf16_t* RSP; float* SCp; int thin_pn;
    __device__ __forceinline__ void operator()(const f32x4 (&acc)[2][2][4][2], const pg8::Unit& u, int wr, int wc, int fr, int fq) const {
        const int row0 = u.pm * 256 + wr * 64 + fr, col0 = u.pn * 256 + wc * 32 + 8 * fq;
        const bool thin = (u.pn == thin_pn);
        float rsv[2][4];
#pragma unroll
        for (int ai = 0; ai < 2; ++ai)
#pragma unroll
            for (int m = 0; m < 4; ++m) rsv[ai][m] = RSP ? row_rstd(RSP, (size_t)(row0 + ai * 128 + m * 16)) : 1.f;
#pragma unroll
        for (int ai = 0; ai < 2; ++ai)
#pragma unroll
            for (int m = 0; m < 4; ++m) { const size_t row = (size_t)(row0 + ai * 128 + m * 16); const float rs = rsv[ai][m];
                if (thin) { if (wc == 0 && fq < 2) { *(f32x4*)(SCp + row * 16 + 8 * fq) = acc[ai][0][m][0] * rs; *(f32x4*)(SCp + row * 16 + 8 * fq + 4) = acc[ai][0][m][1] * rs; } }
                else { bf16_t* rowp = O + row * ldc + col0;
#pragma unroll
                    for (int bj = 0; bj < 2; ++bj) { const f32x4 v0 = acc[ai][bj][m][0] * rs, v1 = acc[ai][bj][m][1] * rs;
                        u32x4 w; w.x = cvt_pk_bf16(v0[0], v0[1]); w.y = cvt_pk_bf16(v0[2], v0[3]); w.z = cvt_pk_bf16(v1[0], v1[1]); w.w = cvt_pk_bf16(v1[2], v1[3]);
                        *(u32x4*)(rowp + bj * 128) = w; } } }
    }
};
struct EpiLR1 {
    static constexpr bool PERM = true;
    bf16_t* O; const float* w0; const float* a0;
    __device__ __forceinline__ void operator()(const f32x4 (&acc)[2][2][4][2], const pg8::Unit& u, int wr, int wc, int fr, int fq) const {
        const int row0 = u.pm * 256 + wr * 64 + fr, col0 = u.pn * 256 + wc * 32 + 8 * fq;
        const float* bias = (u.pn < 2) ? (w0 + col0) : (a0 + col0 - 512); const float sc = (u.pn < 2) ? -0.60653066f : 1.f;
#pragma unroll
        for (int bj = 0; bj < 2; ++bj) {
            const f32x4 b0 = *(const f32x4*)(bias + bj * 128), b1 = *(const f32x4*)(bias + bj * 128 + 4);
#pragma unroll
            for (int ai = 0; ai < 2; ++ai)
#pragma unroll
                for (int m = 0; m < 4; ++m) {
                    float v[8];
#pragma unroll
                    for (int j = 0; j < 4; ++j) { v[j] = sc * sigmoidf_(acc[ai][bj][m][0][j] + b0[j]); v[4 + j] = sc * sigmoidf_(acc[ai][bj][m][1][j] + b1[j]); }
                    *(u32x4*)(O + (size_t)(row0 + ai * 128 + m * 16) * 1024 + col0 + bj * 128) = pack8(v);
                }
        }
    }
};
struct EpiMemKV {
    static constexpr bool PERM = false;
    float* PK;
    __device__ __forceinline__ void operator()(const f32x4 (&acc)[2][2][4][2], const pg8::Unit& u, int wr, int wc, int fr, int fq) const {
        const int t = u.pn >> 2; float* base = PK + (size_t)(t & 1) * (O_PMV - O_PMK) + (size_t)(t >> 1) * (8 * 256 * 1024);
        const int row0 = u.pm * 256 + wr * 64 + fr, col0 = (u.pn & 3) * 256 + wc * 32 + 4 * fq;
#pragma unroll
        for (int ai = 0; ai < 2; ++ai)
#pragma unroll
            for (int m = 0; m < 4; ++m) { float* rowp = base + (size_t)(row0 + ai * 128 + m * 16) * 1024 + col0;
#pragma unroll
                for (int bj = 0; bj < 2; ++bj)
#pragma unroll
                    for (int n = 0; n < 2; ++n) *(f32x4*)(rowp + bj * 128 + n * 16) = acc[ai][bj][m][n]; }
    }
};
template <class Epi> __device__ __forceinline__ void run_gemm(const int wv__, LAS unsigned char* lds, const bf16_t* A, const bf16_t* Bt, int M, int N, int K, const Epi& E) {
    pg8::Gemm g{A, Bt, M, N, K}; pg8::StaticOrder S; S.init(M, N, (int)gridDim.x, (int)blockIdx.x);
    pg8::gemm_phase<Epi>(wv__, lds, g, S, E);
}

__device__ __forceinline__ void cvt_item(const float* W, int ld, int c0, int k0, bf16_t* dst, int K, const float* ks, LAS float* scr, int lane) {
#pragma unroll 8
    for (int i = 0; i < 32; ++i) { const int kk = 2 * i + (lane >> 5); float v = W[(size_t)(k0 + kk) * ld + c0 + (lane & 31)]; if (ks) v *= ks[k0 + kk]; scr[kk * 33 + (lane & 31)] = v; }
    LDS_WAIT();
    const int c = lane & 7;
#pragma unroll
    for (int j = 0; j < 4; ++j) { const int n = (lane >> 3) + 8 * j; const LAS float* s = scr + (8 * c) * 33 + n;
        u32x4 o; o.x = cvt_pk_bf16(s[0 * 33], s[1 * 33]); o.y = cvt_pk_bf16(s[2 * 33], s[3 * 33]); o.z = cvt_pk_bf16(s[4 * 33], s[5 * 33]); o.w = cvt_pk_bf16(s[6 * 33], s[7 * 33]);
        *(u32x4*)(dst + (size_t)n * K + k0 + 8 * c) = o; }
    LDS_WAIT();
}
__device__ __forceinline__ void cvt_seg(const float* W, int ld, int c0, int nc, int K, bf16_t* dst, const float* ks, LAS float* scr, int lane, int gw, int NGW, int& cum) {
    const int nb = nc / 32, n = (K / 64) * nb;
    int it = (gw - (cum % NGW) + NGW) % NGW;
    for (; it < n; it += NGW) { const int kb = it / nb, b = it % nb; cvt_item(W, ld, c0 + 32 * b, 64 * kb, dst + (size_t)(32 * b) * K, K, ks, scr, lane); }
    cum += n;
}
__device__ __forceinline__ void cvt_ffn_up(const float* wg, const float* wu, const float* ks, bf16_t* dst, LAS float* scr, int lane, int gw, int NGW, int& cum) {
    const int n = 2 * 88 * 16;
    int it = (gw - (cum % NGW) + NGW) % NGW;
    for (; it < n; it += NGW) { const int kb = it / 176, r = it % 176, gu = r / 88, cb = r % 88;
        cvt_item(gu ? wu : wg, FF, 32 * cb, 64 * kb, dst + (size_t)((cb >> 2) * 256 + gu * 128 + (cb & 3) * 32) * D, D, ks, scr, lane); }
    cum += n;
}

template <bool FROM_INPUT, int NCOL>
__device__ __forceinline__ void norm_phase(const int wv__, const float* xp, const float* xs, float* X, bf16_t* H, const float* w, const float* Wsm, int ldw, int c0w, float* SC, LAS unsigned char* lds) {
    const int tid = otid(), lane = tid & 63, wave = tid >> 6;
    const int gw = blockIdx.x * 8 + wave, NGW = gridDim.x * 8;
    LAS float* lw = (LAS float*)lds;
    if (NCOL > 0) {
        for (int idx = tid; idx < 1024 * NCOL; idx += 512) { const int k = idx / NCOL, c = idx % NCOL; const int ln = (k >> 2) & 63, j = k >> 8, i = k & 3;
            lw[((((j * 4 + i) * (NCOL / 4) + (c >> 2)) * 64 + ln) << 2) + (c & 3)] = Wsm[(size_t)k * ldw + c0w + c]; }
        __syncthreads();
    }
    f32x4 wv[4];
#pragma unroll
    for (int j = 0; j < 4; ++j) wv[j] = *(const f32x4*)(w + (lane + 64 * j) * 4);
    for (int row = gw; row < MT; row += NGW) {
        const float* src = FROM_INPUT ? (row < MP ? xp + (size_t)row * D : xs + (size_t)(row - MP) * D) : X + (size_t)row * D;
        f32x4 v[4]; float ss = 0.f;
#pragma unroll
        for (int j = 0; j < 4; ++j) { v[j] = *(const f32x4*)(src + (lane + 64 * j) * 4); ss += (v[j][0] * v[j][0] + v[j][1] * v[j][1]) + (v[j][2] * v[j][2] + v[j][3] * v[j][3]); }
        const float rstd = rsqrtf(wave_sum(ss) * (1.f / D) + EPSF);
#pragma unroll
        for (int j = 0; j < 4; ++j) {
            if (FROM_INPUT) *(f32x4*)(X + (size_t)row * D + (lane + 64 * j) * 4) = v[j];
            v[j] = v[j] * rstd * wv[j];
            u32x2 o; o.x = cvt_pk_bf16(v[j][0], v[j][1]); o.y = cvt_pk_bf16(v[j][2], v[j][3]);
            *(u32x2*)(H + (size_t)row * D + (lane + 64 * j) * 4) = o;
        }
        if (NCOL > 0) {
            float part[NCOL > 0 ? NCOL : 1];
#pragma unroll
            for (int c = 0; c < NCOL; ++c) part[c] = 0.f;
#pragma unroll
            for (int j = 0; j < 4; ++j)
#pragma unroll
                for (int i = 0; i < 4; ++i)
#pragma unroll
                    for (int cq = 0; cq < NCOL / 4; ++cq) { const f32x4 ww = *(const LAS f32x4*)(lw + ((((j * 4 + i) * (NCOL / 4) + cq) * 64 + lane) << 2));
#pragma unroll
                        for (int e = 0; e < 4; ++e) part[cq * 4 + e] += v[j][i] * ww[e]; if (cq == NCOL / 4 - 1) asm volatile("" ::: "memory"); }
            float mine = 0.f;
#pragma unroll
            for (int c = 0; c < NCOL; ++c) { const float s = wave_sum(part[c]); if (lane == c) mine = s; }
            if (lane < NCOL) SC[(size_t)row * 16 + lane] = mine;
        }
    }
}

__device__ __forceinline__ void rwkv_prep_phase(const int wv__, const bf16_t* P, bf16_t* AP, bf16_t* HALO) {
    const float* mu = inptr(18); const float* sh0 = inptr(3); float* outp = outptr();
    const int gt = blockIdx.x * 512 + otid(), NT = gridDim.x * 512;
    for (int it = gt; it < MT * 32; it += NT) {
        const int row = it >> 5, c8 = (it & 31) * 8; int s, t; row_info(row, s, t);
        float cur[8], prv[8], o[8];
        unpack8(*(const u32x4*)(P + (size_t)row * PE + 1536 + c8), cur);
        if (t > 0) unpack8(*(const u32x4*)(P + (size_t)(row - 1) * PE + 1536 + c8), prv);
        else {
#pragma unroll
            for (int i = 0; i < 8; ++i) prv[i] = (s >= 8) ? sh0[(size_t)(s - 8) * 1792 + 1536 + c8 + i] : 0.f; }
#pragma unroll
        for (int i = 0; i < 8; ++i) { const float x = cur[i] + (prv[i] - cur[i]) * mu[1536 + c8 + i]; o[i] = (c8 < 64) ? tanhf_(x) : ((c8 < 128) ? x : sigmoidf_(x)); }
        *(u32x4*)(AP + (size_t)row * 256 + c8) = pack8(o);
    }
    for (int it = gt; it < 8 * 128 * 3 * 192; it += NT) { const int ch = it % 192, r = it / 192, j = r % 3, sc = r / 3, c = sc & 127, s = sc >> 7;
        if (c > 0) *(u32x4*)(HALO + (size_t)r * 1536 + ch * 8) = *(const u32x4*)(P + (size_t)(s * 8192 + c * 64 - 3 + j) * PE + 1792 + ch * 8); }
    for (int it = gt; it < 24 * (1792 + 3 * 1536); it += NT) {
        const int s = it / 6400, r = it % 6400; const int T = seq_T(s), r0 = seq_row0(s);
        if (r < 1792) { const float v = bf2f(P[(size_t)(r0 + T - 1) * PE + r]); outp[(s < 8 ? O_PSHIFT + (size_t)s * 1792 : O_SSHIFT + (size_t)(s - 8) * 1792) + r] = v; }
        else { const int q = r - 1792, j = q / 1536, c = q % 1536; const float v = bf2f(P[(size_t)(r0 + T - 3 + j) * PE + 1792 + c]);
            outp[(s < 8 ? O_PCONV + (size_t)s * 4608 : O_SCONV + (size_t)(s - 8) * 4608) + q] = v; }
    }
}

__device__ __forceinline__ void rwkv_scan_phase(const int wv__, const bf16_t* P, const bf16_t* LREA, bf16_t* YC, float* BONUS, LAS unsigned char* lds) {
    const int tid = otid();
    LAS float* L = (LAS float*)lds;
    constexpr int BUFW = 10752;
    LAS float* YB = L + 2 * BUFW;
    const float* mu = inptr(18); const float* kkw = inptr(24); const float* kaw = inptr(25); const float* rkw = inptr(26); const float* sh0 = inptr(3); const float* st_in = inptr(4); float* outp = outptr();
    for (int item = blockIdx.x; item < 768; item += gridDim.x) {
        int s, h, q; if (item < 256) { const int bh = item >> 2; q = item & 3; s = bh >> 3; h = bh & 7; } else { const int i2 = item - 256, bh = i2 >> 2; q = i2 & 3; s = 8 + (bh >> 3); h = bh & 7; }
        const int T = seq_T(s), r0 = seq_row0(s), nch = (T + 31) >> 5;
        const bool comp = tid < 256;
        const int rl = (tid >> 4) & 15, li = tid & 15;
        f32x4 S = (f32x4){0.f, 0.f, 0.f, 0.f};
        float* stout = outp + (s < 8 ? O_PRWKV + ((size_t)(s * 8 + h) * 64 + 16 * q + rl) * 64 : O_SRWKV + ((size_t)((s - 8) * 8 + h) * 64 + 16 * q + rl) * 64) + 4 * li;
        if (comp && s >= 8) S = *(const f32x4*)(st_in + ((size_t)((s - 8) * 8 + h) * 64 + 16 * q + rl) * 64 + 4 * li);
        f32x4 mur, muk, muv, ckk, cka, crk, shr, shk, shv;
        mur = muk = muv = ckk = cka = crk = shr = shk = shv = (f32x4){0.f, 0.f, 0.f, 0.f};
        const int c0 = h * 64 + 4 * li;
        if (!comp) { mur = *(const f32x4*)(mu + c0); muk = *(const f32x4*)(mu + 512 + c0); muv = *(const f32x4*)(mu + 1024 + c0); ckk = *(const f32x4*)(kkw + c0); cka = *(const f32x4*)(kaw + c0); crk = *(const f32x4*)(rkw + c0);
            if (s >= 8) { const float* sh = sh0 + (size_t)(s - 8) * 1792; shr = *(const f32x4*)(sh + c0); shk = *(const f32x4*)(sh + 512 + c0); shv = *(const f32x4*)(sh + 1024 + c0); } }
        u32x2 raw[2][8];
#define RWKV_PREFETCH(cn) do { _Pragma("unroll") for (int ps = 0; ps < 2; ++ps) { const int t = (cn) * 32 + ps * 16 + rl; const bool ok = t < T; const bf16_t* pr = P + (size_t)(r0 + t) * PE + c0; const bf16_t* lr = LREA + (size_t)(r0 + t) * 1024 + c0; \
            const u32x2 z2 = (u32x2){0u, 0u}; \
            raw[ps][0] = ok ? *(const u32x2*)pr : z2; raw[ps][1] = ok ? *(const u32x2*)(pr + 512) : z2; raw[ps][2] = ok ? *(const u32x2*)(pr + 1024) : z2; \
            const bool okp = ok && t > 0; \
            raw[ps][3] = okp ? *(const u32x2*)(pr - PE) : z2; raw[ps][4] = okp ? *(const u32x2*)(pr - PE + 512) : z2; raw[ps][5] = okp ? *(const u32x2*)(pr - PE + 1024) : z2; \
            raw[ps][6] = ok ? *(const u32x2*)lr : z2; raw[ps][7] = ok ? *(const u32x2*)(lr + 512) : z2; } } while (0)
        if (!comp) RWKV_PREFETCH(0);
        for (int c = -1; c < nch; ++c) {
            if (!comp) {
                const int cn = c + 1;
                if (cn < nch) {
                    LAS float* B = L + (cn & 1) * BUFW;
#pragma unroll
                    for (int ps = 0; ps < 2; ++ps) {
                        const int tk = ps * 16 + rl, t = cn * 32 + tk;
                        f32x4 rc, kc, vc, rp, kp, vp, ee, aa;
#define UNPK(dst, w) dst = (f32x4){bflo((w).x), bfhi((w).x), bflo((w).y), bfhi((w).y)}
                        UNPK(rc, raw[ps][0]); UNPK(kc, raw[ps][1]); UNPK(vc, raw[ps][2]); UNPK(rp, raw[ps][3]); UNPK(kp, raw[ps][4]); UNPK(vp, raw[ps][5]); UNPK(ee, raw[ps][6]); UNPK(aa, raw[ps][7]);
#undef UNPK
                        if (t == 0) { rp = shr; kp = shk; vp = shv; }
                        const f32x4 xr = rc + (rp - rc) * mur, xk = kc + (kp - kc) * muk, xv = vc + (vp - vc) * muv;
                        const f32x4 kkv = xk * ckk;
                        const float n2 = rowsum16((kkv[0] * kkv[0] + kkv[1] * kkv[1]) + (kkv[2] * kkv[2] + kkv[3] * kkv[3]));
                        const f32x4 kk = kkv * rsqrtf(n2 + EPSF);
                        const f32x4 kpr = xk * (1.f + (aa - 1.f) * cka);
                        const f32x4 bt = xr * kpr * crk;
                        const float bon = rowsum16((bt[0] + bt[1]) + (bt[2] + bt[3]));
                        const f32x4 w = (f32x4){__expf(ee[0]), __expf(ee[1]), __expf(ee[2]), __expf(ee[3])};
                        *(LAS f32x4*)(B + tk * 64 + 4 * li) = w; *(LAS f32x4*)(B + 2048 + tk * 64 + 4 * li) = kpr; *(LAS f32x4*)(B + 4096 + tk * 64 + 4 * li) = -kk;
                        *(LAS f32x4*)(B + 6144 + tk * 64 + 4 * li) = kk * aa; *(LAS f32x4*)(B + 8192 + tk * 64 + 4 * li) = xr;
                        if ((li >> 2) == q) *(LAS f32x4*)(B + 10240 + tk * 16 + 4 * (li & 3)) = xv;
                        if (q == 0 && li == 0 && t < T) BONUS[(size_t)(r0 + t) * 8 + h] = bon;
                    }
                    if (cn + 1 < nch) RWKV_PREFETCH(cn + 1);
                }
            } else if (c >= 0) {
                const LAS float* B = L + (c & 1) * BUFW; LAS float* yb = YB + (c & 1) * 8192;
                const int nv = min(32, T - c * 32);
#define RWKV_STEP(tt) do { \
                    const f32x4 w = *(const LAS f32x4*)(B + (tt) * 64 + li * 4), kp = *(const LAS f32x4*)(B + 2048 + (tt) * 64 + li * 4), na = *(const LAS f32x4*)(B + 4096 + (tt) * 64 + li * 4), \
                                bb = *(const LAS f32x4*)(B + 6144 + (tt) * 64 + li * 4), rr = *(const LAS f32x4*)(B + 8192 + (tt) * 64 + li * 4); \
                    const float vv = B[10240 + (tt) * 16 + rl]; \
                    float sa = (S[0] * na[0] + S[1] * na[1]) + (S[2] * na[2] + S[3] * na[3]); \
                    const f32x4 tS = S * w + vv * kp; \
                    sa = rowsum16(sa); \
                    S = tS + sa * bb; \
                    yb[((tt) * 16 + rl) * 16 + li] = (S[0] * rr[0] + S[1] * rr[1]) + (S[2] * rr[2] + S[3] * rr[3]); } while (0)
                __builtin_amdgcn_s_setprio(2);
                if (nv == 32) {
#pragma unroll
                    for (int tt = 0; tt < 32; ++tt) RWKV_STEP(tt);
                } else {
                    for (int tt = 0; tt < nv; ++tt) RWKV_STEP(tt);
                }
                __builtin_amdgcn_s_setprio(0);
#undef RWKV_STEP
            }
            __syncthreads();
            if (!comp && c >= 0) {
                const LAS float* yb = YB + (c & 1) * 8192; const int tt = (tid >> 3) & 31, pr2 = tid & 7; const int t = c * 32 + tt;
                if (t < T) { const LAS f32x4* p = (const LAS f32x4*)(yb + (tt * 16 + 2 * pr2) * 16);
                    const f32x4 a0 = p[0], a1 = p[1], a2 = p[2], a3 = p[3], b0 = p[4], b1 = p[5], b2 = p[6], b3 = p[7];
                    const f32x4 sa_ = (a0 + a1) + (a2 + a3), sb_ = (b0 + b1) + (b2 + b3);
                    *(unsigned*)(YC + (size_t)(r0 + t) * 1024 + h * 64 + 16 * q + 2 * pr2) = cvt_pk_bf16((sa_[0] + sa_[1]) + (sa_[2] + sa_[3]), (sb_[0] + sb_[1]) + (sb_[2] + sb_[3])); }
            }
        }
#undef RWKV_PREFETCH
        if (comp) *(f32x4*)stout = S;
        __syncthreads();
    }
}

__device__ __forceinline__ void rwkv_post_phase(const int wv__, const bf16_t* P, const bf16_t* GATE, const float* BONUS, bf16_t* YC) {
    const int lane = otid() & 63, wave = otid() >> 6, gw = blockIdx.x * 8 + wave, NGW = gridDim.x * 8;
    const float* mu = inptr(18); const float* lnw = inptr(27); const float* lnb = inptr(28); const float* sh0 = inptr(3);
    for (int row = gw; row < MT; row += NGW) {
        int s, t; row_info(row, s, t);
#pragma unroll 2
        for (int h = 0; h < 8; ++h) {
            const int c = h * 64 + lane;
            const float y = bf2f(YC[(size_t)row * 1024 + c]);
            const float mean = wave_sum(y) * (1.f / 64.f); const float d = y - mean; const float var = wave_sum(d * d) * (1.f / 64.f);
            const float yn = d * rsqrtf(var + 64e-5f) * lnw[c] + lnb[c];
            const float vc = bf2f(P[(size_t)row * PE + 1024 + c]);
            const float vp = (t > 0) ? bf2f(P[(size_t)(row - 1) * PE + 1024 + c]) : ((s >= 8) ? sh0[(size_t)(s - 8) * 1792 + 1024 + c] : 0.f);
            const float xv = vc + (vp - vc) * mu[1024 + c];
            const float o = (yn + BONUS[(size_t)row * 8 + h] * xv) * bf2f(GATE[(size_t)row * 1024 + c]);
            YC[(size_t)row * 1024 + c] = f2bf(o);
        }
    }
}

__device__ __forceinline__ void delta_conv8(const float* cw, const float* cv0, const bf16_t* P, const bf16_t* HALO, int s, int r0, int T, int t0, int t, int h, int part, int cg, float (&y)[8]) {
    const int ch = part * 512 + h * 128 + cg * 8;
    float acc[8];
#pragma unroll
    for (int i = 0; i < 8; ++i) acc[i] = 0.f;
    const bool ok = t < T;
#pragma unroll
    for (int j = 0; j < 4; ++j) {
        const int tt = t - 3 + j; float x[8];
        if (ok && tt >= t0) unpack8(*(const u32x4*)(P + (size_t)(r0 + tt) * PE + 1792 + ch), x);
        else if (ok && tt >= 0) unpack8(*(const u32x4*)(HALO + ((size_t)(s * 128 + (t0 >> 6)) * 3 + (tt - t0 + 3)) * 1536 + ch), x);
        else if (ok && s >= 8) {
#pragma unroll
            for (int i = 0; i < 8; ++i) x[i] = cv0[((size_t)(s - 8) * 3 + (tt + 3)) * 1536 + ch + i]; }
        else {
#pragma unroll
            for (int i = 0; i < 8; ++i) x[i] = 0.f; }
        const f32x4 w0 = *(const f32x4*)(cw + j * 1536 + ch), w1 = *(const f32x4*)(cw + j * 1536 + ch + 4);
#pragma unroll
        for (int i = 0; i < 4; ++i) { acc[i] += x[i] * w0[i]; acc[4 + i] += x[4 + i] * w1[i]; }
    }
    float ss = 0.f;
#pragma unroll
    for (int i = 0; i < 8; ++i) { y[i] = ok ? siluf_(acc[i]) : 0.f; ss += y[i] * y[i]; }
    if (part < 2) { ss = rowsum16(ss); const float sc = rsqrtf(ss + EPSF) * (part == 0 ? 0.08838834764831845f : 1.f);
#pragma unroll
        for (int i = 0; i < 8; ++i) y[i] *= sc; }
}
__device__ __forceinline__ void delta_gates(const int wv__, float nA, float dtb, float* SC, int r0, int T, int t0, int h, LAS float* GS) {
    const int lane = otid();
    const int t = t0 + lane; float g = 0.f, be = 0.f;
    if (t < T) { const float* sc = SC + (size_t)(r0 + t) * 16; g = nA * softplusf_(sc[h] + dtb); be = sigmoidf_(sc[4 + h]); }
#pragma unroll
    for (int d = 1; d < 64; d <<= 1) { const float o = __shfl_up(g, d); if (lane >= d) g += o; }
    GS[lane] = g; GS[64 + lane] = __expf(g); GS[128 + lane] = be;
    if (t < T) { SC[(size_t)(r0 + t) * 16 + 8 + h] = g; SC[(size_t)(r0 + t) * 16 + 12 + h] = be; }
}
__device__ __forceinline__ void delta_prep_phase(const int wv__, bf16_t* P, const bf16_t* HALO, float* SC, bf16_t* VBWK, LAS unsigned char* lds) {
    const int tid = otid(), lane = tid & 63, wave = tid >> 6;
    LAS bf16_t* Ks = (LAS bf16_t*)lds;
    LAS bf16_t* Vs = Ks + 64 * 136;
    LAS float* Mm = (LAS float*)(lds + 2 * 64 * 136 * 2);
    LAS float* GS = Mm + 64 * 68;
    LAS float* SOL = GS + 192;
    LAS bf16_t* Qs = (LAS bf16_t*)(SOL + 64 * 256);
    const float* cw = inptr(29); const float* cv0 = inptr(5); const float* Alog = inptr(30); const float* dtbp = inptr(31);
    for (int task = blockIdx.x; task < 4160; task += gridDim.x) {
        int s, h, t0; if (task < 4096) { s = task >> 9; h = (task >> 7) & 3; t0 = (task & 127) * 64; } else { const int q = task - 4096; s = 8 + (q >> 2); h = q & 3; t0 = 0; }
        const int T = seq_T(s), r0 = seq_row0(s); const float nA = -__expf(Alog[h]), dtb = dtbp[h];
        if (tid < 64) delta_gates(wv__, nA, dtb, SC, r0, T, t0, h, GS);
#pragma unroll
        for (int it = 0; it < 2; ++it) { const int item = tid + 512 * it, tk = item >> 4, cg = item & 15; float y[8];
            delta_conv8(cw, cv0, P, HALO, s, r0, T, t0, t0 + tk, h, 0, cg, y); *(LAS u32x4*)(Qs + tk * 136 + cg * 8) = pack8(y);
            delta_conv8(cw, cv0, P, HALO, s, r0, T, t0, t0 + tk, h, 1, cg, y); *(LAS u32x4*)(Ks + tk * 136 + cg * 8) = pack8(y);
            delta_conv8(cw, cv0, P, HALO, s, r0, T, t0, t0 + tk, h, 2, cg, y); *(LAS u32x4*)(Vs + tk * 136 + cg * 8) = pack8(y); }
        __syncthreads();
#pragma unroll
        for (int it = 0; it < 2; ++it) { const int item = tid + 512 * it, tk = item >> 4, cg = item & 15;
            if (t0 + tk < T) { bf16_t* pr = P + (size_t)(r0 + t0 + tk) * PE + 1792 + h * 128 + cg * 8;
                *(u32x4*)pr = *(const LAS u32x4*)(Qs + tk * 136 + cg * 8); *(u32x4*)(pr + 512) = *(const LAS u32x4*)(Ks + tk * 136 + cg * 8); } }
#pragma unroll
        for (int i = 0; i < 2; ++i) { const int tile = wave + 8 * i, mi = tile >> 2, ni = tile & 3;
            f32x4 acc = mma_tile(Ks + mi * 16 * 136, 136, Ks + ni * 16 * 136, 136, 128, (f32x4){0.f, 0.f, 0.f, 0.f}, lane);
            const int m = ni * 16 + (lane & 15);
#pragma unroll
            for (int j = 0; j < 4; ++j) { const int l = mi * 16 + (lane >> 4) * 4 + j; Mm[l * 68 + m] = (l > m) ? GS[128 + l] * acc[j] * __expf(GS[l] - GS[m]) : 0.f; } }
        __syncthreads();
        if (tid < 256) {
            const int c = tid;
            for (int l = 0; l < 64; ++l) {
                float r = (c < 128) ? GS[128 + l] * bf2f(Vs[l * 136 + c]) : GS[128 + l] * GS[64 + l] * bf2f(Ks[l * 136 + (c - 128)]);
                const LAS float* Mr = Mm + l * 68;
                int m = 0;
                for (; m + 4 <= l; m += 4) { const f32x4 mv = *(const LAS f32x4*)(Mr + m);
                    r -= (mv[0] * SOL[m * 256 + c] + mv[1] * SOL[(m + 1) * 256 + c]) + (mv[2] * SOL[(m + 2) * 256 + c] + mv[3] * SOL[(m + 3) * 256 + c]); }
                for (; m < l; ++m) r -= Mr[m] * SOL[m * 256 + c];
                SOL[l * 256 + c] = r;
            }
            bf16_t* o = VBWK + (size_t)task * (64 * 256) + c;
            for (int l = 0; l < 64; ++l) o[l * 256] = f2bf(SOL[l * 256 + c]);
        }
        __syncthreads();
    }
}
__device__ __forceinline__ void delta_seq_phase(const int wv__, const bf16_t* P, const float* SC, const bf16_t* VBWK, bf16_t* SLOT, LAS unsigned char* lds) {
    const int tid = otid(), lane = tid & 63, wave = tid >> 6;
    LAS bf16_t* ST = (LAS bf16_t*)lds;
    LAS bf16_t* Wk = ST + 32 * 136;
    LAS bf16_t* Vb = Wk + 64 * 136;
    LAS bf16_t* KdT = Vb + 64 * 40;
    LAS bf16_t* UT = KdT + 128 * 72;
    LAS float* GS = (LAS float*)(UT + 32 * 72);
    const int r16 = lane & 15, q4 = (lane >> 4) * 4;
    const float* Alog = inptr(30); const float* dtbp = inptr(31); const float* dst0 = inptr(6); float* outp = outptr();
    for (int task = blockIdx.x; task < 384; task += gridDim.x) {
        const int hv = task & 3, sh = task >> 2;
        const int s = sh < 32 ? (sh >> 2) : 8 + ((sh - 32) >> 2), h = sh & 3;
        const int T = seq_T(s), r0 = seq_row0(s), nch = (T + 63) >> 6; const float nA = -__expf(Alog[h]), dtb = dtbp[h];
        f32x4 accS[2];
        const float* st0 = dst0 + (size_t)((s - 8) * 4 + h) * 128 * 128;
#pragma unroll
        for (int i = 0; i < 2; ++i) {
#pragma unroll
            for (int j = 0; j < 4; ++j) accS[i][j] = (s >= 8) ? st0[(size_t)(wave * 16 + q4 + j) * 128 + hv * 32 + i * 16 + r16] : 0.f;
            { u32x2 w; w.x = cvt_pk_bf16(accS[i][0], accS[i][1]); w.y = cvt_pk_bf16(accS[i][2], accS[i][3]); *(LAS u32x2*)(ST + (i * 16 + r16) * 136 + wave * 16 + q4) = w; }
        }
        u32x4 Rk[2], vbr[3]; float gsc = 0.f, bsc = 0.f;
#define DQ_LOAD(cc) do { const int t0n = (cc) * 64; const int vt_ = s < 8 ? (s * 4 + h) * 128 + (cc) : 4096 + (s - 8) * 4 + h; \
            _Pragma("unroll") for (int it = 0; it < 2; ++it) { const int item = tid + 512 * it, tk = item & 63, cg = item >> 6; \
                Rk[it] = (t0n + tk < T) ? *(const u32x4*)(P + (size_t)(r0 + t0n + tk) * PE + 1792 + 512 + h * 128 + cg * 8) : (u32x4){0u, 0u, 0u, 0u}; } \
            { const bf16_t* src = VBWK + (size_t)vt_ * (64 * 256); _Pragma("unroll") for (int it = 0; it < 3; ++it) { const int idx = tid + 512 * it, l = idx / 20, ch = idx % 20; \
                if (idx < 1280) vbr[it] = *(const u32x4*)(src + l * 256 + (ch < 4 ? hv * 4 + ch : 12 + ch) * 8); } } \
            if (tid < 64) { const int t = t0n + tid; gsc = 0.f; bsc = 0.f; if (t < T) { const float* sc = SC + (size_t)(r0 + t) * 16; gsc = sc[8 + h]; bsc = sc[12 + h]; } } \
            } while (0)
        DQ_LOAD(0);
        __syncthreads();
        for (int c = 0; c < nch; ++c) {
            const int tid = otid(), lane = tid & 63, wave = tid >> 6, r16 = lane & 15, q4 = (lane >> 4) * 4;
            if (tid < 64) {
                const int nv = min(64, T - c * 64); float g = gsc; const float gl_ = __shfl(g, nv - 1); if (tid >= nv) g = gl_;
                GS[tid] = g; GS[64 + tid] = __expf(g); GS[128 + tid] = bsc;
            }
#pragma unroll
            for (int it = 0; it < 3; ++it) { const int idx = tid + 512 * it, l = idx / 20, ch = idx % 20;
                if (idx < 1280) { if (ch < 4) *(LAS u32x4*)(Vb + l * 40 + ch * 8) = vbr[it]; else *(LAS u32x4*)(Wk + l * 136 + (ch - 4) * 8) = vbr[it]; } }
            if (s < 8) { bf16_t* dst = SLOT + (size_t)((s * 4 + h) * 128 + c) * 16384 + (size_t)(hv * 32) * 128;
                const int r = tid >> 4, ch = tid & 15; *(u32x4*)(dst + r * 128 + ch * 8) = *(const LAS u32x4*)(ST + r * 136 + ch * 8); }
            __syncthreads();
            const float Glast = GS[63];
#pragma unroll
            for (int it = 0; it < 2; ++it) { const int item = tid + 512 * it, tk = item & 63, cg = item >> 6; float y[8]; unpack8(Rk[it], y);
                const float kd = __expf(Glast - GS[tk]);
#pragma unroll
                for (int i = 0; i < 8; ++i) KdT[(cg * 8 + i) * 72 + tk] = f2bf(y[i] * kd); }
            if (c + 1 < nch) DQ_LOAD(c + 1);
            { const int mi = wave >> 1, ni = wave & 1;
                const f32x4 wst = mma_tile(Wk + mi * 16 * 136, 136, ST + ni * 16 * 136, 136, 128, (f32x4){0.f, 0.f, 0.f, 0.f}, lane);
                const int dv = ni * 16 + r16; float u[4];
#pragma unroll
                for (int j = 0; j < 4; ++j) { const int l = mi * 16 + q4 + j; u[j] = bf2f(Vb[l * 40 + dv]) - wst[j]; }
                u32x2 w; w.x = cvt_pk_bf16(u[0], u[1]); w.y = cvt_pk_bf16(u[2], u[3]);
                *(LAS u32x2*)(UT + dv * 72 + mi * 16 + q4) = w; }
            __syncthreads();
            const float gl = __expf(Glast);
#pragma unroll
            for (int i = 0; i < 2; ++i) accS[i] = mma_tile(KdT + wave * 16 * 72, 72, UT + i * 16 * 72, 72, 64, accS[i] * gl, lane);
#pragma unroll
            for (int i = 0; i < 2; ++i) { u32x2 w; w.x = cvt_pk_bf16(accS[i][0], accS[i][1]); w.y = cvt_pk_bf16(accS[i][2], accS[i][3]); *(LAS u32x2*)(ST + (i * 16 + r16) * 136 + wave * 16 + q4) = w; }
            __syncthreads();
        }
#undef DQ_LOAD
        float* so = outp + (s < 8 ? O_PDELTA + (size_t)(s * 4 + h) * 16384 : O_SDELTA + (size_t)((s - 8) * 4 + h) * 16384);
#pragma unroll
        for (int i = 0; i < 2; ++i)
#pragma unroll
            for (int j = 0; j < 4; ++j) so[(size_t)(wave * 16 + q4 + j) * 128 + hv * 32 + i * 16 + r16] = accS[i][j];
        __syncthreads();
    }
}
__device__ __forceinline__ void delta_out_phase(const int wv__, const bf16_t* P, const float* SC, const bf16_t* VBWK, const bf16_t* SLOT, bf16_t* YC, LAS unsigned char* lds) {
    LAS bf16_t* ST = (LAS bf16_t*)lds;
    LAS bf16_t* Qs = ST + 128 * 136;
    LAS bf16_t* Ks = Qs + 64 * 136;
    LAS bf16_t* Wk = Ks + 64 * 136;
    LAS bf16_t* Vb = Wk + 64 * 136;
    LAS bf16_t* UT = Vb + 64 * 136;
    LAS bf16_t* QKm = UT + 128 * 72;
    LAS float* GS = (LAS float*)(QKm + 64 * 72);
    LAS float* Ob = (LAS float*)Wk;
    const float* Alog = inptr(30); const float* dtbp = inptr(31); const float* dnw = inptr(32); const float* dst0 = inptr(6);
    for (int task = blockIdx.x; task < 4160; task += gridDim.x) {
        const int tid = otid(), lane = tid & 63, wave = tid >> 6, r16 = lane & 15, q4 = (lane >> 4) * 4, el = tid >> 3, ecb = (tid & 7) * 16;
        int s, h, c; if (task < 4096) { s = task >> 9; h = (task >> 7) & 3; c = task & 127; } else { const int q = task - 4096; s = 8 + (q >> 2); h = q & 3; c = 0; }
        const int T = seq_T(s), r0 = seq_row0(s), t0 = c * 64; const float nA = -__expf(Alog[h]), dtb = dtbp[h];
        u32x4 zr0 = (u32x4){0u, 0u, 0u, 0u}, zr1 = zr0;
        { const int t = t0 + el; if (t < T) { const bf16_t* p = P + (size_t)(r0 + t) * PE + 3328 + h * 128 + ecb; zr0 = *(const u32x4*)p; zr1 = *(const u32x4*)(p + 8); } }
        if (s < 8) { const bf16_t* src = SLOT + (size_t)task * 16384;
#pragma unroll
            for (int it = 0; it < 4; ++it) { const int idx = tid + 512 * it, r = idx >> 4, ch = idx & 15; *(LAS u32x4*)(ST + r * 136 + ch * 8) = *(const u32x4*)(src + r * 128 + ch * 8); } }
        else { const float* st0 = dst0 + (size_t)((s - 8) * 4 + h) * 128 * 128;
            for (int idx = tid; idx < 128 * 128; idx += 512) { const int dk = idx >> 7, dv = idx & 127; ST[dv * 136 + dk] = f2bf(st0[idx]); } }
#pragma unroll
        for (int it = 0; it < 2; ++it) { const int item = tid + 512 * it, tk = item >> 4, cg = item & 15; const bool ok = t0 + tk < T;
            const bf16_t* pr = P + (size_t)(r0 + t0 + tk) * PE + 1792 + h * 128 + cg * 8;
            *(LAS u32x4*)(Qs + tk * 136 + cg * 8) = ok ? *(const u32x4*)pr : (u32x4){0u, 0u, 0u, 0u}; *(LAS u32x4*)(Ks + tk * 136 + cg * 8) = ok ? *(const u32x4*)(pr + 512) : (u32x4){0u, 0u, 0u, 0u}; }
        { const bf16_t* src = VBWK + (size_t)task * (64 * 256);
#pragma unroll
          for (int it = 0; it < 4; ++it) { const int idx = tid + 512 * it, l = idx >> 5, ch = idx & 31; const u32x4 v = *(const u32x4*)(src + l * 256 + ch * 8);
              if (ch < 16) *(LAS u32x4*)(Vb + l * 136 + ch * 8) = v; else *(LAS u32x4*)(Wk + l * 136 + (ch - 16) * 8) = v; } }
        if (tid < 64) {
            const int t = t0 + tid; float g = 0.f, be = 0.f; const int nv = min(64, T - t0);
            if (t < T) { const float* sc = SC + (size_t)(r0 + t) * 16; g = sc[8 + h]; be = sc[12 + h]; }
            const float gl_ = __shfl(g, nv - 1); if (tid >= nv) g = gl_;
            GS[tid] = g; GS[64 + tid] = __expf(g); GS[128 + tid] = be;
        }
        __syncthreads();
        f32x4 accO[4], wst[4], qkt[2];
#pragma unroll
        for (int i = 0; i < 4; ++i) {
            wst[i] = mma_tile(Wk + i * 16 * 136, 136, ST + wave * 16 * 136, 136, 128, (f32x4){0.f, 0.f, 0.f, 0.f}, lane);
            accO[i] = mma_tile(Qs + i * 16 * 136, 136, ST + wave * 16 * 136, 136, 128, (f32x4){0.f, 0.f, 0.f, 0.f}, lane); }
#pragma unroll
        for (int i = 0; i < 2; ++i) { const int tile = wave + 8 * i, mi = tile >> 2, ni = tile & 3;
            qkt[i] = mma_tile(Qs + mi * 16 * 136, 136, Ks + ni * 16 * 136, 136, 128, (f32x4){0.f, 0.f, 0.f, 0.f}, lane); }
#pragma unroll
        for (int i = 0; i < 4; ++i) {
            const int dv = wave * 16 + r16; float u[4];
#pragma unroll
            for (int j = 0; j < 4; ++j) { const int l = i * 16 + q4 + j; u[j] = bf2f(Vb[l * 136 + dv]) - wst[i][j]; accO[i][j] *= GS[64 + l]; }
            u32x2 w; w.x = cvt_pk_bf16(u[0], u[1]); w.y = cvt_pk_bf16(u[2], u[3]);
            *(LAS u32x2*)(UT + dv * 72 + i * 16 + q4) = w;
        }
#pragma unroll
        for (int i = 0; i < 2; ++i) { const int tile = wave + 8 * i, mi = tile >> 2, ni = tile & 3; const int m = ni * 16 + r16;
#pragma unroll
            for (int j = 0; j < 4; ++j) { const int l = mi * 16 + q4 + j; QKm[l * 72 + m] = f2bf((m <= l) ? qkt[i][j] * __expf(GS[l] - GS[m]) : 0.f); } }
        __syncthreads();
#pragma unroll
        for (int i = 0; i < 4; ++i) accO[i] = mma_tile(QKm + i * 16 * 72, 72, UT + wave * 16 * 72, 72, 64, accO[i], lane);
#pragma unroll
        for (int i = 0; i < 4; ++i)
#pragma unroll
            for (int j = 0; j < 4; ++j) Ob[(i * 16 + q4 + j) * 132 + wave * 16 + r16] = accO[i][j];
        __syncthreads();
        { const int l = el, cb = ecb, t = t0 + l; float o[16], ss = 0.f;
#pragma unroll
          for (int i = 0; i < 4; ++i) { const f32x4 v = *(const LAS f32x4*)(Ob + l * 132 + cb + 4 * i); o[4 * i] = v[0]; o[4 * i + 1] = v[1]; o[4 * i + 2] = v[2]; o[4 * i + 3] = v[3]; ss += (v[0] * v[0] + v[1] * v[1]) + (v[2] * v[2] + v[3] * v[3]); }
          ss = rowsum8(ss); const float rstd = rsqrtf(ss * (1.f / 128.f) + EPSF);
          if (t < T) { const size_t row = (size_t)(r0 + t); float z[16], r[16];
              unpack8(zr0, *(float(*)[8])&z[0]); unpack8(zr1, *(float(*)[8])&z[8]);
#pragma unroll
              for (int i = 0; i < 16; ++i) r[i] = o[i] * rstd * dnw[cb + i] * siluf_(z[i]);
              *(u32x4*)(YC + row * 1024 + 512 + h * 128 + cb) = pack8(*(float(*)[8])&r[0]); *(u32x4*)(YC + row * 1024 + 512 + h * 128 + cb + 8) = pack8(*(float(*)[8])&r[8]); } }
        __syncthreads();
    }
}

template <int DK, bool RET, int MODE>
__device__ __forceinline__ void lin_chunk_task(const int wv__, const bf16_t* P, const float* SC, bf16_t* YC, bf16_t* SBUF, float* DECB, LAS unsigned char* lds, int s, int h, int c) {
    const int tid = otid(), lane = tid & 63, wave = tid >> 6;
    constexpr int LQ = DK + 8, NTK = DK / 16, NS = (8 * NTK) / 8;
    LAS bf16_t* ST = (LAS bf16_t*)lds;
    LAS bf16_t* Qi = ST + 128 * LQ;
    LAS bf16_t* Ki = Qi + 64 * LQ;
    LAS bf16_t* KoT = Ki + 64 * LQ;
    LAS bf16_t* VT = KoT + DK * 72;
    LAS bf16_t* Sc = VT + 128 * 72;
    LAS float* Ob = (LAS float*)(Sc + 64 * 72);
    LAS float* TOT = Ob + 64 * 132;
    const int r16 = lane & 15, q4 = (lane >> 4) * 4;
    const int T = seq_T(s), r0 = seq_row0(s);
    const int slot = s < 8 ? (s * 4 + h) * 128 + c : 4096 + (s - 8) * 4 + h;
    bf16_t* sb = SBUF + (size_t)slot * (DK * 128);
    const int qoff = RET ? 1536 + h * 128 : h * 64, koff = RET ? 2048 + h * 128 : 256 + h * 64, voff = RET ? 2560 + h * 128 : 512 + h * 128, goff = RET ? 3072 + h * 128 : 1024 + h * 128;
    const float lg = RET ? __logf(1.f - exp2f(-5.f - (float)h)) : 0.f;
    const int pc = tid & 63, tg = tid >> 6;
    const int vdv = tid & 127, vtg = tid >> 7;
    const int t0 = c * 64; const int nvalid = min(64, T - t0);
    unsigned qr[8], kr[8], vr[8];
#pragma unroll
    for (int i = 0; i < 8; ++i) { const int tk = tg * 8 + i; unsigned a_ = 0u, b_ = 0u;
        if (tk < nvalid) { const bf16_t* p = P + (size_t)(r0 + t0 + tk) * PO;
            if (RET) { if (MODE == 3) a_ = (unsigned)p[qoff + pc] | ((unsigned)p[qoff + 64 + pc] << 16); b_ = (unsigned)p[koff + pc] | ((unsigned)p[koff + 64 + pc] << 16); }
            else { a_ = (MODE == 3 ? (unsigned)p[qoff + pc] : 0u) | ((unsigned)p[koff + pc] << 16); } }
        qr[i] = a_; kr[i] = b_; }
#pragma unroll
    for (int i = 0; i < 8; ++i) { const int tk = vtg * 16 + 2 * i; unsigned a_ = 0u;
        if (tk < nvalid) a_ = (unsigned)P[(size_t)(r0 + t0 + tk) * PO + voff + vdv];
        if (tk + 1 < nvalid) a_ |= (unsigned)P[(size_t)(r0 + t0 + tk + 1) * PO + voff + vdv] << 16;
        vr[i] = a_; }
    if (MODE == 3) {
#pragma unroll
        for (int it = 0; it < (128 * DK / 8) / 512; ++it) { const int idx = tid + 512 * it, r = idx / (DK / 8), ch = idx % (DK / 8);
            *(LAS u32x4*)(ST + r * LQ + ch * 8) = *(const u32x4*)(sb + r * DK + ch * 8); }
    }
    *(LAS u32x4*)(VT + vdv * 72 + vtg * 16) = (u32x4){vr[0], vr[1], vr[2], vr[3]}; *(LAS u32x4*)(VT + vdv * 72 + vtg * 16 + 8) = (u32x4){vr[4], vr[5], vr[6], vr[7]};
    if (!RET) {
        const int ch = pc; float la[8], run = 0.f;
        const float* a2p = inptr(35); const float abias = inptr(36)[h * 64 + ch];
        float a2c[16];
#pragma unroll
        for (int r = 0; r < 16; ++r) a2c[r] = a2p[r * 256 + h * 64 + ch];
#pragma unroll
        for (int i = 0; i < 8; ++i) { const int tk = tg * 8 + i; float x = 0.f;
            if (tk < nvalid) { const float* sc = SC + (size_t)(r0 + t0 + tk) * 16; float z = abias;
#pragma unroll
                for (int r4 = 0; r4 < 4; ++r4) { const f32x4 sv = *(const f32x4*)(sc + r4 * 4); z += (sv[0] * a2c[r4 * 4] + sv[1] * a2c[r4 * 4 + 1]) + (sv[2] * a2c[r4 * 4 + 2] + sv[3] * a2c[r4 * 4 + 3]); }
                x = -softplusf_(-z) * (1.f / 16.f); }
            run += x; la[i] = run; }
        TOT[tg * 64 + ch] = run;
        __syncthreads();
        float pre = 0.f, tot = 0.f;
#pragma unroll
        for (int g = 0; g < 8; ++g) { const float v = TOT[g * 64 + ch]; tot += v; if (g < tg) pre += v; }
        if (MODE == 1 && tg == 0) DECB[(size_t)slot * 64 + ch] = __expf(tot);
        float ko[8];
#pragma unroll
        for (int i = 0; i < 8; ++i) { const int tk = tg * 8 + i; const float cum = la[i] + pre; const float qv = bflo(qr[i]) * 0.125f, kv = bfhi(qr[i]);
            if (MODE == 3) { Qi[tk * LQ + ch] = f2bf(qv * __expf(cum)); Ki[tk * LQ + ch] = f2bf(kv * __expf(-cum)); }
            else ko[i] = kv * __expf(tot - cum); }
        if (MODE == 1) *(LAS u32x4*)(KoT + ch * 72 + tg * 8) = pack8(ko);
    } else {
        const int pi = pc;
        const float inv = exp2f(-(float)pi * (13.287712379549449f / 64.f));
        const float tot = (float)nvalid * lg;
        float ko1[8], ko2[8];
#pragma unroll
        for (int i = 0; i < 8; ++i) { const int tk = tg * 8 + i;
            const float cum = (float)min(tk + 1, nvalid) * lg;
            const float x1 = bflo(qr[i]), x2 = bfhi(qr[i]), y1 = bflo(kr[i]), y2 = bfhi(kr[i]);
            const float pos = (float)(t0 + tk + (s >= 8 ? 1024 : 0)); const float rev = pos * inv * 0.15915494309189535f; const float fr = rev - floorf(rev);
            const float sn = __builtin_amdgcn_sinf(fr), cs = __builtin_amdgcn_cosf(fr);
            const float k1 = (y1 * cs - y2 * sn) * 0.08838834764831845f, k2 = (y1 * sn + y2 * cs) * 0.08838834764831845f;
            if (MODE == 3) { const float q1 = x1 * cs - x2 * sn, q2 = x1 * sn + x2 * cs; const float ei = __expf(cum), eo = __expf(-cum);
                Qi[tk * LQ + pi] = f2bf(q1 * ei); Qi[tk * LQ + 64 + pi] = f2bf(q2 * ei); Ki[tk * LQ + pi] = f2bf(k1 * eo); Ki[tk * LQ + 64 + pi] = f2bf(k2 * eo); }
            else { const float ek = __expf(tot - cum); ko1[i] = k1 * ek; ko2[i] = k2 * ek; } }
        if (MODE == 1) { *(LAS u32x4*)(KoT + pi * 72 + tg * 8) = pack8(ko1); *(LAS u32x4*)(KoT + (64 + pi) * 72 + tg * 8) = pack8(ko2); }
    }
    __syncthreads();
    if (MODE == 1) {
        f32x4 accS[NS];
#pragma unroll
        for (int i = 0; i < NS; ++i) { const int tile = wave + 8 * i, mi = tile / NTK, ni = tile % NTK;
            accS[i] = mma_tile(KoT + ni * 16 * 72, 72, VT + mi * 16 * 72, 72, 64, (f32x4){0.f, 0.f, 0.f, 0.f}, lane); }
#pragma unroll
        for (int i = 0; i < NS; ++i) { const int tile = wave + 8 * i, mi = tile / NTK, ni = tile % NTK;
            u32x2 w; w.x = cvt_pk_bf16(accS[i][0], accS[i][1]); w.y = cvt_pk_bf16(accS[i][2], accS[i][3]);
            *(u32x2*)(sb + (mi * 16 + r16) * DK + ni * 16 + q4) = w; }
        __syncthreads();
        return;
    }
    const int el = tid >> 3, ecb = (tid & 7) * 16;
    u32x4 zr0 = (u32x4){0u, 0u, 0u, 0u}, zr1 = zr0;
    { const int t = t0 + el; if (t < T) { const bf16_t* p = P + (size_t)(r0 + t) * PO + goff + ecb; zr0 = *(const u32x4*)p; zr1 = *(const u32x4*)(p + 8); } }
    f32x4 accO[4];
#pragma unroll
    for (int i = 0; i < 4; ++i) accO[i] = mma_tile(Qi + i * 16 * LQ, LQ, ST + wave * 16 * LQ, LQ, DK, (f32x4){0.f, 0.f, 0.f, 0.f}, lane);
    f32x4 sct[2];
#pragma unroll
    for (int i = 0; i < 2; ++i) { const int tile = wave + 8 * i, mi = tile >> 2, ni = tile & 3;
        sct[i] = mma_tile(Qi + mi * 16 * LQ, LQ, Ki + ni * 16 * LQ, LQ, DK, (f32x4){0.f, 0.f, 0.f, 0.f}, lane); }
#pragma unroll
    for (int i = 0; i < 2; ++i) { const int tile = wave + 8 * i, mi = tile >> 2, ni = tile & 3; const int m = ni * 16 + r16;
#pragma unroll
        for (int j = 0; j < 4; ++j) { const int l = mi * 16 + q4 + j; Sc[l * 72 + m] = f2bf((m <= l) ? sct[i][j] : 0.f); } }
    __syncthreads();
#pragma unroll
    for (int i = 0; i < 4; ++i) accO[i] = mma_tile(Sc + i * 16 * 72, 72, VT + wave * 16 * 72, 72, 64, accO[i], lane);
#pragma unroll
    for (int i = 0; i < 4; ++i)
#pragma unroll
        for (int j = 0; j < 4; ++j) Ob[(i * 16 + q4 + j) * 132 + wave * 16 + r16] = accO[i][j];
    __syncthreads();
    { const int l = el, cb = ecb, t = t0 + l; float o[16], sm = 0.f;
#pragma unroll
      for (int i = 0; i < 4; ++i) { const f32x4 v = *(const LAS f32x4*)(Ob + l * 132 + cb + 4 * i); o[4 * i] = v[0]; o[4 * i + 1] = v[1]; o[4 * i + 2] = v[2]; o[4 * i + 3] = v[3]; sm += (v[0] + v[1]) + (v[2] + v[3]); }
      float mean = 0.f;
      if (RET) { mean = rowsum8(sm) * (1.f / 128.f); }
      float ss = 0.f;
#pragma unroll
      for (int i = 0; i < 16; ++i) { o[i] -= mean; ss += o[i] * o[i]; }
      ss = rowsum8(ss); const float rstd = rsqrtf(ss * (1.f / 128.f) + EPSF);
      if (t < T) { const size_t row = (size_t)(r0 + t); float z[16], r[16]; const float* gnw = inptr(37);
          unpack8(zr0, *(float(*)[8])&z[0]); unpack8(zr1, *(float(*)[8])&z[8]);
#pragma unroll
          for (int i = 0; i < 16; ++i) r[i] = o[i] * rstd * (RET ? 1.f : gnw[cb + i]) * siluf_(z[i]);
          bf16_t* dst = YC + row * 1024 + (RET ? 512 : 0) + h * 128 + cb;
          *(u32x4*)dst = pack8(*(float(*)[8])&r[0]); *(u32x4*)(dst + 8) = pack8(*(float(*)[8])&r[8]); } }
    __syncthreads();
}
template <int MODE>
__device__ __forceinline__ void odd_chunk_phase(const int wv__, const bf16_t* P, const float* SC, bf16_t* YC, bf16_t* SR, bf16_t* SG, float* DECB, LAS unsigned char* lds) {
    for (int task = blockIdx.x; task < 8320; task += gridDim.x) {
        if (task < 4096) lin_chunk_task<128, true, MODE>(wv__, P, SC, YC, SR, DECB, lds, task >> 9, (task >> 7) & 3, task & 127);
        else if (task < 8192) { const int q = task - 4096; lin_chunk_task<64, false, MODE>(wv__, P, SC, YC, SG, DECB, lds, q >> 9, (q >> 7) & 3, q & 127); }
        else if (task < 8256) { const int q = task - 8192; lin_chunk_task<128, true, MODE>(wv__, P, SC, YC, SR, DECB, lds, 8 + (q >> 2), q & 3, 0); }
        else { const int q = task - 8256; lin_chunk_task<64, false, MODE>(wv__, P, SC, YC, SG, DECB, lds, 8 + (q >> 2), q & 3, 0); }
    }
}
__device__ __forceinline__ void lin_state_scan(const int wv__, bf16_t* SR, bf16_t* SG, const float* DECB) {
    const int gt = blockIdx.x * 512 + otid(), NT = gridDim.x * 512;
    const float* gin = inptr(7); const float* rin = inptr(8); float* outp = outptr();
    for (int it = gt; it < 96 * 2048 + 96 * 1024; it += NT) {
        const bool ret = it < 96 * 2048; const int q = ret ? it : it - 96 * 2048;
        const int DKc = ret ? 128 : 64, per = ret ? 2048 : 1024;
        const int sh = q / per, e = q % per; const int dv = e / (DKc / 8), dk0 = (e % (DKc / 8)) * 8;
        const int s = sh < 32 ? (sh >> 2) : 8 + ((sh - 32) >> 2), h = sh & 3;
        const int nch = s < 8 ? 128 : 1;
        const int slot0 = s < 8 ? (s * 4 + h) * 128 : 4096 + (s - 8) * 4 + h;
        bf16_t* sb = (ret ? SR : SG) + (size_t)slot0 * (DKc * 128) + dv * DKc + dk0;
        float S[8];
        if (s >= 8) { const float* st = (ret ? rin : gin) + (size_t)((s - 8) * 4 + h) * DKc * 128;
#pragma unroll
            for (int i = 0; i < 8; ++i) S[i] = st[(size_t)(dk0 + i) * 128 + dv]; }
        else {
#pragma unroll
            for (int i = 0; i < 8; ++i) S[i] = 0.f; }
        const float dret = ret ? __expf(64.f * __logf(1.f - exp2f(-5.f - (float)h))) : 0.f;
        const float dret1 = ret ? __expf(16.f * __logf(1.f - exp2f(-5.f - (float)h))) : 0.f;
        for (int c0 = 0; c0 < nch; c0 += 8) {
            u32x4 d[8]; f32x4 dcA[8], dcB[8];
#pragma unroll
            for (int u = 0; u < 8; ++u) if (c0 + u < nch) { d[u] = *(const u32x4*)(sb + (size_t)(c0 + u) * (DKc * 128));
                if (!ret) { const float* dp = DECB + (size_t)(slot0 + c0 + u) * 64 + dk0; dcA[u] = *(const f32x4*)dp; dcB[u] = *(const f32x4*)(dp + 4); } }
#pragma unroll
            for (int u = 0; u < 8; ++u) if (c0 + u < nch) {
                float dd[8]; unpack8(d[u], dd);
                *(u32x4*)(sb + (size_t)(c0 + u) * (DKc * 128)) = pack8(S);
#pragma unroll
                for (int i = 0; i < 8; ++i) { const float dec = ret ? (s < 8 ? dret : dret1) : (i < 4 ? dcA[u][i] : dcB[u][i - 4]); S[i] = S[i] * dec + dd[i]; } }
        }
        float* so = outp + (ret ? (s < 8 ? O_PRET + (size_t)(s * 4 + h) * 16384 : O_SRET + (size_t)((s - 8) * 4 + h) * 16384)
                                : (s < 8 ? O_PGLA + (size_t)(s * 4 + h) * 8192 : O_SGLA + (size_t)((s - 8) * 4 + h) * 8192));
#pragma unroll
        for (int i = 0; i < 8; ++i) so[(size_t)(dk0 + i) * 128 + dv] = S[i];
    }
}

__device__ __forceinline__ void kv_convert(const int wv__, int layer, bf16_t* KB, bf16_t* VTB, LAS unsigned char* lds) {
    const int tid = otid(), lane = tid & 63, wave = tid >> 6;
    const int gt = blockIdx.x * 512 + tid, NT = gridDim.x * 512;
    const float* outp = outptr(); const float* ck = inptr(9); const float* cv = inptr(10);
    for (int it = gt; it < 96 * 256 * 32; it += NT) {
        const int sh = it >> 13, r = it & 8191; const int s = sh >> 2, h = sh & 3, mem = r >> 5, c8 = (r & 31) * 8;
        const float* kb = (s < 8 ? outp + O_PMK + (size_t)layer * 2097152 + (size_t)s * 262144 : ck + (size_t)layer * 4194304 + (size_t)(s - 8) * 262144) + (size_t)mem * 1024 + h * 256 + c8;
        const f32x4 a = *(const f32x4*)kb, b = *(const f32x4*)(kb + 4);
        u32x4 w; w.x = cvt_pk_bf16(a[0], a[1]); w.y = cvt_pk_bf16(a[2], a[3]); w.z = cvt_pk_bf16(b[0], b[1]); w.w = cvt_pk_bf16(b[2], b[3]);
        *(u32x4*)(KB + (size_t)sh * 65536 + mem * 256 + c8) = w;
    }
    LAS float* scr = (LAS float*)(lds + wave * 8704);
    const int gw = blockIdx.x * 8 + wave, NGW = gridDim.x * 8;
    for (int it = gw; it < 96 * 32; it += NGW) { const int sh = it >> 5, r = it & 31, kb = r >> 3, nb = r & 7; const int s = sh >> 2, h = sh & 3;
        const float* vb = (s < 8 ? outp + O_PMV + (size_t)layer * 2097152 + (size_t)s * 262144 : cv + (size_t)layer * 4194304 + (size_t)(s - 8) * 262144) + h * 256;
        cvt_item(vb, 1024, 32 * nb, 64 * kb, VTB + (size_t)sh * 65536 + (size_t)(32 * nb) * 256, 256, nullptr, scr, lane); }
}
__device__ __forceinline__ void attn_phase(const int wv__, const bf16_t* Q, const bf16_t* KB, const bf16_t* VTB, bf16_t* O, LAS unsigned char* lds) {
    const int tid = otid(), lane = tid & 63, wave = tid >> 6, r16 = lane & 15, q4 = (lane >> 4) * 4;
    LAS bf16_t* QP = (LAS bf16_t*)lds;
    LAS bf16_t* KV = QP + 128 * 264;
    for (int unit = blockIdx.x; unit < 2112; unit += gridDim.x) {
        int s, h, row_base, nrows;
        if (unit < 2048) { s = unit >> 8; h = (unit >> 6) & 3; row_base = s * 8192 + (unit & 63) * 128; nrows = 128; } else { const int q = unit - 2048; s = 8 + (q >> 2); h = q & 3; row_base = MP + (s - 8) * 16; nrows = 16; }
        const bf16_t* kb = KB + (size_t)(s * 4 + h) * 65536; const bf16_t* vt = VTB + (size_t)(s * 4 + h) * 65536;
#pragma unroll
        for (int it = 0; it < 8; ++it) { const int idx = tid + 512 * it, r = idx >> 5, ch = idx & 31;
            u32x4 v = (u32x4){0u, 0u, 0u, 0u}; if (r < nrows) v = *(const u32x4*)(Q + (size_t)(row_base + r) * 1024 + h * 256 + ch * 8);
            *(LAS u32x4*)(QP + r * 264 + ch * 8) = v; }
        f32x4 accS[16];
#pragma unroll
        for (int hf = 0; hf < 2; ++hf) {
#pragma unroll
            for (int it = 0; it < 8; ++it) { const int idx = tid + 512 * it, r = idx >> 5, ch = idx & 31; *(LAS u32x4*)(KV + r * 264 + ch * 8) = *(const u32x4*)(kb + (size_t)(hf * 128 + r) * 256 + ch * 8); }
            __syncthreads();
#pragma unroll
            for (int ni = 0; ni < 8; ++ni) accS[hf * 8 + ni] = mma_tile(QP + wave * 16 * 264, 264, KV + ni * 16 * 264, 264, 256, (f32x4){0.f, 0.f, 0.f, 0.f}, lane);
            __syncthreads();
        }
        float mx[4], sm[4];
#pragma unroll
        for (int j = 0; j < 4; ++j) { float m = accS[0][j];
#pragma unroll
            for (int ni = 1; ni < 16; ++ni) m = fmaxf(m, accS[ni][j]);
            mx[j] = rowmax16(m); sm[j] = 0.f; }
#pragma unroll
        for (int ni = 0; ni < 16; ++ni)
#pragma unroll
            for (int j = 0; j < 4; ++j) { const float p = __expf((accS[ni][j] - mx[j]) * 0.0625f); accS[ni][j] = p; sm[j] += p; }
#pragma unroll
        for (int j = 0; j < 4; ++j) sm[j] = __builtin_amdgcn_rcpf(rowsum16(sm[j]));
#pragma unroll
        for (int ni = 0; ni < 16; ++ni)
#pragma unroll
            for (int j = 0; j < 4; ++j) QP[(wave * 16 + q4 + j) * 264 + ni * 16 + r16] = f2bf(accS[ni][j] * sm[j]);
        f32x4 accO[16];
#pragma unroll
        for (int ni = 0; ni < 16; ++ni) accO[ni] = (f32x4){0.f, 0.f, 0.f, 0.f};
#pragma unroll
        for (int hf = 0; hf < 2; ++hf) {
#pragma unroll
            for (int it = 0; it < 8; ++it) { const int idx = tid + 512 * it, r = idx >> 4, ch = idx & 15; *(LAS u32x4*)(KV + r * 136 + ch * 8) = *(const u32x4*)(vt + (size_t)r * 256 + hf * 128 + ch * 8); }
            __syncthreads();
#pragma unroll
            for (int ni = 0; ni < 16; ++ni) accO[ni] = mma_tile(QP + wave * 16 * 264 + hf * 128, 264, KV + ni * 16 * 136, 136, 128, accO[ni], lane);
            __syncthreads();
        }
#pragma unroll
        for (int ni = 0; ni < 16; ++ni)
#pragma unroll
            for (int j = 0; j < 4; ++j) { const int r = wave * 16 + q4 + j; if (r < nrows) O[(size_t)(row_base + r) * 1024 + h * 256 + ni * 16 + r16] = f2bf(accO[ni][j]); }
    }
}

__device__ __forceinline__ void prologue_phase(const int wv__, bf16_t* WT, bf16_t* AMEM, LAS unsigned char* lds) {
    const int tid = otid(), lane = tid & 63, wave = tid >> 6, gw = blockIdx.x * 8 + wave, NGW = gridDim.x * 8;
    LAS float* scr = (LAS float*)(lds + wave * 8704);
    int cum = 0;
    for (int l = 0; l < 2; ++l) {
        cvt_ffn_up(inptr(12) + (size_t)l * D * FF, inptr(13) + (size_t)l * D * FF, nullptr, WT + E_F1U + (size_t)l * 5632 * 1024, scr, lane, gw, NGW, cum);
        cvt_seg(inptr(14) + (size_t)l * FF * D, D, 0, D, FF, WT + E_F1D + (size_t)l * 1024 * 2816, nullptr, scr, lane, gw, NGW, cum);
        cvt_ffn_up(inptr(45) + (size_t)l * D * FF, inptr(46) + (size_t)l * D * FF, nullptr, WT + E_F2U + (size_t)l * 5632 * 1024, scr, lane, gw, NGW, cum);
        cvt_seg(inptr(47) + (size_t)l * FF * D, D, 0, D, FF, WT + E_F2D + (size_t)l * 1024 * 2816, nullptr, scr, lane, gw, NGW, cum);
        cvt_seg(inptr(40) + (size_t)l * D * D, D, 0, D, D, WT + E_WQ + (size_t)l * D * D, inptr(38) + l * D, scr, lane, gw, NGW, cum);
        cvt_seg(inptr(43) + (size_t)l * D * D, D, 0, D, D, WT + E_WO + (size_t)l * D * D, nullptr, scr, lane, gw, NGW, cum);
        cvt_seg(inptr(41) + (size_t)l * D * D, D, 0, D, D, WT + E_MKV + (size_t)(2 * l) * D * D, inptr(39) + l * D, scr, lane, gw, NGW, cum);
        cvt_seg(inptr(42) + (size_t)l * D * D, D, 0, D, D, WT + E_MKV + (size_t)(2 * l + 1) * D * D, inptr(39) + l * D, scr, lane, gw, NGW, cum);
    }
    cvt_seg(inptr(16), 3848, 0, 1792, D, WT + E_EIN, inptr(15), scr, lane, gw, NGW, cum);
    cvt_seg(inptr(16), 3848, 1792, 1536, D, WT + E_EIN + 1792ull * D, inptr(15), scr, lane, gw, NGW, cum);
    cvt_seg(inptr(16), 3848, 3336, 512, D, WT + E_EIN + 3328ull * D, inptr(15), scr, lane, gw, NGW, cum);
    cvt_seg(inptr(17), D, 0, D, D, WT + E_EOUT, nullptr, scr, lane, gw, NGW, cum);
    cvt_seg(inptr(33), 3600, 0, 1024, D, WT + E_OIN, inptr(15) + D, scr, lane, gw, NGW, cum);
    cvt_seg(inptr(33), 3600, 1040, 2560, D, WT + E_OIN + 1024ull * D, inptr(15) + D, scr, lane, gw, NGW, cum);
    cvt_seg(inptr(34), D, 0, D, D, WT + E_OOUT, nullptr, scr, lane, gw, NGW, cum);
    const int gt = blockIdx.x * 512 + tid, NTH = gridDim.x * 512;
    const float* w2p = inptr(20); const float* a2p = inptr(22); const float* g2p = inptr(23);
    for (int i = gt; i < 1024 * 256; i += NTH) { const int n = i >> 8, k = i & 255; float v = 0.f;
        if (n < 512) { if (k < 64) v = w2p[(size_t)k * 512 + n]; } else { if (k >= 64 && k < 128) v = a2p[(size_t)(k - 64) * 512 + (n - 512)]; }
        WT[E_LR1 + i] = f2bf(v); }
    for (int i = gt; i < 512 * 256; i += NTH) { const int n = i >> 8, k = i & 255; WT[E_LR2 + i] = f2bf(k >= 128 ? g2p[(size_t)(k - 128) * 512 + n] : 0.f); }
    { const float* we = inptr(16); const float* wo = inptr(33); const float* nm = inptr(15);
      for (int i = gt; i < 256 * 1024; i += NTH) { const int n = i >> 10, k = i & 1023;
          WT[E_EIN + 3840ull * D + i] = f2bf(n < 8 ? we[(size_t)k * 3848 + 3328 + n] * nm[k] : 0.f);
          WT[E_OIN + 3584ull * D + i] = f2bf(n < 16 ? wo[(size_t)k * 3600 + 1024 + n] * nm[D + k] : 0.f); } }
    const float* memp = inptr(2);
    for (int row = gw; row < 2048; row += NGW) {
        const float* src = memp + (size_t)row * D; f32x4 v[4]; float ss = 0.f;
#pragma unroll
        for (int j = 0; j < 4; ++j) { v[j] = *(const f32x4*)(src + (lane + 64 * j) * 4); ss += (v[j][0] * v[j][0] + v[j][1] * v[j][1]) + (v[j][2] * v[j][2] + v[j][3] * v[j][3]); }
        const float rstd = rsqrtf(wave_sum(ss) * (1.f / D) + EPSF);
#pragma unroll
        for (int j = 0; j < 4; ++j) { u32x2 o; o.x = cvt_pk_bf16(v[j][0] * rstd, v[j][1] * rstd); o.y = cvt_pk_bf16(v[j][2] * rstd, v[j][3] * rstd); *(u32x2*)(AMEM + (size_t)row * D + (lane + 64 * j) * 4) = o; }
    }
}
__device__ __forceinline__ void norm_xb_phase(const int wv__, const bf16_t* XBp, const bf16_t* RSPp, bf16_t* H, const float* w) {
    const int lane = otid() & 63, wave = otid() >> 6, gw = blockIdx.x * 8 + wave, NGW = gridDim.x * 8;
    f32x4 wv[4];
#pragma unroll
    for (int j = 0; j < 4; ++j) wv[j] = *(const f32x4*)(w + lane * 16 + j * 4);
    for (int row = gw; row < MT; row += NGW) {
        const u32x4 a = *(const u32x4*)(XBp + (size_t)row * D + lane * 16), b = *(const u32x4*)(XBp + (size_t)row * D + lane * 16 + 8);
        const float rs = row_rstd(RSPp, (size_t)row);
        float x[16], o[16]; unpack8(a, *(float(*)[8])&x[0]); unpack8(b, *(float(*)[8])&x[8]);
#pragma unroll
        for (int i = 0; i < 16; ++i) o[i] = x[i] * rs * wv[i >> 2][i & 3];
        *(u32x4*)(H + (size_t)row * D + lane * 16) = pack8(*(float(*)[8])&o[0]); *(u32x4*)(H + (size_t)row * D + lane * 16 + 8) = pack8(*(float(*)[8])&o[8]);
    }
}
__device__ __forceinline__ void final_norm_phase(const int wv__, float* X, const float* w) {
    const int lane = otid() & 63, wave = otid() >> 6, gw = blockIdx.x * 8 + wave, NGW = gridDim.x * 8;
    f32x4 wv[4];
#pragma unroll
    for (int j = 0; j < 4; ++j) wv[j] = *(const f32x4*)(w + (lane + 64 * j) * 4);
    for (int row = gw; row < MT; row += NGW) {
        float* p = X + (size_t)row * D; f32x4 v[4]; float ss = 0.f;
#pragma unroll
        for (int j = 0; j < 4; ++j) { v[j] = *(const f32x4*)(p + (lane + 64 * j) * 4); ss += (v[j][0] * v[j][0] + v[j][1] * v[j][1]) + (v[j][2] * v[j][2] + v[j][3] * v[j][3]); }
        const float rstd = rsqrtf(wave_sum(ss) * (1.f / D) + EPSF);
#pragma unroll
        for (int j = 0; j < 4; ++j) *(f32x4*)(p + (lane + 64 * j) * 4) = v[j] * rstd * wv[j];
    }
}

#define XB_TMO      128
#define XB_XCNT(j)  (256  + 64 * (j))
#define XB_XSUB(j)  (1280 + 64 * (j))
#define XB_XGEN(j)  (2304 + 64 * (j))
#define XB_TOP      3328
#define XB_TOPGEN   3392
#define XCD_BAR_WORDS 3456
#define XB_SPIN_CAP (1u << 21)

__device__ __forceinline__ unsigned xb_ld(unsigned* p)              { return __hip_atomic_load(p, __ATOMIC_RELAXED, __HIP_MEMORY_SCOPE_AGENT); }
__device__ __forceinline__ unsigned xb_add(unsigned* p, unsigned v) { return __hip_atomic_fetch_add(p, v, __ATOMIC_RELAXED, __HIP_MEMORY_SCOPE_AGENT); }
__device__ __forceinline__ unsigned xb_xcc_id() { return (unsigned)__builtin_amdgcn_s_getreg((3 << 11) | 20) & 0xFu; }
#define XB_SPIN(cond, bar) do { unsigned _sp = 0; while (cond) { __builtin_amdgcn_s_sleep(4); \
    if ((++_sp & 255u) == 0u) { if (xb_ld(&(bar)[XB_TMO])) break; if (_sp > XB_SPIN_CAP) { atomicAdd(&(bar)[XB_TMO], 1u); break; } } } } while (0)

struct XcdBarrier {
    unsigned* bar; unsigned x;
    volatile LAS unsigned* st;
};

__device__ __forceinline__ XcdBarrier xcd_barrier_post(unsigned* bar, volatile LAS unsigned* st) {
    XcdBarrier b; b.bar = bar; b.x = xb_xcc_id(); b.st = st;
    if (threadIdx.x == 0) (void)xb_add(&bar[XB_XCNT(b.x)], 1u);
    return b;
}
__device__ __forceinline__ void xcd_barrier_complete(unsigned* bar, unsigned x, unsigned& nloc, unsigned& nx) {
    const unsigned G = gridDim.x * gridDim.y * gridDim.z;
    unsigned sum, cnt, mine, sp = 0u;
    for (;;) {
        sum = 0u; cnt = 0u; mine = 0u;
#pragma unroll
        for (unsigned j = 0; j < 16; ++j) { const unsigned c = xb_ld(&bar[XB_XCNT(j)]); sum += c; cnt += (c > 0u) ? 1u : 0u; mine = (j == x) ? c : mine; }
        if (sum == G) break;
        __builtin_amdgcn_s_sleep(4);
        if ((++sp & 255u) == 0u) { if (xb_ld(&bar[XB_TMO])) break; if (sp > XB_SPIN_CAP) { atomicAdd(&bar[XB_TMO], 1u); break; } }
    }
    nloc = mine > 0u ? mine : 1u; nx = cnt > 0u ? cnt : 1u;
}

__device__ __forceinline__ void xcd_barrier(const XcdBarrier& b) {
    asm volatile("s_waitcnt vmcnt(0)" ::: "memory");
    __syncthreads();
    if (threadIdx.x == 0) {
        unsigned* bar = b.bar;
        __builtin_amdgcn_s_waitcnt(0);
        unsigned nloc = b.st[0], nx = b.st[1];
        if (nloc == 0u) { xcd_barrier_complete(bar, b.x, nloc, nx); b.st[0] = nloc; b.st[1] = nx; }
        const unsigned old = xb_add(&bar[XB_XSUB(b.x)], 1u);
        const unsigned gen = old / nloc;
        if (old + 1u == (gen + 1u) * nloc) {
            __builtin_amdgcn_fence(__ATOMIC_RELEASE, "agent");
            asm volatile("s_waitcnt vmcnt(0)" ::: "memory");
            const unsigned og = xb_add(&bar[XB_TOP], 1u);
            const unsigned tg = og / nx;
            if (og + 1u == (tg + 1u) * nx) xb_add(&bar[XB_TOPGEN], 1u);
            else XB_SPIN(xb_ld(&bar[XB_TOPGEN]) == tg, bar);
            __builtin_amdgcn_fence(__ATOMIC_ACQUIRE, "agent");
            xb_add(&bar[XB_XGEN(b.x)], 1u);
            asm volatile("s_waitcnt vmcnt(0)" ::: "memory");
        } else {
            XB_SPIN(xb_ld(&bar[XB_XGEN(b.x)]) == gen, bar);
            __builtin_amdgcn_fence(__ATOMIC_ACQUIRE, "agent");
            asm volatile("s_waitcnt vmcnt(0)" ::: "memory");
        }
    }
    __syncthreads();
}

#define WT ((bf16_t*)(wsptr() + WS_WT))
#define AMEM ((bf16_t*)(wsptr() + WS_AMEM))
#define SC ((float*)(wsptr() + WS_SC))
#define BONUS ((float*)(wsptr() + WS_BONUS))
#define HY ((bf16_t*)(wsptr() + WS_HY))
#define BIG ((bf16_t*)(wsptr() + WS_BIG))
#define LREA ((bf16_t*)(wsptr() + WS_LREA))
#define VBWK ((bf16_t*)(wsptr() + WS_VBWK))
#define AP ((bf16_t*)(wsptr() + WS_AP))
#define KB ((bf16_t*)(wsptr() + WS_KB))
#define VTB ((bf16_t*)(wsptr() + WS_VTB))
#define X (outptr())
#ifndef SITE_MASK
#define SITE_MASK 0xffffffffffffffffull
#endif
#ifndef DUP_MASK
#define DUP_MASK 0ull
#endif
#define GSYNC() do { if (ph == lo + 1) { grid.sync(); bar = xcd_barrier_post((unsigned*)(wsptr() + WS_BAR), (volatile LAS unsigned*)(lds + LDS_BYTES - 16)); } else xcd_barrier(bar); } while (0)
#define PHASE(...) do { if (ph >= lo && ph < hi) { if (ph > lo) GSYNC(); { __VA_ARGS__ } if ((DUP_MASK >> ph) & 1ull) { xcd_barrier(bar); { __VA_ARGS__ } } } ++ph; } while (0)

#define XB LREA
#define RSP ((bf16_t*)(wsptr() + WS_BONUS))
template <int l> __device__ __forceinline__ void layer_phases(const int wv__, cg::grid_group& grid, XcdBarrier& bar, int& ph, const int lo, const int hi, LAS unsigned char* lds) {
        if (l == 0) PHASE({ { EpiMemKV E{outptr() + O_PMK}; run_gemm(wv__, lds, AMEM, WT + E_MKV, 2048, 4096, D, E); }
                            EpiSwiglu E{BIG, nullptr}; run_gemm(wv__, lds, HY, WT + E_F1U, MT, 5632, D, E); });
        else { PHASE({ norm_xb_phase(wv__, XB, RSP, HY, inptr(11) + l * D); });
               PHASE({ EpiSwiglu E{BIG, nullptr}; run_gemm(wv__, lds, HY, WT + E_F1U + (size_t)l * 5632 * 1024, MT, 5632, D, E); }); }
        PHASE({ EpiResid E{X, 0.5f, XB, RSP}; run_gemm(wv__, lds, BIG, WT + E_F1D + (size_t)l * 1024 * 2816, MT, D, FF, E); });
        if (l == 0) {
            PHASE({ EpiBf16 E{BIG, PE, RSP, SC, 15}; run_gemm(wv__, lds, XB, WT + E_EIN, MT, PE + 256, D, E); });
            PHASE({ rwkv_prep_phase(wv__, BIG, AP, (bf16_t*)(wsptr() + WS_HALO)); });
            PHASE({ { EpiLR1 E{LREA, inptr(19), inptr(21)}; run_gemm(wv__, lds, AP, WT + E_LR1, MT, 1024, 256, E); }
                    { EpiBf16 E{HY + 512, 1024, nullptr, nullptr, -1}; run_gemm(wv__, lds, AP, WT + E_LR2, MT, 512, 256, E); }
                    delta_prep_phase(wv__, BIG, (const bf16_t*)(wsptr() + WS_HALO), SC, VBWK, lds); });
            PHASE({ rwkv_scan_phase(wv__, BIG, LREA, HY, BONUS, lds); });
            PHASE({ rwkv_post_phase(wv__, BIG, HY + 512, BONUS, HY); delta_seq_phase(wv__, BIG, SC, VBWK, LREA, lds); });
            PHASE({ delta_out_phase(wv__, BIG, SC, VBWK, LREA, HY, lds); });
            PHASE({ EpiResid E{X, 1.f, XB, RSP}; run_gemm(wv__, lds, HY, WT + E_EOUT, MT, D, D, E); });
        } else {
            PHASE({ EpiBf16 E{BIG, PO, RSP, SC, 14}; run_gemm(wv__, lds, XB, WT + E_OIN, MT, PO + 256, D, E); });
            PHASE({ odd_chunk_phase<1>(wv__, BIG, SC, HY, VBWK, LREA, (float*)AP, lds); });
            PHASE({ lin_state_scan(wv__, VBWK, LREA, (const float*)AP); });
            PHASE({ odd_chunk_phase<3>(wv__, BIG, SC, HY, VBWK, LREA, (float*)AP, lds); });
            PHASE({ EpiResid E{X, 1.f, XB, RSP}; run_gemm(wv__, lds, HY, WT + E_OOUT, MT, D, D, E); });
        }
        PHASE({ kv_convert(wv__, l, KB, VTB, lds); __syncthreads(); EpiBf16 E{BIG, 1024, RSP, nullptr, -1}; run_gemm(wv__, lds, XB, WT + E_WQ + (size_t)l * D * D, MT, D, D, E); });
        PHASE({ attn_phase(wv__, BIG, KB, VTB, HY, lds); });
        PHASE({ EpiResid E{X, 1.f, XB, RSP}; run_gemm(wv__, lds, HY, WT + E_WO + (size_t)l * D * D, MT, D, D, E); });
        PHASE({ norm_xb_phase(wv__, XB, RSP, HY, inptr(44) + l * D); });
        PHASE({ EpiSwiglu E{BIG, nullptr}; run_gemm(wv__, lds, HY, WT + E_F2U + (size_t)l * 5632 * 1024, MT, 5632, D, E); });
        PHASE({ EpiResid E{X, 0.5f, XB, RSP}; run_gemm(wv__, lds, BIG, WT + E_F2D + (size_t)l * 1024 * 2816, MT, D, FF, E); });
}
constexpr int NPHASE = 31;
__global__ void __launch_bounds__(512, 2) hybrid_fwd(Args a) {
    extern __shared__ __attribute__((aligned(16))) unsigned char lds_raw[];
    LAS unsigned char* lds = (LAS unsigned char*)lds_raw;
    cg::grid_group grid = cg::this_grid();
    const int wv__ = __builtin_amdgcn_readfirstlane((int)(threadIdx.x >> 6));
    const int lo = a.ph_lo, hi = a.ph_hi;
    int ph = 0;
    if (threadIdx.x < 4) ((LAS unsigned*)(lds + LDS_BYTES - 16))[threadIdx.x] = 0u;
    if (blockIdx.x == 0) { unsigned* bw = (unsigned*)(wsptr() + WS_BAR); for (int i = threadIdx.x; i < 3456; i += 512) bw[i] = 0u; }
    __syncthreads();
    XcdBarrier bar; bar.bar = nullptr; bar.x = 0; bar.st = nullptr;
    PHASE({ prologue_phase(wv__, WT, AMEM, lds); __syncthreads(); norm_phase<true, 0>(wv__, inptr(0), inptr(1), X, HY, inptr(11), nullptr, 0, 0, nullptr, lds); });
#ifdef TEST_ORDER
    PHASE({ if (blockIdx.x == 0) { const long long t0 = wall_clock64(); while (wall_clock64() - t0 < 300000) __builtin_amdgcn_s_sleep(64);
            float* xo = X; for (int i = otid(); i < 1024; i += 512) xo[i] = 1.0f; } });
    PHASE({ float* xo = X; const float v = ((volatile float*)xo)[0] + 1.0f; const int gt = blockIdx.x * 512 + otid(); for (size_t i = 1024 + gt; i < (size_t)MT * 1024; i += (size_t)gridDim.x * 512) xo[i] = v; });
    return;
#endif
    layer_phases<0>(wv__, grid, bar, ph, lo, hi, lds);
    layer_phases<1>(wv__, grid, bar, ph, lo, hi, lds);
#ifdef EXTRA_SYNCS
    for (int i = 0; i < EXTRA_SYNCS; ++i) grid.sync();
#endif
    PHASE({ final_norm_phase(wv__, X, inptr(48)); });
#undef PHASE
}

extern "C" void kernel_launch(void* const* d_in, const int* in_sizes, int n_in, void* d_out, int out_size, void* d_ws, size_t ws_size, hipStream_t stream) {
    static int grid = 0;
    if (grid == 0) {
        int dev = 0, cus = 0, per_cu = 0;
        hipGetDevice(&dev);
        hipDeviceGetAttribute(&cus, hipDeviceAttributeMultiprocessorCount, dev);
        if (hipFuncSetAttribute((const void*)hybrid_fwd, hipFuncAttributeMaxDynamicSharedMemorySize, LDS_BYTES) != hipSuccess) fprintf(stderr, "kernel_launch: hipFuncSetAttribute failed\n");
        if (hipOccupancyMaxActiveBlocksPerMultiprocessor(&per_cu, (const void*)hybrid_fwd, 512, LDS_BYTES) != hipSuccess || per_cu < 1) { fprintf(stderr, "kernel_launch: occupancy query says %d\n", per_cu); per_cu = 1; }
        (void)hipGetLastError();
        grid = cus > 0 ? cus : 256;
        if (n_in != 49 || (size_t)out_size != O_END || ws_size < WS_END) fprintf(stderr, "kernel_launch: unexpected sizes n_in %d out %d ws %zu (need %zu)\n", n_in, out_size, ws_size, (size_t)WS_END);
    }
#ifdef DBG_MEMSET
    (void)hipMemsetAsync(d_ws, 0, WS_END, stream);
#endif
    Args a{};
    for (int i = 0; i < 49; ++i) a.in[i] = (const float*)d_in[i];
    a.out = (float*)d_out; a.ws = (unsigned char*)d_ws;
#ifndef N_LAUNCH_PER_PHASE
    a.ph_lo = 0; a.ph_hi = NPHASE;
    void* args[] = {&a};
    hipError_t e = hipLaunchCooperativeKernel((const void*)hybrid_fwd, dim3(grid), dim3(512), args, LDS_BYTES, stream);
    if (e != hipSuccess) fprintf(stderr, "cooperative launch failed: %s (grid %d)\n", hipGetErrorString(e), grid);
#else
#ifndef PH_STOP
#define PH_STOP NPHASE
#endif
    for (int p = 0; p < PH_STOP; ++p) {
        a.ph_lo = p; a.ph_hi = p + 1;
        void* args[] = {&a};
        hipError_t e = hipLaunchCooperativeKernel((const void*)hybrid_fwd, dim3(grid), dim3(512), args, LDS_BYTES, stream);
        if (e != hipSuccess) { fprintf(stderr, "cooperative launch %d failed: %s (grid %d)\n", p, hipGetErrorString(e), grid); break; }
    }
#endif
}
```

```cpp
#include <hip/hip_runtime.h>
#include <hip/hip_cooperative_groups.h>
#include <cstdio>
#include <cstdint>
namespace cg = cooperative_groups;

#define LAS __attribute__((address_space(3)))
typedef unsigned short bf16_t;
typedef short bf16x8 __attribute__((ext_vector_type(8)));
typedef float f32x4 __attribute__((ext_vector_type(4)));
typedef float f32x2 __attribute__((ext_vector_type(2)));
typedef unsigned u32x4 __attribute__((ext_vector_type(4)));
typedef unsigned u32x2 __attribute__((ext_vector_type(2)));

#define otid() otid_(wv__)
__device__ __forceinline__ int otid_(int wv) { int t = (wv << 6) | (int)__builtin_amdgcn_mbcnt_hi(~0u, __builtin_amdgcn_mbcnt_lo(~0u, 0u)); asm volatile("" : "+v"(t)); return t; }
namespace pg8 {
constexpr int BM = 256, BK = 64, HALF = 128, HTB = HALF * BK * 2, STAGE_BYTES = 8 * HTB, NXCD = 8, WGM = 8;
__host__ __device__ __forceinline__ int lds_byte(int r, int c) { const int st = (r >> 4) * 2 + (c >> 5), rr = r & 15, cc = c & 31, ob = rr * 64 + cc * 2; return st * 1024 + (ob ^ (((ob >> 9) & 1) << 5)); }
__host__ __device__ __forceinline__ void stage_rc(int b, int& R, int& C) { const int st = b / 1024, sb = b % 1024, swz = sb ^ (((sb >> 9) & 1) << 5); R = (st >> 1) * 16 + swz / 64; C = (st & 1) * 32 + (swz % 64) / 2; }
__host__ __device__ __forceinline__ int perm32(int rho) { const int n = rho >> 4, i = rho & 15; return 8 * (i >> 2) + 4 * n + (i & 3); }
struct Unit { int pm, pn; };
struct Gemm { const bf16_t* A; const bf16_t* Bt; int M, N, K; };
struct StaticOrder {
    int nM, nN, nwg, G, c;
    __device__ void init(int M, int N, int G_, int c_) { nM = M / BM; nN = N / BM; nwg = nM * nN; G = G_; c = c_; }
    __device__ bool next(int i, Unit& u) const {
        const long L = (long)i * G + c; if (L >= nwg) return false;
        int wgid = (int)L; { const int q = nwg / NXCD, r = nwg % NXCD, xcd = wgid % NXCD, off = wgid / NXCD; wgid = (xcd < r ? xcd * (q + 1) : r * (q + 1) + (xcd - r) * q) + off; }
        const int nig = WGM * nN, gid = wgid / nig, fm = gid * WGM, gsz = (nM - fm) < WGM ? (nM - fm) : WGM;
        u.pm = fm + ((wgid % nig) % gsz); u.pn = (wgid % nig) / gsz; return true;
    }
};
typedef __bf16 bf16n2 __attribute__((ext_vector_type(2)));
typedef float f32n2 __attribute__((ext_vector_type(2)));
__device__ __forceinline__ unsigned cvt_pk_bf16(float lo, float hi) { const f32n2 v = {lo, hi}; const bf16n2 r = __builtin_convertvector(v, bf16n2); return __builtin_bit_cast(unsigned, r); }

template <class Epi>
__device__ __forceinline__ void gemm_phase(const int wv__, LAS unsigned char* lds, const Gemm g, const StaticOrder& S, const Epi& E) {
    const int tid = otid(), wid = __builtin_amdgcn_readfirstlane(tid >> 6), lane = tid & 63, wr = wid >> 2, wc = wid & 3, fr = lane & 15, fq = lane >> 4;
    const int K = g.K, nt = K / BK;
    unsigned voffA[2], voffB[2];
#pragma unroll
    for (int i = 0; i < 2; ++i) { int R, C; stage_rc(tid * 16 + i * 8192, R, C); const int Rb = Epi::PERM ? ((R & ~31) + perm32(R & 31)) : R;
        voffA[i] = (unsigned)(R * K + C) * 2u; voffB[i] = (unsigned)(Rb * K + C) * 2u; }
    const size_t kstep = (size_t)(BK * 2);
    const size_t hstep = (size_t)HALF * K * 2;
    const size_t tstep = 2 * hstep;
    const unsigned ldsw = (unsigned)wid * 1024u;
    const int aoff = lds_byte(wr * 64 + fr, fq * 8), boff = lds_byte(wc * 32 + fr, fq * 8);
#define PG8_SA(b, h) (((b) * 2 + (h)) * HTB)
#define PG8_SB(b, h) ((4 + (b) * 2 + (h)) * HTB)
#define PG8_STAGE(bufoff, gbase, voff) do { _Pragma("unroll") for (int _i = 0; _i < 2; ++_i) \
        __builtin_amdgcn_global_load_lds((const unsigned*)((const char*)(gbase) + (voff)[_i]), (LAS unsigned*)(lds + (bufoff) + ldsw + _i * 8192), 16, 0, 0); } while (0)
#define PG8_LDA(dst, b, h) do { _Pragma("unroll") for (int m = 0; m < 4; ++m) _Pragma("unroll") for (int k = 0; k < 2; ++k) dst[m][k] = *(const LAS bf16x8*)(lds + PG8_SA(b, h) + aoff + m * 2048 + k * 1024); } while (0)
#define PG8_LDB(dst, b, h) do { _Pragma("unroll") for (int n = 0; n < 2; ++n) _Pragma("unroll") for (int k = 0; k < 2; ++k) dst[n][k] = *(const LAS bf16x8*)(lds + PG8_SB(b, h) + boff + n * 2048 + k * 1024); } while (0)
#define PG8_MMA(ai, bj, At, Bt) do { __builtin_amdgcn_s_setprio(1); _Pragma("unroll") for (int m = 0; m < 4; ++m) _Pragma("unroll") for (int n = 0; n < 2; ++n) _Pragma("unroll") for (int k = 0; k < 2; ++k) \
        acc[ai][bj][m][n] = __builtin_amdgcn_mfma_f32_16x16x32_bf16(Bt[n][k], At[m][k], acc[ai][bj][m][n], 0, 0, 0); __builtin_amdgcn_s_setprio(0); } while (0)
#define PG8_WAIT_V(n) asm volatile("s_waitcnt vmcnt(" #n ")" ::: "memory")
#define PG8_WAIT_L(n) asm volatile("s_waitcnt lgkmcnt(" #n ")" ::: "memory")
#define PG8_BAR __builtin_amdgcn_s_barrier()
#define PG8_SCHED __builtin_amdgcn_sched_barrier(0)
    Unit cur, nxt; int ui = 0;
    if (!S.next(0, cur)) return;
    f32x4 acc[2][2][4][2];
#pragma unroll
    for (int a = 0; a < 2; ++a)
#pragma unroll
        for (int b = 0; b < 2; ++b)
#pragma unroll
            for (int m = 0; m < 4; ++m)
#pragma unroll
                for (int n = 0; n < 2; ++n) acc[a][b][m][n] = (f32x4){0.f, 0.f, 0.f, 0.f};
    bf16x8 At[4][2], B0[2][2], B1[2][2];
    const char* cA = (const char*)g.A + (size_t)cur.pm * tstep; const char* cB = (const char*)g.Bt + (size_t)cur.pn * tstep;
    PG8_STAGE(PG8_SB(0, 0), cB, voffB); PG8_STAGE(PG8_SA(0, 0), cA, voffA); PG8_STAGE(PG8_SB(0, 1), cB + hstep, voffB); PG8_STAGE(PG8_SA(0, 1), cA + hstep, voffA);
    if (wr == 1) PG8_BAR;
    PG8_WAIT_V(4); PG8_BAR;
    PG8_STAGE(PG8_SB(1, 0), cB + kstep, voffB); PG8_STAGE(PG8_SA(1, 0), cA + kstep, voffA); PG8_STAGE(PG8_SB(1, 1), cB + hstep + kstep, voffB);
    PG8_WAIT_V(6); PG8_BAR;
    for (;;) {
        const bool has_next = S.next(ui + 1, nxt);
        const char* nA = has_next ? (const char*)g.A + (size_t)nxt.pm * tstep : cA; const char* nB = has_next ? (const char*)g.Bt + (size_t)nxt.pn * tstep : cB;
#pragma unroll 1
        for (int t = 0; t < nt; t += 2) {
            const bool last = (t == nt - 2);
            const char* a1 = cA + (size_t)(t + 1) * kstep;
            const char* a2 = last ? nA : cA + (size_t)(t + 2) * kstep; const char* b2 = last ? nB : cB + (size_t)(t + 2) * kstep;
            const char* a3 = a2 + kstep; const char* b3 = b2 + kstep;
            PG8_LDB(B0, 0, 0); PG8_SCHED; PG8_LDA(At, 0, 0); PG8_STAGE(PG8_SA(1, 1), a1 + hstep, voffA);
            PG8_WAIT_L(8); PG8_BAR; PG8_WAIT_L(0); PG8_MMA(0, 0, At, B0); PG8_BAR; PG8_SCHED;
            PG8_LDB(B1, 0, 1); PG8_STAGE(PG8_SB(0, 0), b2, voffB);
            PG8_BAR; PG8_WAIT_L(0); PG8_MMA(0, 1, At, B1); PG8_BAR;
            PG8_LDA(At, 0, 1); PG8_STAGE(PG8_SA(0, 0), a2, voffA);
            PG8_BAR; PG8_WAIT_L(0); PG8_MMA(1, 0, At, B0); PG8_BAR; PG8_SCHED;
            PG8_STAGE(PG8_SB(0, 1), b2 + hstep, voffB);
            PG8_WAIT_V(6); PG8_BAR; PG8_MMA(1, 1, At, B1); PG8_BAR;
            PG8_LDB(B0, 1, 0); PG8_SCHED; PG8_LDA(At, 1, 0); PG8_STAGE(PG8_SA(0, 1), a2 + hstep, voffA);
            PG8_WAIT_L(8); PG8_BAR; PG8_WAIT_L(0); PG8_MMA(0, 0, At, B0); PG8_BAR; PG8_SCHED;
            PG8_LDB(B1, 1, 1); PG8_STAGE(PG8_SB(1, 0), b3, voffB);
            PG8_BAR; PG8_WAIT_L(0); PG8_MMA(0, 1, At, B1); PG8_BAR;
            PG8_LDA(At, 1, 1); PG8_STAGE(PG8_SA(1, 0), a3, voffA);
            PG8_BAR; PG8_WAIT_L(0); PG8_MMA(1, 0, At, B0); PG8_BAR; PG8_SCHED;
            PG8_STAGE(PG8_SB(1, 1), b3 + hstep, voffB);
            PG8_WAIT_V(6); PG8_BAR; PG8_MMA(1, 1, At, B1); PG8_BAR;
        }
        E(acc, cur, wr, wc, fr, fq);
        if (!has_next) break;
#pragma unroll
        for (int a = 0; a < 2; ++a)
#pragma unroll
            for (int b = 0; b < 2; ++b)
#pragma unroll
                for (int m = 0; m < 4; ++m)
#pragma unroll
                    for (int n = 0; n < 2; ++n) acc[a][b][m][n] = (f32x4){0.f, 0.f, 0.f, 0.f};
        cur = nxt; cA = nA; cB = nB; ++ui;
    }
    PG8_WAIT_V(0);
    if (wr == 0) PG8_BAR;
    PG8_BAR;
#undef PG8_SA
#undef PG8_SB
#undef PG8_STAGE
#undef PG8_LDA
#undef PG8_LDB
#undef PG8_MMA
#undef PG8_WAIT_V
#undef PG8_WAIT_L
#undef PG8_BAR
#undef PG8_SCHED
}
}
using pg8::cvt_pk_bf16;

constexpr int D = 1024, MP = 65536, MS = 256, MT = MP + MS, FF = 2816;
constexpr int PE = 3840, PO = 3584;
constexpr float EPSF = 1e-6f;
constexpr size_t O_Y = 0;
constexpr size_t O_PSHIFT = (size_t)MT * D;
constexpr size_t O_PRWKV = O_PSHIFT + 8 * 1792;
constexpr size_t O_PCONV = O_PRWKV + 8 * 8 * 64 * 64;
constexpr size_t O_PDELTA = O_PCONV + 8 * 3 * 1536;
constexpr size_t O_PGLA = O_PDELTA + 8 * 4 * 128 * 128;
constexpr size_t O_PRET = O_PGLA + 8 * 4 * 64 * 128;
constexpr size_t O_PMK = O_PRET + 8 * 4 * 128 * 128;
constexpr size_t O_PMV = O_PMK + 2 * 8 * 256 * 1024;
constexpr size_t O_SSHIFT = O_PMV + 2 * 8 * 256 * 1024;
constexpr size_t O_SRWKV = O_SSHIFT + 16 * 1792;
constexpr size_t O_SCONV = O_SRWKV + 16 * 8 * 64 * 64;
constexpr size_t O_SDELTA = O_SCONV + 16 * 3 * 1536;
constexpr size_t O_SGLA = O_SDELTA + 16 * 4 * 128 * 128;
constexpr size_t O_SRET = O_SGLA + 16 * 4 * 64 * 128;
constexpr size_t O_END = O_SRET + 16 * 4 * 128 * 128;
static_assert(O_END == 80631808, "output size");
constexpr size_t al256(size_t x) { return (x + 255) & ~(size_t)255; }
constexpr size_t E_F1U = 0;
constexpr size_t E_F1D = E_F1U + 2ull * 5632 * 1024;
constexpr size_t E_F2U = E_F1D + 2ull * 1024 * 2816;
constexpr size_t E_F2D = E_F2U + 2ull * 5632 * 1024;
constexpr size_t E_EIN = E_F2D + 2ull * 1024 * 2816;
constexpr size_t E_EOUT = E_EIN + 4096ull * 1024;
constexpr size_t E_OIN = E_EOUT + 1024ull * 1024;
constexpr size_t E_OOUT = E_OIN + 3840ull * 1024;
constexpr size_t E_WQ = E_OOUT + 1024ull * 1024;
constexpr size_t E_WO = E_WQ + 2ull * 1024 * 1024;
constexpr size_t E_MKV = E_WO + 2ull * 1024 * 1024;
constexpr size_t E_LR1 = E_MKV + 4096ull * 1024;
constexpr size_t E_LR2 = E_LR1 + 1024ull * 256;
constexpr size_t E_END = E_LR2 + 512ull * 256;
constexpr size_t WS_WT = 0;
constexpr size_t WS_AMEM = al256(WS_WT + E_END * 2);
constexpr size_t WS_SC = al256(WS_AMEM + 2048ull * 1024 * 2);
constexpr size_t WS_BONUS = al256(WS_SC + (size_t)MT * 16 * 4);
constexpr size_t WS_HY = al256(WS_BONUS + (size_t)MT * 8 * 4);
constexpr size_t WS_BIG = al256(WS_HY + (size_t)MT * 1024 * 2);
constexpr size_t WS_LREA = al256(WS_BIG + (size_t)MT * 3840 * 2);
constexpr size_t WS_VBWK = al256(WS_LREA + (size_t)MT * 1024 * 2);
constexpr size_t WS_AP = al256(WS_VBWK + 4160ull * 64 * 256 * 2);
constexpr size_t WS_BAR = al256(WS_AP + (size_t)MT * 256 * 2);
constexpr size_t WS_HALO = al256(WS_BAR + 3456 * 4);
constexpr size_t WS_END = al256(WS_HALO + 8ull * 128 * 3 * 1536 * 2);
constexpr size_t WS_KB = WS_BIG + (size_t)MT * 1024 * 2;
constexpr size_t WS_VTB = WS_KB + 96ull * 256 * 256 * 2;
static_assert(WS_END <= (1ull << 30), "workspace budget");
constexpr int LDS_BYTES = 155648;

struct Args { const float* in[49]; float* out; unsigned char* ws; int ph_lo, ph_hi; };
#define KAS __attribute__((address_space(4)))
__device__ __forceinline__ const float* inptr(int k) { const KAS char* kp = (const KAS char*)__builtin_amdgcn_kernarg_segment_ptr(); return *(const float* const volatile KAS*)(kp + 8 * k); }
__device__ __forceinline__ float* outptr() { const KAS char* kp = (const KAS char*)__builtin_amdgcn_kernarg_segment_ptr(); return *(float* const volatile KAS*)(kp + 8 * 49); }
__device__ __forceinline__ unsigned char* wsptr() { const KAS char* kp = (const KAS char*)__builtin_amdgcn_kernarg_segment_ptr(); return *(unsigned char* const volatile KAS*)(kp + 8 * 50); }

__device__ __forceinline__ float bf2f(bf16_t b) { return __uint_as_float((unsigned)b << 16); }
__device__ __forceinline__ bf16_t f2bf(float f) { return (bf16_t)(cvt_pk_bf16(f, 0.f) & 0xffffu); }
__device__ __forceinline__ float bflo(unsigned w) { return __uint_as_float(w << 16); }
__device__ __forceinline__ float bfhi(unsigned w) { return __uint_as_float(w & 0xffff0000u); }
__device__ __forceinline__ void unpack8(const u32x4 w, float (&f)[8]) { f[0] = bflo(w.x); f[1] = bfhi(w.x); f[2] = bflo(w.y); f[3] = bfhi(w.y); f[4] = bflo(w.z); f[5] = bfhi(w.z); f[6] = bflo(w.w); f[7] = bfhi(w.w); }
__device__ __forceinline__ u32x4 pack8(const float (&f)[8]) { u32x4 w; w.x = cvt_pk_bf16(f[0], f[1]); w.y = cvt_pk_bf16(f[2], f[3]); w.z = cvt_pk_bf16(f[4], f[5]); w.w = cvt_pk_bf16(f[6], f[7]); return w; }
template <int CTRL> __device__ __forceinline__ float dpp_mov(float v) { return __builtin_bit_cast(float, __builtin_amdgcn_update_dpp(0, __builtin_bit_cast(int, v), CTRL, 0xf, 0xf, true)); }
__device__ __forceinline__ float rowsum8(float v) { v += dpp_mov<0xB1>(v); v += dpp_mov<0x4E>(v); v += dpp_mov<0x141>(v); return v; }
__device__ __forceinline__ float rowsum16(float v) { v = rowsum8(v); v += dpp_mov<0x140>(v); return v; }
__device__ __forceinline__ float rowmax16(float v) { v = fmaxf(v, dpp_mov<0xB1>(v)); v = fmaxf(v, dpp_mov<0x4E>(v)); v = fmaxf(v, dpp_mov<0x141>(v)); v = fmaxf(v, dpp_mov<0x140>(v)); return v; }
__device__ __forceinline__ float wave_sum(float v) { v = rowsum16(v); v += __shfl_xor(v, 16); v += __shfl_xor(v, 32); return v; }
__device__ __forceinline__ float sigmoidf_(float x) { return __builtin_amdgcn_rcpf(1.f + __expf(-x)); }
__device__ __forceinline__ float siluf_(float x) { return x * sigmoidf_(x); }
__device__ __forceinline__ float tanhf_(float x) { return 1.f - 2.f * __builtin_amdgcn_rcpf(1.f + __expf(2.f * x)); }
__device__ __forceinline__ float softplusf_(float x) { return fmaxf(x, 0.f) + log1pf(__expf(-fabsf(x))); }
__device__ __forceinline__ void row_info(int row, int& s, int& t) { if (row < MP) { s = row >> 13; t = row & 8191; } else { const int r = row - MP; s = 8 + (r >> 4); t = r & 15; } }
__device__ __forceinline__ int seq_row0(int s) { return s < 8 ? s * 8192 : MP + (s - 8) * 16; }
__device__ __forceinline__ int seq_T(int s) { return s < 8 ? 8192 : 16; }
#define LDS_WAIT() asm volatile("s_waitcnt lgkmcnt(0)" ::: "memory")

__device__ __forceinline__ f32x4 mma_tile(const LAS bf16_t* A, int lda, const LAS bf16_t* B, int ldb, int K, f32x4 acc, int lane) {
    const LAS bf16_t* a = A + (lane & 15) * lda + (lane >> 4) * 8;
    const LAS bf16_t* b = B + (lane & 15) * ldb + (lane >> 4) * 8;
    for (int k = 0; k < K; k += 32) {
        const bf16x8 av = *(const LAS bf16x8*)(a + k), bv = *(const LAS bf16x8*)(b + k);
        acc = __builtin_amdgcn_mfma_f32_16x16x32_bf16(av, bv, acc, 0, 0, 0);
    }
    return acc;
}

struct EpiResid {
    static constexpr bool PERM = false;
    float* X; float scale; bf16_t* XB; bf16_t* RSP;
    __device__ __forceinline__ void operator()(const f32x4 (&acc)[2][2][4][2], const pg8::Unit& u, int wr, int wc, int fr, int fq) const {
        const int row0 = u.pm * 256 + wr * 64 + fr, col0 = u.pn * 256 + wc * 32 + 4 * fq;
#pragma unroll
        for (int ai = 0; ai < 2; ++ai)
#pragma unroll
            for (int m = 0; m < 4; ++m) { const size_t row = (size_t)(row0 + ai * 128 + m * 16); float* rowp = X + row * D + col0; bf16_t* xbp = XB + row * D + col0; float ss = 0.f;
#pragma unroll
                for (int bj = 0; bj < 2; ++bj)
#pragma unroll
                    for (int n = 0; n < 2; ++n) { f32x4* p = (f32x4*)(rowp + bj * 128 + n * 16); const f32x4 v = *p + acc[ai][bj][m][n] * scale; *p = v;
                        ss += (v[0] * v[0] + v[1] * v[1]) + (v[2] * v[2] + v[3] * v[3]);
                        u32x2 w; w.x = cvt_pk_bf16(v[0], v[1]); w.y = cvt_pk_bf16(v[2], v[3]); *(u32x2*)(xbp + bj * 128 + n * 16) = w; }
                ss += __shfl_xor(ss, 16); ss += __shfl_xor(ss, 32);
                if (fq == 0) RSP[row * 16 + u.pn * 4 + wc] = f2bf(ss); }
    }
};
__device__ __forceinline__ float row_rstd(const bf16_t* RSP, size_t row) {
    const u32x4 a = *(const u32x4*)(RSP + row * 16), b = *(const u32x4*)(RSP + row * 16 + 8);
    const float s = ((bflo(a.x) + bfhi(a.x)) + (bflo(a.y) + bfhi(a.y))) + ((bflo(a.z) + bfhi(a.z)) + (bflo(a.w) + bfhi(a.w)))
                  + ((bflo(b.x) + bfhi(b.x)) + (bflo(b.y) + bfhi(b.y))) + ((bflo(b.z) + bfhi(b.z)) + (bflo(b.w) + bfhi(b.w)));
    return rsqrtf(s * (1.f / D) + EPSF);
}
struct EpiSwiglu {
    static constexpr bool PERM = true;
    bf16_t* O; const bf16_t* RSP;
    __device__ __forceinline__ void operator()(const f32x4 (&acc)[2][2][4][2], const pg8::Unit& u, int wr, int wc, int fr, int fq) const {
        const int row0 = u.pm * 256 + wr * 64 + fr, col0 = u.pn * 128 + wc * 32 + 8 * fq;
        float rsv[2][4];
#pragma unroll
        for (int ai = 0; ai < 2; ++ai)
#pragma unroll
            for (int m = 0; m < 4; ++m) rsv[ai][m] = RSP ? row_rstd(RSP, (size_t)(row0 + ai * 128 + m * 16)) : 1.f;
#pragma unroll
        for (int ai = 0; ai < 2; ++ai)
#pragma unroll
            for (int m = 0; m < 4; ++m) {
                float v[8]; const float rs = rsv[ai][m];
#pragma unroll
                for (int n = 0; n < 2; ++n)
#pragma unroll
                    for (int j = 0; j < 4; ++j) v[4 * n + j] = siluf_(acc[ai][0][m][n][j] * rs) * (acc[ai][1][m][n][j] * rs);
                *(u32x4*)(O + (size_t)(row0 + ai * 128 + m * 16) * FF + col0) = pack8(v);
            }
    }
};
struct EpiBf16 {
    static constexpr bool PERM = true;
    bf16_t* O; int ldc; const bf16_t* RSP; float* SCp; int thin_pn;
    __device__ __forceinline__ void operator()(const f32x4 (&acc)[2][2][4][2], const pg8::Unit& u, int wr, int wc, int fr, int fq) const {
        const int row0 = u.pm * 256 + wr * 64 + fr, col0 = u.pn * 256 + wc * 32 + 8 * fq;
        const bool thin = (u.pn == thin_pn);
        float rsv[2][4];
#pragma unroll
        for (int ai = 0; ai < 2; ++ai)
#pragma unroll
            for (int m = 0; m < 4; ++m) rsv[ai][m] = RSP ? row_rstd(RSP, (size_t)(row0 + ai * 128 + m * 16)) : 1.f;
#pragma unroll
        for (int ai = 0; ai < 2; ++ai)
#pragma unroll
            for (int m = 0; m < 4; ++m) { const size_t row = (size_t)(row0 + ai * 128 + m * 16); const float rs = rsv[ai][m];
                if (thin) { if (wc == 0 && fq < 2) { *(f32x4*)(SCp + row * 16 + 8 * fq) = acc[ai][0][m][0] * rs; *(f32x4*)(SCp + row * 16 + 8 * fq + 4) = acc[ai][0][m][1] * rs; } }
                else { bf16_t* rowp = O + row * ldc + col0;
#pragma unroll
                    for (int bj = 0; bj < 2; ++bj) { const f32x4 v0 = acc[ai][bj][m][0] * rs, v1 = acc[ai][bj][m][1] * rs;
                        u32x4 w; w.x = cvt_pk_bf16(v0[0], v0[1]); w.y = cvt_pk_bf16(v0[2], v0[3]); w.z = cvt_pk_bf16(v1[0], v1[1]); w.w = cvt_pk_bf16(v1[2], v1[3]);
                        *(u32x4*)(rowp + bj * 128) = w; } } }
    }
};
struct EpiLR1 {
    static constexpr bool PERM = true;
    bf16_t* O; const float* w0; const float* a0;
    __device__ __forceinline__ void operator()(const f32x4 (&acc)[2][2][4][2], const pg8::Unit& u, int wr, int wc, int fr, int fq) const {
        const int row0 = u.pm * 256 + wr * 64 + fr, col0 = u.pn * 256 + wc * 32 + 8 * fq;
        const float* bias = (u.pn < 2) ? (w0 + col0) : (a0 + col0 - 512); const float sc = (u.pn < 2) ? -0.60653066f : 1.f;
#pragma unroll
        for (int bj = 0; bj < 2; ++bj) {
            const f32x4 b0 = *(const f32x4*)(bias + bj * 128), b1 = *(const f32x4*)(bias + bj * 128 + 4);
#pragma unroll
            for (int ai = 0; ai < 2; ++ai)
#pragma unroll
                for (int m = 0; m < 4; ++m) {
                    float v[8];
#pragma unroll
                    for (int j = 0; j < 4; ++j) { v[j] = sc * sigmoidf_(acc[ai][bj][m][0][j] + b0[j]); v[4 + j] = sc * sigmoidf_(acc[ai][bj][m][1][j] + b1[j]); }
                    *(u32x4*)(O + (size_t)(row0 + ai * 128 + m * 16) * 1024 + col0 + bj * 128) = pack8(v);
                }
        }
    }
};
struct EpiMemKV {
    static constexpr bool PERM = false;
    float* PK;
    __device__ __forceinline__ void operator()(const f32x4 (&acc)[2][2][4][2], const pg8::Unit& u, int wr, int wc, int fr, int fq) const {
        const int t = u.pn >> 2; float* base = PK + (size_t)(t & 1) * (O_PMV - O_PMK) + (size_t)(t >> 1) * (8 * 256 * 1024);
        const int row0 = u.pm * 256 + wr * 64 + fr, col0 = (u.pn & 3) * 256 + wc * 32 + 4 * fq;
#pragma unroll
        for (int ai = 0; ai < 2; ++ai)
#pragma unroll
            for (int m = 0; m < 4; ++m) { float* rowp = base + (size_t)(row0 + ai * 128 + m * 16) * 1024 + col0;
#pragma unroll
                for (int bj = 0; bj < 2; ++bj)
#pragma unroll
                    for (int n = 0; n < 2; ++n) *(f32x4*)(rowp + bj * 128 + n * 16) = acc[ai][bj][m][n]; }
    }
};
template <class Epi> __device__ __forceinline__ void run_gemm(const int wv__, LAS unsigned char* lds, const bf16_t* A, const bf16_t* Bt, int M, int N, int K, const Epi& E) {
    pg8::Gemm g{A, Bt, M, N, K}; pg8::StaticOrder S; S.init(M, N, (int)gridDim.x, (int)blockIdx.x);
    pg8::gemm_phase<Epi>(wv__, lds, g, S, E);
}

__device__ __forceinline__ void cvt_item(const float* W, int ld, int c0, int k0, bf16_t* dst, int K, const float* ks, LAS float* scr, int lane) {
#pragma unroll 8
    for (int i = 0; i < 32; ++i) { const int kk = 2 * i + (lane >> 5); float v = W[(size_t)(k0 + kk) * ld + c0 + (lane & 31)]; if (ks) v *= ks[k0 + kk]; scr[kk * 33 + (lane & 31)] = v; }
    LDS_WAIT();
    const int c = lane & 7;
#pragma unroll
    for (int j = 0; j < 4; ++j) { const int n = (lane >> 3) + 8 * j; const LAS float* s = scr + (8 * c) * 33 + n;
        u32x4 o; o.x = cvt_pk_bf16(s[0 * 33], s[1 * 33]); o.y = cvt_pk_bf16(s[2 * 33], s[3 * 33]); o.z = cvt_pk_bf16(s[4 * 33], s[5 * 33]); o.w = cvt_pk_bf16(s[6 * 33], s[7 * 33]);
        *(u32x4*)(dst + (size_t)n * K + k0 + 8 * c) = o; }
    LDS_WAIT();
}
__device__ __forceinline__ void cvt_seg(const float* W, int ld, int c0, int nc, int K, bf16_t* dst, const float* ks, LAS float* scr, int lane, int gw, int NGW, int& cum) {
    const int nb = nc / 32, n = (K / 64) * nb;
    int it = (gw - (cum % NGW) + NGW) % NGW;
    for (; it < n; it += NGW) { const int kb = it / nb, b = it % nb; cvt_item(W, ld, c0 + 32 * b, 64 * kb, dst + (size_t)(32 * b) * K, K, ks, scr, lane); }
    cum += n;
}
__device__ __forceinline__ void cvt_ffn_up(const float* wg, const float* wu, const float* ks, bf16_t* dst, LAS float* scr, int lane, int gw, int NGW, int& cum) {
    const int n = 2 * 88 * 16;
    int it = (gw - (cum % NGW) + NGW) % NGW;
    for (; it < n; it += NGW) { const int kb = it / 176, r = it % 176, gu = r / 88, cb = r % 88;
        cvt_item(gu ? wu : wg, FF, 32 * cb, 64 * kb, dst + (size_t)((cb >> 2) * 256 + gu * 128 + (cb & 3) * 32) * D, D, ks, scr, lane); }
    cum += n;
}

template <bool FROM_INPUT, int NCOL>
__device__ __forceinline__ void norm_phase(const int wv__, const float* xp, const float* xs, float* X, bf16_t* H, const float* w, const float* Wsm, int ldw, int c0w, float* SC, LAS unsigned char* lds) {
    const int tid = otid(), lane = tid & 63, wave = tid >> 6;
    const int gw = blockIdx.x * 8 + wave, NGW = gridDim.x * 8;
    LAS float* lw = (LAS float*)lds;
    if (NCOL > 0) {
        for (int idx = tid; idx < 1024 * NCOL; idx += 512) { const int k = idx / NCOL, c = idx % NCOL; const int ln = (k >> 2) & 63, j = k >> 8, i = k & 3;
            lw[((((j * 4 + i) * (NCOL / 4) + (c >> 2)) * 64 + ln) << 2) + (c & 3)] = Wsm[(size_t)k * ldw + c0w + c]; }
        __syncthreads();
    }
    f32x4 wv[4];
#pragma unroll
    for (int j = 0; j < 4; ++j) wv[j] = *(const f32x4*)(w + (lane + 64 * j) * 4);
    for (int row = gw; row < MT; row += NGW) {
        const float* src = FROM_INPUT ? (row < MP ? xp + (size_t)row * D : xs + (size_t)(row - MP) * D) : X + (size_t)row * D;
        f32x4 v[4]; float ss = 0.f;
#pragma unroll
        for (int j = 0; j < 4; ++j) { v[j] = *(const f32x4*)(src + (lane + 64 * j) * 4); ss += (v[j][0] * v[j][0] + v[j][1] * v[j][1]) + (v[j][2] * v[j][2] + v[j][3] * v[j][3]); }
        const float rstd = rsqrtf(wave_sum(ss) * (1.f / D) + EPSF);
#pragma unroll
        for (int j = 0; j < 4; ++j) {
            if (FROM_INPUT) *(f32x4*)(X + (size_t)row * D + (lane + 64 * j) * 4) = v[j];
            v[j] = v[j] * rstd * wv[j];
            u32x2 o; o.x = cvt_pk_bf16(v[j][0], v[j][1]); o.y = cvt_pk_bf16(v[j][2], v[j][3]);
            *(u32x2*)(H + (size_t)row * D + (lane + 64 * j) * 4) = o;
        }
        if (NCOL > 0) {
            float part[NCOL > 0 ? NCOL : 1];
#pragma unroll
            for (int c = 0; c < NCOL; ++c) part[c] = 0.f;
#pragma unroll
            for (int j = 0; j < 4; ++j)
#pragma unroll
                for (int i = 0; i < 4; ++i)
#pragma unroll
                    for (int cq = 0; cq < NCOL / 4; ++cq) { const f32x4 ww = *(const LAS f32x4*)(lw + ((((j * 4 + i) * (NCOL / 4) + cq) * 64 + lane) << 2));
#pragma unroll
                        for (int e = 0; e < 4; ++e) part[cq * 4 + e] += v[j][i] * ww[e]; if (cq == NCOL / 4 - 1) asm volatile("" ::: "memory"); }
            float mine = 0.f;
#pragma unroll
            for (int c = 0; c < NCOL; ++c) { const float s = wave_sum(part[c]); if (lane == c) mine = s; }
            if (lane < NCOL) SC[(size_t)row * 16 + lane] = mine;
        }
    }
}

__device__ __forceinline__ void rwkv_prep_phase(const int wv__, const bf16_t* P, bf16_t* AP, bf16_t* HALO) {
    const float* mu = inptr(18); const float* sh0 = inptr(3); float* outp = outptr();
    const int gt = blockIdx.x * 512 + otid(), NT = gridDim.x * 512;
    for (int it = gt; it < MT * 32; it += NT) {
        const int row = it >> 5, c8 = (it & 31) * 8; int s, t; row_info(row, s, t);
        float cur[8], prv[8], o[8];
        unpack8(*(const u32x4*)(P + (size_t)row * PE + 1536 + c8), cur);
        if (t > 0) unpack8(*(const u32x4*)(P + (size_t)(row - 1) * PE + 1536 + c8), prv);
        else {
#pragma unroll
            for (int i = 0; i < 8; ++i) prv[i] = (s >= 8) ? sh0[(size_t)(s - 8) * 1792 + 1536 + c8 + i] : 0.f; }
#pragma unroll
        for (int i = 0; i < 8; ++i) { const float x = cur[i] + (prv[i] - cur[i]) * mu[1536 + c8 + i]; o[i] = (c8 < 64) ? tanhf_(x) : ((c8 < 128) ? x : sigmoidf_(x)); }
        *(u32x4*)(AP + (size_t)row * 256 + c8) = pack8(o);
    }
    for (int it = gt; it < 8 * 128 * 3 * 192; it += NT) { const int ch = it % 192, r = it / 192, j = r % 3, sc = r / 3, c = sc & 127, s = sc >> 7;
        if (c > 0) *(u32x4*)(HALO + (size_t)r * 1536 + ch * 8) = *(const u32x4*)(P + (size_t)(s * 8192 + c * 64 - 3 + j) * PE + 1792 + ch * 8); }
    for (int it = gt; it < 24 * (1792 + 3 * 1536); it += NT) {
        const int s = it / 6400, r = it % 6400; const int T = seq_T(s), r0 = seq_row0(s);
        if (r < 1792) { const float v = bf2f(P[(size_t)(r0 + T - 1) * PE + r]); outp[(s < 8 ? O_PSHIFT + (size_t)s * 1792 : O_SSHIFT + (size_t)(s - 8) * 1792) + r] = v; }
        else { const int q = r - 1792, j = q / 1536, c = q % 1536; const float v = bf2f(P[(size_t)(r0 + T - 3 + j) * PE + 1792 + c]);
            outp[(s < 8 ? O_PCONV + (size_t)s * 4608 : O_SCONV + (size_t)(s - 8) * 4608) + q] = v; }
    }
}

__device__ __forceinline__ void rwkv_scan_phase(const int wv__, const bf16_t* P, const bf16_t* LREA, bf16_t* YC, float* BONUS, LAS unsigned char* lds) {
    const int tid = otid();
    LAS float* L = (LAS float*)lds;
    constexpr int BUFW = 10752;
    LAS float* YB = L + 2 * BUFW;
    const float* mu = inptr(18); const float* kkw = inptr(24); const float* kaw = inptr(25); const float* rkw = inptr(26); const float* sh0 = inptr(3); const float* st_in = inptr(4); float* outp = outptr();
    for (int item = blockIdx.x; item < 768; item += gridDim.x) {
        int s, h, q; if (item < 256) { const int bh = item >> 2; q = item & 3; s = bh >> 3; h = bh & 7; } else { const int i2 = item - 256, bh = i2 >> 2; q = i2 & 3; s = 8 + (bh >> 3); h = bh & 7; }
        const int T = seq_T(s), r0 = seq_row0(s), nch = (T + 31) >> 5;
        const bool comp = tid < 256;
        const int rl = (tid >> 4) & 15, li = tid & 15;
        f32x4 S = (f32x4){0.f, 0.f, 0.f, 0.f};
        float* stout = outp + (s < 8 ? O_PRWKV + ((size_t)(s * 8 + h) * 64 + 16 * q + rl) * 64 : O_SRWKV + ((size_t)((s - 8) * 8 + h) * 64 + 16 * q + rl) * 64) + 4 * li;
        if (comp && s >= 8) S = *(const f32x4*)(st_in + ((size_t)((s - 8) * 8 + h) * 64 + 16 * q + rl) * 64 + 4 * li);
        f32x4 mur, muk, muv, ckk, cka, crk, shr, shk, shv;
        mur = muk = muv = ckk = cka = crk = shr = shk = shv = (f32x4){0.f, 0.f, 0.f, 0.f};
        const int c0 = h * 64 + 4 * li;
        if (!comp) { mur = *(const f32x4*)(mu + c0); muk = *(const f32x4*)(mu + 512 + c0); muv = *(const f32x4*)(mu + 1024 + c0); ckk = *(const f32x4*)(kkw + c0); cka = *(const f32x4*)(kaw + c0); crk = *(const f32x4*)(rkw + c0);
            if (s >= 8) { const float* sh = sh0 + (size_t)(s - 8) * 1792; shr = *(const f32x4*)(sh + c0); shk = *(const f32x4*)(sh + 512 + c0); shv = *(const f32x4*)(sh + 1024 + c0); } }
        u32x2 raw[2][8];
#define RWKV_PREFETCH(cn) do { _Pragma("unroll") for (int ps = 0; ps < 2; ++ps) { const int t = (cn) * 32 + ps * 16 + rl; const bool ok = t < T; const bf16_t* pr = P + (size_t)(r0 + t) * PE + c0; const bf16_t* lr = LREA + (size_t)(r0 + t) * 1024 + c0; \
            const u32x2 z2 = (u32x2){0u, 0u}; \
            raw[ps][0] = ok ? *(const u32x2*)pr : z2; raw[ps][1] = ok ? *(const u32x2*)(pr + 512) : z2; raw[ps][2] = ok ? *(const u32x2*)(pr + 1024) : z2; \
            const bool okp = ok && t > 0; \
            raw[ps][3] = okp ? *(const u32x2*)(pr - PE) : z2; raw[ps][4] = okp ? *(const u32x2*)(pr - PE + 512) : z2; raw[ps][5] = okp ? *(const u32x2*)(pr - PE + 1024) : z2; \
            raw[ps][6] = ok ? *(const u32x2*)lr : z2; raw[ps][7] = ok ? *(const u32x2*)(lr + 512) : z2; } } while (0)
        if (!comp) RWKV_PREFETCH(0);
        for (int c = -1; c < nch; ++c) {
            if (!comp) {
                const int cn = c + 1;
                if (cn < nch) {
                    LAS float* B = L + (cn & 1) * BUFW;
#pragma unroll
                    for (int ps = 0; ps < 2; ++ps) {
                        const int tk = ps * 16 + rl, t = cn * 32 + tk;
                        f32x4 rc, kc, vc, rp, kp, vp, ee, aa;
#define UNPK(dst, w) dst = (f32x4){bflo((w).x), bfhi((w).x), bflo((w).y), bfhi((w).y)}
                        UNPK(rc, raw[ps][0]); UNPK(kc, raw[ps][1]); UNPK(vc, raw[ps][2]); UNPK(rp, raw[ps][3]); UNPK(kp, raw[ps][4]); UNPK(vp, raw[ps][5]); UNPK(ee, raw[ps][6]); UNPK(aa, raw[ps][7]);
#undef UNPK
                        if (t == 0) { rp = shr; kp = shk; vp = shv; }
                        const f32x4 xr = rc + (rp - rc) * mur, xk = kc + (kp - kc) * muk, xv = vc + (vp - vc) * muv;
                        const f32x4 kkv = xk * ckk;
                        const float n2 = rowsum16((kkv[0] * kkv[0] + kkv[1] * kkv[1]) + (kkv[2] * kkv[2] + kkv[3] * kkv[3]));
                        const f32x4 kk = kkv * rsqrtf(n2 + EPSF);
                        const f32x4 kpr = xk * (1.f + (aa - 1.f) * cka);
                        const f32x4 bt = xr * kpr * crk;
                        const float bon = rowsum16((bt[0] + bt[1]) + (bt[2] + bt[3]));
                        const f32x4 w = (f32x4){__expf(ee[0]), __expf(ee[1]), __expf(ee[2]), __expf(ee[3])};
                        *(LAS f32x4*)(B + tk * 64 + 4 * li) = w; *(LAS f32x4*)(B + 2048 + tk * 64 + 4 * li) = kpr; *(LAS f32x4*)(B + 4096 + tk * 64 + 4 * li) = -kk;
                        *(LAS f32x4*)(B + 6144 + tk * 64 + 4 * li) = kk * aa; *(LAS f32x4*)(B + 8192 + tk * 64 + 4 * li) = xr;
                        if ((li >> 2) == q) *(LAS f32x4*)(B + 10240 + tk * 16 + 4 * (li & 3)) = xv;
                        if (q == 0 && li == 0 && t < T) BONUS[(size_t)(r0 + t) * 8 + h] = bon;
                    }
                    if (cn + 1 < nch) RWKV_PREFETCH(cn + 1);
                }
            } else if (c >= 0) {
                const LAS float* B = L + (c & 1) * BUFW; LAS float* yb = YB + (c & 1) * 8192;
                const int nv = min(32, T - c * 32);
#define RWKV_STEP(tt) do { \
                    const f32x4 w = *(const LAS f32x4*)(B + (tt) * 64 + li * 4), kp = *(const LAS f32x4*)(B + 2048 + (tt) * 64 + li * 4), na = *(const LAS f32x4*)(B + 4096 + (tt) * 64 + li * 4), \
                                bb = *(const LAS f32x4*)(B + 6144 + (tt) * 64 + li * 4), rr = *(const LAS f32x4*)(B + 8192 + (tt) * 64 + li * 4); \
                    const float vv = B[10240 + (tt) * 16 + rl]; \
                    float sa = (S[0] * na[0] + S[1] * na[1]) + (S[2] * na[2] + S[3] * na[3]); \
                    const f32x4 tS = S * w + vv * kp; \
                    sa = rowsum16(sa); \
                    S = tS + sa * bb; \
                    yb[((tt) * 16 + rl) * 16 + li] = (S[0] * rr[0] + S[1] * rr[1]) + (S[2] * rr[2] + S[3] * rr[3]); } while (0)
                __builtin_amdgcn_s_setprio(2);
                if (nv == 32) {
#pragma unroll
                    for (int tt = 0; tt < 32; ++tt) RWKV_STEP(tt);
                } else {
                    for (int tt = 0; tt < nv; ++tt) RWKV_STEP(tt);
                }
                __builtin_amdgcn_s_setprio(0);
#undef RWKV_STEP
            }
            __syncthreads();
            if (!comp && c >= 0) {
                const LAS float* yb = YB + (c & 1) * 8192; const int tt = (tid >> 3) & 31, pr2 = tid & 7; const int t = c * 32 + tt;
                if (t < T) { const LAS f32x4* p = (const LAS f32x4*)(yb + (tt * 16 + 2 * pr2) * 16);
                    const f32x4 a0 = p[0], a1 = p[1], a2 = p[2], a3 = p[3], b0 = p[4], b1 = p[5], b2 = p[6], b3 = p[7];
                    const f32x4 sa_ = (a0 + a1) + (a2 + a3), sb_ = (b0 + b1) + (b2 + b3);
                    *(unsigned*)(YC + (size_t)(r0 + t) * 1024 + h * 64 + 16 * q + 2 * pr2) = cvt_pk_bf16((sa_[0] + sa_[1]) + (sa_[2] + sa_[3]), (sb_[0] + sb_[1]) + (sb_[2] + sb_[3])); }
            }
        }
#undef RWKV_PREFETCH
        if (comp) *(f32x4*)stout = S;
        __syncthreads();
    }
}

__device__ __forceinline__ void rwkv_post_phase(const int wv__, const bf16_t* P, const bf16_t* GATE, const float* BONUS, bf16_t* YC) {
    const int lane = otid() & 63, wave = otid() >> 6, gw = blockIdx.x * 8 + wave, NGW = gridDim.x * 8;
    const float* mu = inptr(18); const float* lnw = inptr(27); const float* lnb = inptr(28); const float* sh0 = inptr(3);
    const int h = lane >> 3, c0 = h * 64 + (lane & 7) * 8;
    float w8[8], b8[8], m8[8];
#pragma unroll
    for (int i = 0; i < 8; ++i) { w8[i] = lnw[c0 + i]; b8[i] = lnb[c0 + i]; m8[i] = mu[1024 + c0 + i]; }
    for (int row = gw; row < MT; row += NGW) {
        int s, t; row_info(row, s, t);
        float y[8], vc[8], vp[8], g[8], o[8];
        unpack8(*(const u32x4*)(YC + (size_t)row * 1024 + c0), y);
        unpack8(*(const u32x4*)(P + (size_t)row * PE + 1024 + c0), vc);
        unpack8(*(const u32x4*)(GATE + (size_t)row * 1024 + c0), g);
        if (t > 0) unpack8(*(const u32x4*)(P + (size_t)(row - 1) * PE + 1024 + c0), vp);
        else {
#pragma unroll
            for (int i = 0; i < 8; ++i) vp[i] = (s >= 8) ? sh0[(size_t)(s - 8) * 1792 + 1024 + c0 + i] : 0.f; }
        const float bon = BONUS[(size_t)row * 8 + h];
        float sm = 0.f;
#pragma unroll
        for (int i = 0; i < 8; ++i) sm += y[i];
        const float mean = rowsum8(sm) * (1.f / 64.f); float sq = 0.f;
#pragma unroll
        for (int i = 0; i < 8; ++i) { y[i] -= mean; sq += y[i] * y[i]; }
        const float rstd = rsqrtf(rowsum8(sq) * (1.f / 64.f) + 64e-5f);
#pragma unroll
        for (int i = 0; i < 8; ++i) { const float xv = vc[i] + (vp[i] - vc[i]) * m8[i]; o[i] = (y[i] * rstd * w8[i] + b8[i] + bon * xv) * g[i]; }
        *(u32x4*)(YC + (size_t)row * 1024 + c0) = pack8(o);
    }
}

__device__ __forceinline__ void delta_conv8(const float* cw, const float* cv0, const bf16_t* P, const bf16_t* HALO, int s, int r0, int T, int t0, int t, int h, int part, int cg, float (&y)[8]) {
    const int ch = part * 512 + h * 128 + cg * 8;
    float acc[8];
#pragma unroll
    for (int i = 0; i < 8; ++i) acc[i] = 0.f;
    const bool ok = t < T;
#pragma unroll
    for (int j = 0; j < 4; ++j) {
        const int tt = t - 3 + j; float x[8];
        if (ok && tt >= t0) unpack8(*(const u32x4*)(P + (size_t)(r0 + tt) * PE + 1792 + ch), x);
        else if (ok && tt >= 0) unpack8(*(const u32x4*)(HALO + ((size_t)(s * 128 + (t0 >> 6)) * 3 + (tt - t0 + 3)) * 1536 + ch), x);
        else if (ok && s >= 8) {
#pragma unroll
            for (int i = 0; i < 8; ++i) x[i] = cv0[((size_t)(s - 8) * 3 + (tt + 3)) * 1536 + ch + i]; }
        else {
#pragma unroll
            for (int i = 0; i < 8; ++i) x[i] = 0.f; }
        const f32x4 w0 = *(const f32x4*)(cw + j * 1536 + ch), w1 = *(const f32x4*)(cw + j * 1536 + ch + 4);
#pragma unroll
        for (int i = 0; i < 4; ++i) { acc[i] += x[i] * w0[i]; acc[4 + i] += x[4 + i] * w1[i]; }
    }
    float ss = 0.f;
#pragma unroll
    for (int i = 0; i < 8; ++i) { y[i] = ok ? siluf_(acc[i]) : 0.f; ss += y[i] * y[i]; }
    if (part < 2) { ss = rowsum16(ss); const float sc = rsqrtf(ss + EPSF) * (part == 0 ? 0.08838834764831845f : 1.f);
#pragma unroll
        for (int i = 0; i < 8; ++i) y[i] *= sc; }
}
__device__ __forceinline__ void delta_gates(const int wv__, float nA, float dtb, float* SC, int r0, int T, int t0, int h, LAS float* GS) {
    const int lane = otid();
    const int t = t0 + lane; float g = 0.f, be = 0.f;
    if (t < T) { const float* sc = SC + (size_t)(r0 + t) * 16; g = nA * softplusf_(sc[h] + dtb); be = sigmoidf_(sc[4 + h]); }
#pragma unroll
    for (int d = 1; d < 64; d <<= 1) { const float o = __shfl_up(g, d); if (lane >= d) g += o; }
    GS[lane] = g; GS[64 + lane] = __expf(g); GS[128 + lane] = be;
    if (t < T) { SC[(size_t)(r0 + t) * 16 + 8 + h] = g; SC[(size_t)(r0 + t) * 16 + 12 + h] = be; }
}
__device__ __forceinline__ void delta_prep_phase(const int wv__, bf16_t* P, const bf16_t* HALO, float* SC, bf16_t* VBWK, LAS unsigned char* lds) {
    const int tid = otid(), lane = tid & 63, wave = tid >> 6;
    LAS bf16_t* Ks = (LAS bf16_t*)lds;
    LAS bf16_t* Vs = Ks + 64 * 136;
    LAS float* Mm = (LAS float*)(lds + 2 * 64 * 136 * 2);
    LAS float* GS = Mm + 64 * 68;
    LAS float* SOL = GS + 192;
    LAS bf16_t* Qs = (LAS bf16_t*)(SOL + 64 * 256);
    const float* cw = inptr(29); const float* cv0 = inptr(5); const float* Alog = inptr(30); const float* dtbp = inptr(31);
    for (int task = blockIdx.x; task < 4160; task += gridDim.x) {
        int s, h, t0; if (task < 4096) { s = task >> 9; h = (task >> 7) & 3; t0 = (task & 127) * 64; } else { const int q = task - 4096; s = 8 + (q >> 2); h = q & 3; t0 = 0; }
        const int T = seq_T(s), r0 = seq_row0(s); const float nA = -__expf(Alog[h]), dtb = dtbp[h];
        if (tid < 64) delta_gates(wv__, nA, dtb, SC, r0, T, t0, h, GS);
#pragma unroll
        for (int it = 0; it < 2; ++it) { const int item = tid + 512 * it, tk = item >> 4, cg = item & 15; float y[8];
            delta_conv8(cw, cv0, P, HALO, s, r0, T, t0, t0 + tk, h, 0, cg, y); *(LAS u32x4*)(Qs + tk * 136 + cg * 8) = pack8(y);
            delta_conv8(cw, cv0, P, HALO, s, r0, T, t0, t0 + tk, h, 1, cg, y); *(LAS u32x4*)(Ks + tk * 136 + cg * 8) = pack8(y);
            delta_conv8(cw, cv0, P, HALO, s, r0, T, t0, t0 + tk, h, 2, cg, y); *(LAS u32x4*)(Vs + tk * 136 + cg * 8) = pack8(y); }
        __syncthreads();
#pragma unroll
        for (int it = 0; it < 2; ++it) { const int item = tid + 512 * it, tk = item >> 4, cg = item & 15;
            if (t0 + tk < T) { bf16_t* pr = P + (size_t)(r0 + t0 + tk) * PE + 1792 + h * 128 + cg * 8;
                *(u32x4*)pr = *(const LAS u32x4*)(Qs + tk * 136 + cg * 8); *(u32x4*)(pr + 512) = *(const LAS u32x4*)(Ks + tk * 136 + cg * 8); } }
#pragma unroll
        for (int i = 0; i < 2; ++i) { const int tile = wave + 8 * i, mi = tile >> 2, ni = tile & 3;
            f32x4 acc = mma_tile(Ks + mi * 16 * 136, 136, Ks + ni * 16 * 136, 136, 128, (f32x4){0.f, 0.f, 0.f, 0.f}, lane);
            const int m = ni * 16 + (lane & 15);
#pragma unroll
            for (int j = 0; j < 4; ++j) { const int l = mi * 16 + (lane >> 4) * 4 + j; Mm[l * 68 + m] = (l > m) ? GS[128 + l] * acc[j] * __expf(GS[l] - GS[m]) : 0.f; } }
        __syncthreads();
        if (tid < 256) {
            const int c = tid;
            for (int l = 0; l < 64; ++l) {
                float r = (c < 128) ? GS[128 + l] * bf2f(Vs[l * 136 + c]) : GS[128 + l] * GS[64 + l] * bf2f(Ks[l * 136 + (c - 128)]);
                const LAS float* Mr = Mm + l * 68;
                int m = 0;
                for (; m + 4 <= l; m += 4) { const f32x4 mv = *(const LAS f32x4*)(Mr + m);
                    r -= (mv[0] * SOL[m * 256 + c] + mv[1] * SOL[(m + 1) * 256 + c]) + (mv[2] * SOL[(m + 2) * 256 + c] + mv[3] * SOL[(m + 3) * 256 + c]); }
                for (; m < l; ++m) r -= Mr[m] * SOL[m * 256 + c];
                SOL[l * 256 + c] = r;
            }
            bf16_t* o = VBWK + (size_t)task * (64 * 256) + c;
            for (int l = 0; l < 64; ++l) o[l * 256] = f2bf(SOL[l * 256 + c]);
        }
        __syncthreads();
    }
}
__device__ __forceinline__ void delta_seq_phase(const int wv__, const bf16_t* P, const float* SC, const bf16_t* VBWK, bf16_t* SLOT, LAS unsigned char* lds) {
    const int tid = otid(), lane = tid & 63, wave = tid >> 6;
    LAS bf16_t* ST = (LAS bf16_t*)lds;
    LAS bf16_t* Wk = ST + 32 * 136;
    LAS bf16_t* Vb = Wk + 64 * 136;
    LAS bf16_t* KdT = Vb + 64 * 40;
    LAS bf16_t* UT = KdT + 128 * 72;
    LAS float* GS = (LAS float*)(UT + 32 * 72);
    const int r16 = lane & 15, q4 = (lane >> 4) * 4;
    const float* Alog = inptr(30); const float* dtbp = inptr(31); const float* dst0 = inptr(6); float* outp = outptr();
    for (int task = blockIdx.x; task < 384; task += gridDim.x) {
        const int hv = task & 3, sh = task >> 2;
        const int s = sh < 32 ? (sh >> 2) : 8 + ((sh - 32) >> 2), h = sh & 3;
        const int T = seq_T(s), r0 = seq_row0(s), nch = (T + 63) >> 6; const float nA = -__expf(Alog[h]), dtb = dtbp[h];
        f32x4 accS[2];
        const float* st0 = dst0 + (size_t)((s - 8) * 4 + h) * 128 * 128;
#pragma unroll
        for (int i = 0; i < 2; ++i) {
#pragma unroll
            for (int j = 0; j < 4; ++j) accS[i][j] = (s >= 8) ? st0[(size_t)(wave * 16 + q4 + j) * 128 + hv * 32 + i * 16 + r16] : 0.f;
            { u32x2 w; w.x = cvt_pk_bf16(accS[i][0], accS[i][1]); w.y = cvt_pk_bf16(accS[i][2], accS[i][3]); *(LAS u32x2*)(ST + (i * 16 + r16) * 136 + wave * 16 + q4) = w; }
        }
        u32x4 Rk[2], vbr[3]; float gsc = 0.f, bsc = 0.f;
#define DQ_LOAD(cc) do { const int t0n = (cc) * 64; const int vt_ = s < 8 ? (s * 4 + h) * 128 + (cc) : 4096 + (s - 8) * 4 + h; \
            _Pragma("unroll") for (int it = 0; it < 2; ++it) { const int item = tid + 512 * it, tk = item & 63, cg = item >> 6; \
                Rk[it] = (t0n + tk < T) ? *(const u32x4*)(P + (size_t)(r0 + t0n + tk) * PE + 1792 + 512 + h * 128 + cg * 8) : (u32x4){0u, 0u, 0u, 0u}; } \
            { const bf16_t* src = VBWK + (size_t)vt_ * (64 * 256); _Pragma("unroll") for (int it = 0; it < 3; ++it) { const int idx = tid + 512 * it, l = idx / 20, ch = idx % 20; \
                if (idx < 1280) vbr[it] = *(const u32x4*)(src + l * 256 + (ch < 4 ? hv * 4 + ch : 12 + ch) * 8); } } \
            if (tid < 64) { const int t = t0n + tid; gsc = 0.f; bsc = 0.f; if (t < T) { const float* sc = SC + (size_t)(r0 + t) * 16; gsc = sc[8 + h]; bsc = sc[12 + h]; } } \
            } while (0)
        DQ_LOAD(0);
        __syncthreads();
        for (int c = 0; c < nch; ++c) {
            const int tid = otid(), lane = tid & 63, wave = tid >> 6, r16 = lane & 15, q4 = (lane >> 4) * 4;
            if (tid < 64) {
                const int nv = min(64, T - c * 64); float g = gsc; const float gl_ = __shfl(g, nv - 1); if (tid >= nv) g = gl_;
                GS[tid] = g; GS[64 + tid] = __expf(g); GS[128 + tid] = bsc;
            }
#pragma unroll
            for (int it = 0; it < 3; ++it) { const int idx = tid + 512 * it, l = idx / 20, ch = idx % 20;
                if (idx < 1280) { if (ch < 4) *(LAS u32x4*)(Vb + l * 40 + ch * 8) = vbr[it]; else *(LAS u32x4*)(Wk + l * 136 + (ch - 4) * 8) = vbr[it]; } }
            if (s < 8) { bf16_t* dst = SLOT + (size_t)((s * 4 + h) * 128 + c) * 16384 + (size_t)(hv * 32) * 128;
                const int r = tid >> 4, ch = tid & 15; *(u32x4*)(dst + r * 128 + ch * 8) = *(const LAS u32x4*)(ST + r * 136 + ch * 8); }
            __syncthreads();
            const float Glast = GS[63];
#pragma unroll
            for (int it = 0; it < 2; ++it) { const int item = tid + 512 * it, tk = item & 63, cg = item >> 6; float y[8]; unpack8(Rk[it], y);
                const float kd = __expf(Glast - GS[tk]);
#pragma unroll
                for (int i = 0; i < 8; ++i) KdT[(cg * 8 + i) * 72 + tk] = f2bf(y[i] * kd); }
            if (c + 1 < nch) DQ_LOAD(c + 1);
            { const int mi = wave >> 1, ni = wave & 1;
                const f32x4 wst = mma_tile(Wk + mi * 16 * 136, 136, ST + ni * 16 * 136, 136, 128, (f32x4){0.f, 0.f, 0.f, 0.f}, lane);
                const int dv = ni * 16 + r16; float u[4];
#pragma unroll
                for (int j = 0; j < 4; ++j) { const int l = mi * 16 + q4 + j; u[j] = bf2f(Vb[l * 40 + dv]) - wst[j]; }
                u32x2 w; w.x = cvt_pk_bf16(u[0], u[1]); w.y = cvt_pk_bf16(u[2], u[3]);
                *(LAS u32x2*)(UT + dv * 72 + mi * 16 + q4) = w; }
            __syncthreads();
            const float gl = __expf(Glast);
#pragma unroll
            for (int i = 0; i < 2; ++i) accS[i] = mma_tile(KdT + wave * 16 * 72, 72, UT + i * 16 * 72, 72, 64, accS[i] * gl, lane);
#pragma unroll
            for (int i = 0; i < 2; ++i) { u32x2 w; w.x = cvt_pk_bf16(accS[i][0], accS[i][1]); w.y = cvt_pk_bf16(accS[i][2], accS[i][3]); *(LAS u32x2*)(ST + (i * 16 + r16) * 136 + wave * 16 + q4) = w; }
            __syncthreads();
        }
#undef DQ_LOAD
        float* so = outp + (s < 8 ? O_PDELTA + (size_t)(s * 4 + h) * 16384 : O_SDELTA + (size_t)((s - 8) * 4 + h) * 16384);
#pragma unroll
        for (int i = 0; i < 2; ++i)
#pragma unroll
            for (int j = 0; j < 4; ++j) so[(size_t)(wave * 16 + q4 + j) * 128 + hv * 32 + i * 16 + r16] = accS[i][j];
        __syncthreads();
    }
}
__device__ __forceinline__ void delta_out_phase(const int wv__, const bf16_t* P, const float* SC, const bf16_t* VBWK, const bf16_t* SLOT, bf16_t* YC, LAS unsigned char* lds) {
    LAS bf16_t* ST = (LAS bf16_t*)lds;
    LAS bf16_t* Qs = ST + 128 * 136;
    LAS bf16_t* Ks = Qs + 64 * 136;
    LAS bf16_t* Wk = Ks + 64 * 136;
    LAS bf16_t* Vb = Wk + 64 * 136;
    LAS bf16_t* UT = Vb + 64 * 136;
    LAS bf16_t* QKm = UT + 128 * 72;
    LAS float* GS = (LAS float*)(QKm + 64 * 72);
    LAS float* Ob = (LAS float*)Wk;
    const float* Alog = inptr(30); const float* dtbp = inptr(31); const float* dnw = inptr(32); const float* dst0 = inptr(6);
    for (int task = blockIdx.x; task < 4160; task += gridDim.x) {
        const int tid = otid(), lane = tid & 63, wave = tid >> 6, r16 = lane & 15, q4 = (lane >> 4) * 4, el = tid >> 3, ecb = (tid & 7) * 16;
        int s, h, c; if (task < 4096) { s = task >> 9; h = (task >> 7) & 3; c = task & 127; } else { const int q = task - 4096; s = 8 + (q >> 2); h = q & 3; c = 0; }
        const int T = seq_T(s), r0 = seq_row0(s), t0 = c * 64; const float nA = -__expf(Alog[h]), dtb = dtbp[h];
        u32x4 zr0 = (u32x4){0u, 0u, 0u, 0u}, zr1 = zr0;
        { const int t = t0 + el; if (t < T) { const bf16_t* p = P + (size_t)(r0 + t) * PE + 3328 + h * 128 + ecb; zr0 = *(const u32x4*)p; zr1 = *(const u32x4*)(p + 8); } }
        if (s < 8) { const bf16_t* src = SLOT + (size_t)task * 16384;
#pragma unroll
            for (int it = 0; it < 4; ++it) { const int idx = tid + 512 * it, r = idx >> 4, ch = idx & 15; *(LAS u32x4*)(ST + r * 136 + ch * 8) = *(const u32x4*)(src + r * 128 + ch * 8); } }
        else { const float* st0 = dst0 + (size_t)((s - 8) * 4 + h) * 128 * 128;
            for (int idx = tid; idx < 128 * 128; idx += 512) { const int dk = idx >> 7, dv = idx & 127; ST[dv * 136 + dk] = f2bf(st0[idx]); } }
#pragma unroll
        for (int it = 0; it < 2; ++it) { const int item = tid + 512 * it, tk = item >> 4, cg = item & 15; const bool ok = t0 + tk < T;
            const bf16_t* pr = P + (size_t)(r0 + t0 + tk) * PE + 1792 + h * 128 + cg * 8;
            *(LAS u32x4*)(Qs + tk * 136 + cg * 8) = ok ? *(const u32x4*)pr : (u32x4){0u, 0u, 0u, 0u}; *(LAS u32x4*)(Ks + tk * 136 + cg * 8) = ok ? *(const u32x4*)(pr + 512) : (u32x4){0u, 0u, 0u, 0u}; }
        { const bf16_t* src = VBWK + (size_t)task * (64 * 256);
#pragma unroll
          for (int it = 0; it < 4; ++it) { const int idx = tid + 512 * it, l = idx >> 5, ch = idx & 31; const u32x4 v = *(const u32x4*)(src + l * 256 + ch * 8);
              if (ch < 16) *(LAS u32x4*)(Vb + l * 136 + ch * 8) = v; else *(LAS u32x4*)(Wk + l * 136 + (ch - 16) * 8) = v; } }
        if (tid < 64) {
            const int t = t0 + tid; float g = 0.f, be = 0.f; const int nv = min(64, T - t0);
            if (t < T) { const float* sc = SC + (size_t)(r0 + t) * 16; g = sc[8 + h]; be = sc[12 + h]; }
            const float gl_ = __shfl(g, nv - 1); if (tid >= nv) g = gl_;
            GS[tid] = g; GS[64 + tid] = __expf(g); GS[128 + tid] = be;
        }
        __syncthreads();
        f32x4 accO[4], wst[4], qkt[2];
#pragma unroll
        for (int i = 0; i < 4; ++i) {
            wst[i] = mma_tile(Wk + i * 16 * 136, 136, ST + wave * 16 * 136, 136, 128, (f32x4){0.f, 0.f, 0.f, 0.f}, lane);
            accO[i] = mma_tile(Qs + i * 16 * 136, 136, ST + wave * 16 * 136, 136, 128, (f32x4){0.f, 0.f, 0.f, 0.f}, lane); }
#pragma unroll
        for (int i = 0; i < 2; ++i) { const int tile = wave + 8 * i, mi = tile >> 2, ni = tile & 3;
            qkt[i] = mma_tile(Qs + mi * 16 * 136, 136, Ks + ni * 16 * 136, 136, 128, (f32x4){0.f, 0.f, 0.f, 0.f}, lane); }
#pragma unroll
        for (int i = 0; i < 4; ++i) {
            const int dv = wave * 16 + r16; float u[4];
#pragma unroll
            for (int j = 0; j < 4; ++j) { const int l = i * 16 + q4 + j; u[j] = bf2f(Vb[l * 136 + dv]) - wst[i][j]; accO[i][j] *= GS[64 + l]; }
            u32x2 w; w.x = cvt_pk_bf16(u[0], u[1]); w.y = cvt_pk_bf16(u[2], u[3]);
            *(LAS u32x2*)(UT + dv * 72 + i * 16 + q4) = w;
        }
#pragma unroll
        for (int i = 0; i < 2; ++i) { const int tile = wave + 8 * i, mi = tile >> 2, ni = tile & 3; const int m = ni * 16 + r16;
#pragma unroll
            for (int j = 0; j < 4; ++j) { const int l = mi * 16 + q4 + j; QKm[l * 72 + m] = f2bf((m <= l) ? qkt[i][j] * __expf(GS[l] - GS[m]) : 0.f); } }
        __syncthreads();
#pragma unroll
        for (int i = 0; i < 4; ++i) accO[i] = mma_tile(QKm + i * 16 * 72, 72, UT + wave * 16 * 72, 72, 64, accO[i], lane);
#pragma unroll
        for (int i = 0; i < 4; ++i)
#pragma unroll
            for (int j = 0; j < 4; ++j) Ob[(i * 16 + q4 + j) * 132 + wave * 16 + r16] = accO[i][j];
        __syncthreads();
        { const int l = el, cb = ecb, t = t0 + l; float o[16], ss = 0.f;
#pragma unroll
          for (int i = 0; i < 4; ++i) { const f32x4 v = *(const LAS f32x4*)(Ob + l * 132 + cb + 4 * i); o[4 * i] = v[0]; o[4 * i + 1] = v[1]; o[4 * i + 2] = v[2]; o[4 * i + 3] = v[3]; ss += (v[0] * v[0] + v[1] * v[1]) + (v[2] * v[2] + v[3] * v[3]); }
          ss = rowsum8(ss); const float rstd = rsqrtf(ss * (1.f / 128.f) + EPSF);
          if (t < T) { const size_t row = (size_t)(r0 + t); float z[16], r[16];
              unpack8(zr0, *(float(*)[8])&z[0]); unpack8(zr1, *(float(*)[8])&z[8]);
#pragma unroll
              for (int i = 0; i < 16; ++i) r[i] = o[i] * rstd * dnw[cb + i] * siluf_(z[i]);
              *(u32x4*)(YC + row * 1024 + 512 + h * 128 + cb) = pack8(*(float(*)[8])&r[0]); *(u32x4*)(YC + row * 1024 + 512 + h * 128 + cb + 8) = pack8(*(float(*)[8])&r[8]); } }
        __syncthreads();
    }
}

template <int DK, bool RET, int MODE>
__device__ __forceinline__ void lin_chunk_task(const int wv__, const bf16_t* P, const float* SC, bf16_t* YC, bf16_t* SBUF, float* DECB, LAS unsigned char* lds, int s, int h, int c) {
    const int tid = otid(), lane = tid & 63, wave = tid >> 6;
    constexpr int LQ = DK + 8, NTK = DK / 16, NS = (8 * NTK) / 8;
    LAS bf16_t* ST = (LAS bf16_t*)lds;
    LAS bf16_t* Qi = ST + 128 * LQ;
    LAS bf16_t* Ki = Qi + 64 * LQ;
    LAS bf16_t* KoT = Ki + 64 * LQ;
    LAS bf16_t* VT = KoT + DK * 72;
    LAS bf16_t* Sc = VT + 128 * 72;
    LAS float* Ob = (LAS float*)(Sc + 64 * 72);
    LAS float* TOT = Ob + 64 * 132;
    const int r16 = lane & 15, q4 = (lane >> 4) * 4;
    const int T = seq_T(s), r0 = seq_row0(s);
    const int slot = s < 8 ? (s * 4 + h) * 128 + c : 4096 + (s - 8) * 4 + h;
    bf16_t* sb = SBUF + (size_t)slot * (DK * 128);
    const int qoff = RET ? 1536 + h * 128 : h * 64, koff = RET ? 2048 + h * 128 : 256 + h * 64, voff = RET ? 2560 + h * 128 : 512 + h * 128, goff = RET ? 3072 + h * 128 : 1024 + h * 128;
    const float lg = RET ? __logf(1.f - exp2f(-5.f - (float)h)) : 0.f;
    const int pc = tid & 63, tg = tid >> 6;
    const int vdv = tid & 127, vtg = tid >> 7;
    const int t0 = c * 64; const int nvalid = min(64, T - t0);
    unsigned qr[8], kr[8], vr[8];
#pragma unroll
    for (int i = 0; i < 8; ++i) { const int tk = tg * 8 + i; unsigned a_ = 0u, b_ = 0u;
        if (tk < nvalid) { const bf16_t* p = P + (size_t)(r0 + t0 + tk) * PO;
            if (RET) { if (MODE == 3) a_ = (unsigned)p[qoff + pc] | ((unsigned)p[qoff + 64 + pc] << 16); b_ = (unsigned)p[koff + pc] | ((unsigned)p[koff + 64 + pc] << 16); }
            else { a_ = (MODE == 3 ? (unsigned)p[qoff + pc] : 0u) | ((unsigned)p[koff + pc] << 16); } }
        qr[i] = a_; kr[i] = b_; }
#pragma unroll
    for (int i = 0; i < 8; ++i) { const int tk = vtg * 16 + 2 * i; unsigned a_ = 0u;
        if (tk < nvalid) a_ = (unsigned)P[(size_t)(r0 + t0 + tk) * PO + voff + vdv];
        if (tk + 1 < nvalid) a_ |= (unsigned)P[(size_t)(r0 + t0 + tk + 1) * PO + voff + vdv] << 16;
        vr[i] = a_; }
    if (MODE == 3) {
#pragma unroll
        for (int it = 0; it < (128 * DK / 8) / 512; ++it) { const int idx = tid + 512 * it, r = idx / (DK / 8), ch = idx % (DK / 8);
            *(LAS u32x4*)(ST + r * LQ + ch * 8) = *(const u32x4*)(sb + r * DK + ch * 8); }
    }
    *(LAS u32x4*)(VT + vdv * 72 + vtg * 16) = (u32x4){vr[0], vr[1], vr[2], vr[3]}; *(LAS u32x4*)(VT + vdv * 72 + vtg * 16 + 8) = (u32x4){vr[4], vr[5], vr[6], vr[7]};
    if (!RET) {
        const int ch = pc; float la[8], run = 0.f;
        const float* a2p = inptr(35); const float abias = inptr(36)[h * 64 + ch];
        float a2c[16];
#pragma unroll
        for (int r = 0; r < 16; ++r) a2c[r] = a2p[r * 256 + h * 64 + ch];
#pragma unroll
        for (int i = 0; i < 8; ++i) { const int tk = tg * 8 + i; float x = 0.f;
            if (tk < nvalid) { const float* sc = SC + (size_t)(r0 + t0 + tk) * 16; float z = abias;
#pragma unroll
                for (int r4 = 0; r4 < 4; ++r4) { const f32x4 sv = *(const f32x4*)(sc + r4 * 4); z += (sv[0] * a2c[r4 * 4] + sv[1] * a2c[r4 * 4 + 1]) + (sv[2] * a2c[r4 * 4 + 2] + sv[3] * a2c[r4 * 4 + 3]); }
                x = -softplusf_(-z) * (1.f / 16.f); }
            run += x; la[i] = run; }
        TOT[tg * 64 + ch] = run;
        __syncthreads();
        float pre = 0.f, tot = 0.f;
#pragma unroll
        for (int g = 0; g < 8; ++g) { const float v = TOT[g * 64 + ch]; tot += v; if (g < tg) pre += v; }
        if (MODE == 1 && tg == 0) DECB[(size_t)slot * 64 + ch] = __expf(tot);
        float ko[8];
#pragma unroll
        for (int i = 0; i < 8; ++i) { const int tk = tg * 8 + i; const float cum = la[i] + pre; const float qv = bflo(qr[i]) * 0.125f, kv = bfhi(qr[i]);
            if (MODE == 3) { Qi[tk * LQ + ch] = f2bf(qv * __expf(cum)); Ki[tk * LQ + ch] = f2bf(kv * __expf(-cum)); }
            else ko[i] = kv * __expf(tot - cum); }
        if (MODE == 1) *(LAS u32x4*)(KoT + ch * 72 + tg * 8) = pack8(ko);
    } else {
        const int pi = pc;
        const float inv = exp2f(-(float)pi * (13.287712379549449f / 64.f));
        const float tot = (float)nvalid * lg;
        float ko1[8], ko2[8];
#pragma unroll
        for (int i = 0; i < 8; ++i) { const int tk = tg * 8 + i;
            const float cum = (float)min(tk + 1, nvalid) * lg;
            const float x1 = bflo(qr[i]), x2 = bfhi(qr[i]), y1 = bflo(kr[i]), y2 = bfhi(kr[i]);
            const float pos = (float)(t0 + tk + (s >= 8 ? 1024 : 0)); const float rev = pos * inv * 0.15915494309189535f; const float fr = rev - floorf(rev);
            const float sn = __builtin_amdgcn_sinf(fr), cs = __builtin_amdgcn_cosf(fr);
            const float k1 = (y1 * cs - y2 * sn) * 0.08838834764831845f, k2 = (y1 * sn + y2 * cs) * 0.08838834764831845f;
            if (MODE == 3) { const float q1 = x1 * cs - x2 * sn, q2 = x1 * sn + x2 * cs; const float ei = __expf(cum), eo = __expf(-cum);
                Qi[tk * LQ + pi] = f2bf(q1 * ei); Qi[tk * LQ + 64 + pi] = f2bf(q2 * ei); Ki[tk * LQ + pi] = f2bf(k1 * eo); Ki[tk * LQ + 64 + pi] = f2bf(k2 * eo); }
            else { const float ek = __expf(tot - cum); ko1[i] = k1 * ek; ko2[i] = k2 * ek; } }
        if (MODE == 1) { *(LAS u32x4*)(KoT + pi * 72 + tg * 8) = pack8(ko1); *(LAS u32x4*)(KoT + (64 + pi) * 72 + tg * 8) = pack8(ko2); }
    }
    __syncthreads();
    if (MODE == 1) {
        f32x4 accS[NS];
#pragma unroll
        for (int i = 0; i < NS; ++i) { const int tile = wave + 8 * i, mi = tile / NTK, ni = tile % NTK;
            accS[i] = mma_tile(KoT + ni * 16 * 72, 72, VT + mi * 16 * 72, 72, 64, (f32x4){0.f, 0.f, 0.f, 0.f}, lane); }
#pragma unroll
        for (int i = 0; i < NS; ++i) { const int tile = wave + 8 * i, mi = tile / NTK, ni = tile % NTK;
            u32x2 w; w.x = cvt_pk_bf16(accS[i][0], accS[i][1]); w.y = cvt_pk_bf16(accS[i][2], accS[i][3]);
            *(u32x2*)(sb + (mi * 16 + r16) * DK + ni * 16 + q4) = w; }
        __syncthreads();
        return;
    }
    const int el = tid >> 3, ecb = (tid & 7) * 16;
    u32x4 zr0 = (u32x4){0u, 0u, 0u, 0u}, zr1 = zr0;
    { const int t = t0 + el; if (t < T) { const bf16_t* p = P + (size_t)(r0 + t) * PO + goff + ecb; zr0 = *(const u32x4*)p; zr1 = *(const u32x4*)(p + 8); } }
    f32x4 accO[4];
#pragma unroll
    for (int i = 0; i < 4; ++i) accO[i] = mma_tile(Qi + i * 16 * LQ, LQ, ST + wave * 16 * LQ, LQ, DK, (f32x4){0.f, 0.f, 0.f, 0.f}, lane);
    f32x4 sct[2];
#pragma unroll
    for (int i = 0; i < 2; ++i) { const int tile = wave + 8 * i, mi = tile >> 2, ni = tile & 3;
        sct[i] = mma_tile(Qi + mi * 16 * LQ, LQ, Ki + ni * 16 * LQ, LQ, DK, (f32x4){0.f, 0.f, 0.f, 0.f}, lane); }
#pragma unroll
    for (int i = 0; i < 2; ++i) { const int tile = wave + 8 * i, mi = tile >> 2, ni = tile & 3; const int m = ni * 16 + r16;
#pragma unroll
        for (int j = 0; j < 4; ++j) { const int l = mi * 16 + q4 + j; Sc[l * 72 + m] = f2bf((m <= l) ? sct[i][j] : 0.f); } }
    __syncthreads();
#pragma unroll
    for (int i = 0; i < 4; ++i) accO[i] = mma_tile(Sc + i * 16 * 72, 72, VT + wave * 16 * 72, 72, 64, accO[i], lane);
#pragma unroll
    for (int i = 0; i < 4; ++i)
#pragma unroll
        for (int j = 0; j < 4; ++j) Ob[(i * 16 + q4 + j) * 132 + wave * 16 + r16] = accO[i][j];
    __syncthreads();
    { const int l = el, cb = ecb, t = t0 + l; float o[16], sm = 0.f;
#pragma unroll
      for (int i = 0; i < 4; ++i) { const f32x4 v = *(const LAS f32x4*)(Ob + l * 132 + cb + 4 * i); o[4 * i] = v[0]; o[4 * i + 1] = v[1]; o[4 * i + 2] = v[2]; o[4 * i + 3] = v[3]; sm += (v[0] + v[1]) + (v[2] + v[3]); }
      float mean = 0.f;
      if (RET) { mean = rowsum8(sm) * (1.f / 128.f); }
      float ss = 0.f;
#pragma unroll
      for (int i = 0; i < 16; ++i) { o[i] -= mean; ss += o[i] * o[i]; }
      ss = rowsum8(ss); const float rstd = rsqrtf(ss * (1.f / 128.f) + EPSF);
      if (t < T) { const size_t row = (size_t)(r0 + t); float z[16], r[16]; const float* gnw = inptr(37);
          unpack8(zr0, *(float(*)[8])&z[0]); unpack8(zr1, *(float(*)[8])&z[8]);
#pragma unroll
          for (int i = 0; i < 16; ++i) r[i] = o[i] * rstd * (RET ? 1.f : gnw[cb + i]) * siluf_(z[i]);
          bf16_t* dst = YC + row * 1024 + (RET ? 512 : 0) + h * 128 + cb;
          *(u32x4*)dst = pack8(*(float(*)[8])&r[0]); *(u32x4*)(dst + 8) = pack8(*(float(*)[8])&r[8]); } }
    __syncthreads();
}
template <int MODE>
__device__ __forceinline__ void odd_chunk_phase(const int wv__, const bf16_t* P, const float* SC, bf16_t* YC, bf16_t* SR, bf16_t* SG, float* DECB, LAS unsigned char* lds) {
    for (int task = blockIdx.x; task < 8320; task += gridDim.x) {
        if (task < 4096) lin_chunk_task<128, true, MODE>(wv__, P, SC, YC, SR, DECB, lds, task >> 9, (task >> 7) & 3, task & 127);
        else if (task < 8192) { const int q = task - 4096; lin_chunk_task<64, false, MODE>(wv__, P, SC, YC, SG, DECB, lds, q >> 9, (q >> 7) & 3, q & 127); }
        else if (task < 8256) { const int q = task - 8192; lin_chunk_task<128, true, MODE>(wv__, P, SC, YC, SR, DECB, lds, 8 + (q >> 2), q & 3, 0); }
        else { const int q = task - 8256; lin_chunk_task<64, false, MODE>(wv__, P, SC, YC, SG, DECB, lds, 8 + (q >> 2), q & 3, 0); }
    }
}
__device__ __forceinline__ void lin_state_scan(const int wv__, bf16_t* SR, bf16_t* SG, const float* DECB) {
    const int gt = blockIdx.x * 512 + otid(), NT = gridDim.x * 512;
    const float* gin = inptr(7); const float* rin = inptr(8); float* outp = outptr();
    for (int it = gt; it < 96 * 2048 + 96 * 1024; it += NT) {
        const bool ret = it < 96 * 2048; const int q = ret ? it : it - 96 * 2048;
        const int DKc = ret ? 128 : 64, per = ret ? 2048 : 1024;
        const int sh = q / per, e = q % per; const int dv = e / (DKc / 8), dk0 = (e % (DKc / 8)) * 8;
        const int s = sh < 32 ? (sh >> 2) : 8 + ((sh - 32) >> 2), h = sh & 3;
        const int nch = s < 8 ? 128 : 1;
        const int slot0 = s < 8 ? (s * 4 + h) * 128 : 4096 + (s - 8) * 4 + h;
        bf16_t* sb = (ret ? SR : SG) + (size_t)slot0 * (DKc * 128) + dv * DKc + dk0;
        float S[8];
        if (s >= 8) { const float* st = (ret ? rin : gin) + (size_t)((s - 8) * 4 + h) * DKc * 128;
#pragma unroll
            for (int i = 0; i < 8; ++i) S[i] = st[(size_t)(dk0 + i) * 128 + dv]; }
        else {
#pragma unroll
            for (int i = 0; i < 8; ++i) S[i] = 0.f; }
        const float dret = ret ? __expf(64.f * __logf(1.f - exp2f(-5.f - (float)h))) : 0.f;
        const float dret1 = ret ? __expf(16.f * __logf(1.f - exp2f(-5.f - (float)h))) : 0.f;
        for (int c0 = 0; c0 < nch; c0 += 8) {
            u32x4 d[8]; f32x4 dcA[8], dcB[8];
#pragma unroll
            for (int u = 0; u < 8; ++u) if (c0 + u < nch) { d[u] = *(const u32x4*)(sb + (size_t)(c0 + u) * (DKc * 128));
                if (!ret) { const float* dp = DECB + (size_t)(slot0 + c0 + u) * 64 + dk0; dcA[u] = *(const f32x4*)dp; dcB[u] = *(const f32x4*)(dp + 4); } }
#pragma unroll
            for (int u = 0; u < 8; ++u) if (c0 + u < nch) {
                float dd[8]; unpack8(d[u], dd);
                *(u32x4*)(sb + (size_t)(c0 + u) * (DKc * 128)) = pack8(S);
#pragma unroll
                for (int i = 0; i < 8; ++i) { const float dec = ret ? (s < 8 ? dret : dret1) : (i < 4 ? dcA[u][i] : dcB[u][i - 4]); S[i] = S[i] * dec + dd[i]; } }
        }
        float* so = outp + (ret ? (s < 8 ? O_PRET + (size_t)(s * 4 + h) * 16384 : O_SRET + (size_t)((s - 8) * 4 + h) * 16384)
                                : (s < 8 ? O_PGLA + (size_t)(s * 4 + h) * 8192 : O_SGLA + (size_t)((s - 8) * 4 + h) * 8192));
#pragma unroll
        for (int i = 0; i < 8; ++i) so[(size_t)(dk0 + i) * 128 + dv] = S[i];
    }
}

__device__ __forceinline__ void kv_convert(const int wv__, int layer, bf16_t* KB, bf16_t* VTB, LAS unsigned char* lds) {
    const int tid = otid(), lane = tid & 63, wave = tid >> 6;
    const int gt = blockIdx.x * 512 + tid, NT = gridDim.x * 512;
    const float* outp = outptr(); const float* ck = inptr(9); const float* cv = inptr(10);
    for (int it = gt; it < 96 * 256 * 32; it += NT) {
        const int sh = it >> 13, r = it & 8191; const int s = sh >> 2, h = sh & 3, mem = r >> 5, c8 = (r & 31) * 8;
        const float* kb = (s < 8 ? outp + O_PMK + (size_t)layer * 2097152 + (size_t)s * 262144 : ck + (size_t)layer * 4194304 + (size_t)(s - 8) * 262144) + (size_t)mem * 1024 + h * 256 + c8;
        const f32x4 a = *(const f32x4*)kb, b = *(const f32x4*)(kb + 4);
        u32x4 w; w.x = cvt_pk_bf16(a[0], a[1]); w.y = cvt_pk_bf16(a[2], a[3]); w.z = cvt_pk_bf16(b[0], b[1]); w.w = cvt_pk_bf16(b[2], b[3]);
        *(u32x4*)(KB + (size_t)sh * 65536 + mem * 256 + c8) = w;
    }
    LAS float* scr = (LAS float*)(lds + wave * 8704);
    const int gw = blockIdx.x * 8 + wave, NGW = gridDim.x * 8;
    for (int it = gw; it < 96 * 32; it += NGW) { const int sh = it >> 5, r = it & 31, kb = r >> 3, nb = r & 7; const int s = sh >> 2, h = sh & 3;
        const float* vb = (s < 8 ? outp + O_PMV + (size_t)layer * 2097152 + (size_t)s * 262144 : cv + (size_t)layer * 4194304 + (size_t)(s - 8) * 262144) + h * 256;
        cvt_item(vb, 1024, 32 * nb, 64 * kb, VTB + (size_t)sh * 65536 + (size_t)(32 * nb) * 256, 256, nullptr, scr, lane); }
}
__device__ __forceinline__ void attn_phase(const int wv__, const bf16_t* Q, const bf16_t* KB, const bf16_t* VTB, bf16_t* O, LAS unsigned char* lds) {
    const int tid = otid(), lane = tid & 63, wave = tid >> 6, r16 = lane & 15, q4 = (lane >> 4) * 4;
    LAS bf16_t* QP = (LAS bf16_t*)lds;
    LAS bf16_t* KV = QP + 128 * 264;
    for (int unit = blockIdx.x; unit < 2112; unit += gridDim.x) {
        int s, h, row_base, nrows;
        if (unit < 2048) { s = unit >> 8; h = (unit >> 6) & 3; row_base = s * 8192 + (unit & 63) * 128; nrows = 128; } else { const int q = unit - 2048; s = 8 + (q >> 2); h = q & 3; row_base = MP + (s - 8) * 16; nrows = 16; }
        const bf16_t* kb = KB + (size_t)(s * 4 + h) * 65536; const bf16_t* vt = VTB + (size_t)(s * 4 + h) * 65536;
#pragma unroll
        for (int it = 0; it < 8; ++it) { const int idx = tid + 512 * it, r = idx >> 5, ch = idx & 31;
            u32x4 v = (u32x4){0u, 0u, 0u, 0u}; if (r < nrows) v = *(const u32x4*)(Q + (size_t)(row_base + r) * 1024 + h * 256 + ch * 8);
            *(LAS u32x4*)(QP + r * 264 + ch * 8) = v; }
        f32x4 accS[16];
#pragma unroll
        for (int hf = 0; hf < 2; ++hf) {
#pragma unroll
            for (int it = 0; it < 8; ++it) { const int idx = tid + 512 * it, r = idx >> 5, ch = idx & 31; *(LAS u32x4*)(KV + r * 264 + ch * 8) = *(const u32x4*)(kb + (size_t)(hf * 128 + r) * 256 + ch * 8); }
            __syncthreads();
#pragma unroll
            for (int ni = 0; ni < 8; ++ni) accS[hf * 8 + ni] = mma_tile(QP + wave * 16 * 264, 264, KV + ni * 16 * 264, 264, 256, (f32x4){0.f, 0.f, 0.f, 0.f}, lane);
            __syncthreads();
        }
        float mx[4], sm[4];
#pragma unroll
        for (int j = 0; j < 4; ++j) { float m = accS[0][j];
#pragma unroll
            for (int ni = 1; ni < 16; ++ni) m = fmaxf(m, accS[ni][j]);
            mx[j] = rowmax16(m); sm[j] = 0.f; }
#pragma unroll
        for (int ni = 0; ni < 16; ++ni)
#pragma unroll
            for (int j = 0; j < 4; ++j) { const float p = __expf((accS[ni][j] - mx[j]) * 0.0625f); accS[ni][j] = p; sm[j] += p; }
#pragma unroll
        for (int j = 0; j < 4; ++j) sm[j] = __builtin_amdgcn_rcpf(rowsum16(sm[j]));
#pragma unroll
        for (int ni = 0; ni < 16; ++ni)
#pragma unroll
            for (int j = 0; j < 4; ++j) QP[(wave * 16 + q4 + j) * 264 + ni * 16 + r16] = f2bf(accS[ni][j] * sm[j]);
        f32x4 accO[16];
#pragma unroll
        for (int ni = 0; ni < 16; ++ni) accO[ni] = (f32x4){0.f, 0.f, 0.f, 0.f};
#pragma unroll
        for (int hf = 0; hf < 2; ++hf) {
#pragma unroll
            for (int it = 0; it < 8; ++it) { const int idx = tid + 512 * it, r = idx >> 4, ch = idx & 15; *(LAS u32x4*)(KV + r * 136 + ch * 8) = *(const u32x4*)(vt + (size_t)r * 256 + hf * 128 + ch * 8); }
            __syncthreads();
#pragma unroll
            for (int ni = 0; ni < 16; ++ni) accO[ni] = mma_tile(QP + wave * 16 * 264 + hf * 128, 264, KV + ni * 16 * 136, 136, 128, accO[ni], lane);
            __syncthreads();
        }
#pragma unroll
        for (int ni = 0; ni < 16; ++ni)
#pragma unroll
            for (int j = 0; j < 4; ++j) { const int r = wave * 16 + q4 + j; if (r < nrows) O[(size_t)(row_base + r) * 1024 + h * 256 + ni * 16 + r16] = f2bf(accO[ni][j]); }
    }
}

__device__ __forceinline__ void prologue_phase(const int wv__, bf16_t* WT, bf16_t* AMEM, LAS unsigned char* lds) {
    const int tid = otid(), lane = tid & 63, wave = tid >> 6, gw = blockIdx.x * 8 + wave, NGW = gridDim.x * 8;
    LAS float* scr = (LAS float*)(lds + wave * 8704);
    int cum = 0;
    for (int l = 0; l < 2; ++l) {
        cvt_ffn_up(inptr(12) + (size_t)l * D * FF, inptr(13) + (size_t)l * D * FF, nullptr, WT + E_F1U + (size_t)l * 5632 * 1024, scr, lane, gw, NGW, cum);
        cvt_seg(inptr(14) + (size_t)l * FF * D, D, 0, D, FF, WT + E_F1D + (size_t)l * 1024 * 2816, nullptr, scr, lane, gw, NGW, cum);
        cvt_ffn_up(inptr(45) + (size_t)l * D * FF, inptr(46) + (size_t)l * D * FF, nullptr, WT + E_F2U + (size_t)l * 5632 * 1024, scr, lane, gw, NGW, cum);
        cvt_seg(inptr(47) + (size_t)l * FF * D, D, 0, D, FF, WT + E_F2D + (size_t)l * 1024 * 2816, nullptr, scr, lane, gw, NGW, cum);
        cvt_seg(inptr(40) + (size_t)l * D * D, D, 0, D, D, WT + E_WQ + (size_t)l * D * D, inptr(38) + l * D, scr, lane, gw, NGW, cum);
        cvt_seg(inptr(43) + (size_t)l * D * D, D, 0, D, D, WT + E_WO + (size_t)l * D * D, nullptr, scr, lane, gw, NGW, cum);
        cvt_seg(inptr(41) + (size_t)l * D * D, D, 0, D, D, WT + E_MKV + (size_t)(2 * l) * D * D, inptr(39) + l * D, scr, lane, gw, NGW, cum);
        cvt_seg(inptr(42) + (size_t)l * D * D, D, 0, D, D, WT + E_MKV + (size_t)(2 * l + 1) * D * D, inptr(39) + l * D, scr, lane, gw, NGW, cum);
    }
    cvt_seg(inptr(16), 3848, 0, 1792, D, WT + E_EIN, inptr(15), scr, lane, gw, NGW, cum);
    cvt_seg(inptr(16), 3848, 1792, 1536, D, WT + E_EIN + 1792ull * D, inptr(15), scr, lane, gw, NGW, cum);
    cvt_seg(inptr(16), 3848, 3336, 512, D, WT + E_EIN + 3328ull * D, inptr(15), scr, lane, gw, NGW, cum);
    cvt_seg(inptr(17), D, 0, D, D, WT + E_EOUT, nullptr, scr, lane, gw, NGW, cum);
    cvt_seg(inptr(33), 3600, 0, 1024, D, WT + E_OIN, inptr(15) + D, scr, lane, gw, NGW, cum);
    cvt_seg(inptr(33), 3600, 1040, 2560, D, WT + E_OIN + 1024ull * D, inptr(15) + D, scr, lane, gw, NGW, cum);
    cvt_seg(inptr(34), D, 0, D, D, WT + E_OOUT, nullptr, scr, lane, gw, NGW, cum);
    const int gt = blockIdx.x * 512 + tid, NTH = gridDim.x * 512;
    const float* w2p = inptr(20); const float* a2p = inptr(22); const float* g2p = inptr(23);
    for (int i = gt; i < 1024 * 256; i += NTH) { const int n = i >> 8, k = i & 255; float v = 0.f;
        if (n < 512) { if (k < 64) v = w2p[(size_t)k * 512 + n]; } else { if (k >= 64 && k < 128) v = a2p[(size_t)(k - 64) * 512 + (n - 512)]; }
        WT[E_LR1 + i] = f2bf(v); }
    for (int i = gt; i < 512 * 256; i += NTH) { const int n = i >> 8, k = i & 255; WT[E_LR2 + i] = f2bf(k >= 128 ? g2p[(size_t)(k - 128) * 512 + n] : 0.f); }
    { const float* we = inptr(16); const float* wo = inptr(33); const float* nm = inptr(15);
      for (int i = gt; i < 256 * 1024; i += NTH) { const int n = i >> 10, k = i & 1023;
          WT[E_EIN + 3840ull * D + i] = f2bf(n < 8 ? we[(size_t)k * 3848 + 3328 + n] * nm[k] : 0.f);
          WT[E_OIN + 3584ull * D + i] = f2bf(n < 16 ? wo[(size_t)k * 3600 + 1024 + n] * nm[D + k] : 0.f); } }
    const float* memp = inptr(2);
    for (int row = gw; row < 2048; row += NGW) {
        const float* src = memp + (size_t)row * D; f32x4 v[4]; float ss = 0.f;
#pragma unroll
        for (int j = 0; j < 4; ++j) { v[j] = *(const f32x4*)(src + (lane + 64 * j) * 4); ss += (v[j][0] * v[j][0] + v[j][1] * v[j][1]) + (v[j][2] * v[j][2] + v[j][3] * v[j][3]); }
        const float rstd = rsqrtf(wave_sum(ss) * (1.f / D) + EPSF);
#pragma unroll
        for (int j = 0; j < 4; ++j) { u32x2 o; o.x = cvt_pk_bf16(v[j][0] * rstd, v[j][1] * rstd); o.y = cvt_pk_bf16(v[j][2] * rstd, v[j][3] * rstd); *(u32x2*)(AMEM + (size_t)row * D + (lane + 64 * j) * 4) = o; }
    }
}
__device__ __forceinline__ void norm_xb_phase(const int wv__, const bf16_t* XBp, const bf16_t* RSPp, bf16_t* H, const float* w) {
    const int lane = otid() & 63, wave = otid() >> 6, gw = blockIdx.x * 8 + wave, NGW = gridDim.x * 8;
    f32x4 wv[4];
#pragma unroll
    for (int j = 0; j < 4; ++j) wv[j] = *(const f32x4*)(w + lane * 16 + j * 4);
    for (int row = gw; row < MT; row += NGW) {
        const u32x4 a = *(const u32x4*)(XBp + (size_t)row * D + lane * 16), b = *(const u32x4*)(XBp + (size_t)row * D + lane * 16 + 8);
        const float rs = row_rstd(RSPp, (size_t)row);
        float x[16], o[16]; unpack8(a, *(float(*)[8])&x[0]); unpack8(b, *(float(*)[8])&x[8]);
#pragma unroll
        for (int i = 0; i < 16; ++i) o[i] = x[i] * rs * wv[i >> 2][i & 3];
        *(u32x4*)(H + (size_t)row * D + lane * 16) = pack8(*(float(*)[8])&o[0]); *(u32x4*)(H + (size_t)row * D + lane * 16 + 8) = pack8(*(float(*)[8])&o[8]);
    }
}
__device__ __forceinline__ void final_norm_phase(const int wv__, float* X, const float* w) {
    const int lane = otid() & 63, wave = otid() >> 6, gw = blockIdx.x * 8 + wave, NGW = gridDim.x * 8;
    f32x4 wv[4];
#pragma unroll
    for (int j = 0; j < 4; ++j) wv[j] = *(const f32x4*)(w + (lane + 64 * j) * 4);
    for (int row = gw; row < MT; row += NGW) {
        float* p = X + (size_t)row * D; f32x4 v[4]; float ss = 0.f;
#pragma unroll
        for (int j = 0; j < 4; ++j) { v[j] = *(const f32x4*)(p + (lane + 64 * j) * 4); ss += (v[j][0] * v[j][0] + v[j][1] * v[j][1]) + (v[j][2] * v[j][2] + v[j][3] * v[j][3]); }
        const float rstd = rsqrtf(wave_sum(ss) * (1.f / D) + EPSF);
#pragma unroll
        for (int j = 0; j < 4; ++j) *(f32x4*)(p + (lane + 64 * j) * 4) = v[j] * rstd * wv[j];
    }
}

#define XB_TMO      128
#define XB_XCNT(j)  (256  + 64 * (j))
#define XB_XSUB(j)  (1280 + 64 * (j))
#define XB_XGEN(j)  (2304 + 64 * (j))
#define XB_TOP      3328
#define XB_TOPGEN   3392
#define XCD_BAR_WORDS 3456
#define XB_SPIN_CAP (1u << 21)

__device__ __forceinline__ unsigned xb_ld(unsigned* p)              { return __hip_atomic_load(p, __ATOMIC_RELAXED, __HIP_MEMORY_SCOPE_AGENT); }
__device__ __forceinline__ unsigned xb_add(unsigned* p, unsigned v) { return __hip_atomic_fetch_add(p, v, __ATOMIC_RELAXED, __HIP_MEMORY_SCOPE_AGENT); }
__device__ __forceinline__ unsigned xb_xcc_id() { return (unsigned)__builtin_amdgcn_s_getreg((3 << 11) | 20) & 0xFu; }
#define XB_SPIN(cond, bar) do { unsigned _sp = 0; while (cond) { __builtin_amdgcn_s_sleep(4); \
    if ((++_sp & 255u) == 0u) { if (xb_ld(&(bar)[XB_TMO])) break; if (_sp > XB_SPIN_CAP) { atomicAdd(&(bar)[XB_TMO], 1u); break; } } } } while (0)

struct XcdBarrier {
    unsigned* bar; unsigned x;
    volatile LAS unsigned* st;
};

__device__ __forceinline__ XcdBarrier xcd_barrier_post(unsigned* bar, volatile LAS unsigned* st) {
    XcdBarrier b; b.bar = bar; b.x = xb_xcc_id(); b.st = st;
    if (threadIdx.x == 0) (void)xb_add(&bar[XB_XCNT(b.x)], 1u);
    return b;
}
__device__ __forceinline__ void xcd_barrier_complete(unsigned* bar, unsigned x, unsigned& nloc, unsigned& nx) {
    const unsigned G = gridDim.x * gridDim.y * gridDim.z;
    unsigned sum, cnt, mine, sp = 0u;
    for (;;) {
        sum = 0u; cnt = 0u; mine = 0u;
#pragma unroll
        for (unsigned j = 0; j < 16; ++j) { const unsigned c = xb_ld(&bar[XB_XCNT(j)]); sum += c; cnt += (c > 0u) ? 1u : 0u; mine = (j == x) ? c : mine; }
        if (sum == G) break;
        __builtin_amdgcn_s_sleep(4);
        if ((++sp & 255u) == 0u) { if (xb_ld(&bar[XB_TMO])) break; if (sp > XB_SPIN_CAP) { atomicAdd(&bar[XB_TMO], 1u); break; } }
    }
    nloc = mine > 0u ? mine : 1u; nx = cnt > 0u ? cnt : 1u;
}

__device__ __forceinline__ void xcd_barrier(const XcdBarrier& b) {
    asm volatile("s_waitcnt vmcnt(0)" ::: "memory");
    __syncthreads();
    if (threadIdx.x == 0) {
        unsigned* bar = b.bar;
        __builtin_amdgcn_s_waitcnt(0);
        unsigned nloc = b.st[0], nx = b.st[1];
        if (nloc == 0u) { xcd_barrier_complete(bar, b.x, nloc, nx); b.st[0] = nloc; b.st[1] = nx; }
        const unsigned old = xb_add(&bar[XB_XSUB(b.x)], 1u);
        const unsigned gen = old / nloc;
        if (old + 1u == (gen + 1u) * nloc) {
            __builtin_amdgcn_fence(__ATOMIC_RELEASE, "agent");
            asm volatile("s_waitcnt vmcnt(0)" ::: "memory");
            const unsigned og = xb_add(&bar[XB_TOP], 1u);
            const unsigned tg = og / nx;
            if (og + 1u == (tg + 1u) * nx) xb_add(&bar[XB_TOPGEN], 1u);
            else XB_SPIN(xb_ld(&bar[XB_TOPGEN]) == tg, bar);
            __builtin_amdgcn_fence(__ATOMIC_ACQUIRE, "agent");
            xb_add(&bar[XB_XGEN(b.x)], 1u);
            asm volatile("s_waitcnt vmcnt(0)" ::: "memory");
        } else {
            XB_SPIN(xb_ld(&bar[XB_XGEN(b.x)]) == gen, bar);
            __builtin_amdgcn_fence(__ATOMIC_ACQUIRE, "agent");
            asm volatile("s_waitcnt vmcnt(0)" ::: "memory");
        }
    }
    __syncthreads();
}

#define WT ((bf16_t*)(wsptr() + WS_WT))
#define AMEM ((bf16_t*)(wsptr() + WS_AMEM))
#define SC ((float*)(wsptr() + WS_SC))
#define BONUS ((float*)(wsptr() + WS_BONUS))
#define HY ((bf16_t*)(wsptr() + WS_HY))
#define BIG ((bf16_t*)(wsptr() + WS_BIG))
#define LREA ((bf16_t*)(wsptr() + WS_LREA))
#define VBWK ((bf16_t*)(wsptr() + WS_VBWK))
#define AP ((bf16_t*)(wsptr() + WS_AP))
#define KB ((bf16_t*)(wsptr() + WS_KB))
#define VTB ((bf16_t*)(wsptr() + WS_VTB))
#define X (outptr())
#ifndef SITE_MASK
#define SITE_MASK 0xffffffffffffffffull
#endif
#ifndef DUP_MASK
#define DUP_MASK 0ull
#endif
#define GSYNC() do { if (ph == lo + 1) { grid.sync(); bar = xcd_barrier_post((unsigned*)(wsptr() + WS_BAR), (volatile LAS unsigned*)(lds + LDS_BYTES - 16)); } else xcd_barrier(bar); } while (0)
#define PHASE(...) do { if (ph >= lo && ph < hi) { if (ph > lo) GSYNC(); { __VA_ARGS__ } if ((DUP_MASK >> ph) & 1ull) { xcd_barrier(bar); { __VA_ARGS__ } } } ++ph; } while (0)

#define XB LREA
#define RSP ((bf16_t*)(wsptr() + WS_BONUS))
template <int l> __device__ __forceinline__ void layer_phases(const int wv__, cg::grid_group& grid, XcdBarrier& bar, int& ph, const int lo, const int hi, LAS unsigned char* lds) {
        if (l == 0) PHASE({ { EpiMemKV E{outptr() + O_PMK}; run_gemm(wv__, lds, AMEM, WT + E_MKV, 2048, 4096, D, E); }
                            EpiSwiglu E{BIG, nullptr}; run_gemm(wv__, lds, HY, WT + E_F1U, MT, 5632, D, E); });
        else { PHASE({ norm_xb_phase(wv__, XB, RSP, HY, inptr(11) + l * D); });
               PHASE({ EpiSwiglu E{BIG, nullptr}; run_gemm(wv__, lds, HY, WT + E_F1U + (size_t)l * 5632 * 1024, MT, 5632, D, E); }); }
        PHASE({ EpiResid E{X, 0.5f, XB, RSP}; run_gemm(wv__, lds, BIG, WT + E_F1D + (size_t)l * 1024 * 2816, MT, D, FF, E); });
        if (l == 0) {
            PHASE({ EpiBf16 E{BIG, PE, RSP, SC, 15}; run_gemm(wv__, lds, XB, WT + E_EIN, MT, PE + 256, D, E); });
            PHASE({ rwkv_prep_phase(wv__, BIG, AP, (bf16_t*)(wsptr() + WS_HALO)); });
            PHASE({ { EpiLR1 E{LREA, inptr(19), inptr(21)}; run_gemm(wv__, lds, AP, WT + E_LR1, MT, 1024, 256, E); }
                    { EpiBf16 E{HY + 512, 1024, nullptr, nullptr, -1}; run_gemm(wv__, lds, AP, WT + E_LR2, MT, 512, 256, E); }
                    delta_prep_phase(wv__, BIG, (const bf16_t*)(wsptr() + WS_HALO), SC, VBWK, lds); });
            PHASE({ rwkv_scan_phase(wv__, BIG, LREA, HY, BONUS, lds); });
            PHASE({ rwkv_post_phase(wv__, BIG, HY + 512, BONUS, HY); delta_seq_phase(wv__, BIG, SC, VBWK, LREA, lds); });
            PHASE({ delta_out_phase(wv__, BIG, SC, VBWK, LREA, HY, lds); });
            PHASE({ EpiResid E{X, 1.f, XB, RSP}; run_gemm(wv__, lds, HY, WT + E_EOUT, MT, D, D, E); });
        } else {
            PHASE({ EpiBf16 E{BIG, PO, RSP, SC, 14}; run_gemm(wv__, lds, XB, WT + E_OIN, MT, PO + 256, D, E); });
            PHASE({ odd_chunk_phase<1>(wv__, BIG, SC, HY, VBWK, LREA, (float*)AP, lds); });
            PHASE({ lin_state_scan(wv__, VBWK, LREA, (const float*)AP); });
            PHASE({ odd_chunk_phase<3>(wv__, BIG, SC, HY, VBWK, LREA, (float*)AP, lds); });
            PHASE({ EpiResid E{X, 1.f, XB, RSP}; run_gemm(wv__, lds, HY, WT + E_OOUT, MT, D, D, E); });
        }
        PHASE({ kv_convert(wv__, l, KB, VTB, lds); __syncthreads(); EpiBf16 E{BIG, 1024, RSP, nullptr, -1}; run_gemm(wv__, lds, XB, WT + E_WQ + (size_t)l * D * D, MT, D, D, E); });
        PHASE({ attn_phase(wv__, BIG, KB, VTB, HY, lds); });
        PHASE({ EpiResid E{X, 1.f, XB, RSP}; run_gemm(wv__, lds, HY, WT + E_WO + (size_t)l * D * D, MT, D, D, E); });
        PHASE({ norm_xb_phase(wv__, XB, RSP, HY, inptr(44) + l * D); });
        PHASE({ EpiSwiglu E{BIG, nullptr}; run_gemm(wv__, lds, HY, WT + E_F2U + (size_t)l * 5632 * 1024, MT, 5632, D, E); });
        PHASE({ EpiResid E{X, 0.5f, XB, RSP}; run_gemm(wv__, lds, BIG, WT + E_F2D + (size_t)l * 1024 * 2816, MT, D, FF, E); });
}
constexpr int NPHASE = 31;
__global__ void __launch_bounds__(512, 2) hybrid_fwd(Args a) {
    extern __shared__ __attribute__((aligned(16))) unsigned char lds_raw[];
    LAS unsigned char* lds = (LAS unsigned char*)lds_raw;
    cg::grid_group grid = cg::this_grid();
    const int wv__ = __builtin_amdgcn_readfirstlane((int)(threadIdx.x >> 6));
    const int lo = a.ph_lo, hi = a.ph_hi;
    int ph = 0;
    if (threadIdx.x < 4) ((LAS unsigned*)(lds + LDS_BYTES - 16))[threadIdx.x] = 0u;
    if (blockIdx.x == 0) { unsigned* bw = (unsigned*)(wsptr() + WS_BAR); for (int i = threadIdx.x; i < 3456; i += 512) bw[i] = 0u; }
    __syncthreads();
    XcdBarrier bar; bar.bar = nullptr; bar.x = 0; bar.st = nullptr;
    PHASE({ prologue_phase(wv__, WT, AMEM, lds); __syncthreads(); norm_phase<true, 0>(wv__, inptr(0), inptr(1), X, HY, inptr(11), nullptr, 0, 0, nullptr, lds); });
#ifdef TEST_ORDER
    PHASE({ if (blockIdx.x == 0) { const long long t0 = wall_clock64(); while (wall_clock64() - t0 < 300000) __builtin_amdgcn_s_sleep(64);
            float* xo = X; for (int i = otid(); i < 1024; i += 512) xo[i] = 1.0f; } });
    PHASE({ float* xo = X; const float v = ((volatile float*)xo)[0] + 1.0f; const int gt = blockIdx.x * 512 + otid(); for (size_t i = 1024 + gt; i < (size_t)MT * 1024; i += (size_t)gridDim.x * 512) xo[i] = v; });
    return;
#endif
    layer_phases<0>(wv__, grid, bar, ph, lo, hi, lds);
    layer_phases<1>(wv__, grid, bar, ph, lo, hi, lds);
#ifdef EXTRA_SYNCS
    for (int i = 0; i < EXTRA_SYNCS; ++i) grid.sync();
#endif
    PHASE({ final_norm_phase(wv__, X, inptr(48)); });
#undef PHASE
}

extern "C" void kernel_launch(void* const* d_in, const int* in_sizes, int n_in, void* d_out, int out_size, void* d_ws, size_t ws_size, hipStream_t stream) {
    static int grid = 0;
    if (grid == 0) {
        int dev = 0, cus = 0, per_cu = 0;
        hipGetDevice(&dev);
        hipDeviceGetAttribute(&cus, hipDeviceAttributeMultiprocessorCount, dev);
        if (hipFuncSetAttribute((const void*)hybrid_fwd, hipFuncAttributeMaxDynamicSharedMemorySize, LDS_BYTES) != hipSuccess) fprintf(stderr, "kernel_launch: hipFuncSetAttribute failed\n");
        if (hipOccupancyMaxActiveBlocksPerMultiprocessor(&per_cu, (const void*)hybrid_fwd, 512, LDS_BYTES) != hipSuccess || per_cu < 1) { fprintf(stderr, "kernel_launch: occupancy query says %d\n", per_cu); per_cu = 1; }
        (void)hipGetLastError();
        grid = cus > 0 ? cus : 256;
        if (n_in != 49 || (size_t)out_size != O_END || ws_size < WS_END) fprintf(stderr, "kernel_launch: unexpected sizes n_in %d out %d ws %zu (need %zu)\n", n_in, out_size, ws_size, (size_t)WS_END);
    }
#ifdef DBG_MEMSET
    (void)hipMemsetAsync(d_ws, 0, WS_END, stream);
#endif
    Args a{};
    for (int i = 0; i < 49; ++i) a.in[i] = (const float*)d_in[i];
    a.out = (float*)d_out; a.ws = (unsigned char*)d_ws;
#ifndef N_LAUNCH_PER_PHASE
    a.ph_lo = 0; a.ph_hi = NPHASE;
    void* args[] = {&a};
    hipError_t e = hipLaunchCooperativeKernel((const void*)hybrid_fwd, dim3(grid), dim3(512), args, LDS_BYTES, stream);
    if (e != hipSuccess) fprintf(stderr, "cooperative launch failed: %s (grid %d)\n", hipGetErrorString(e), grid);
#else
#ifndef PH_STOP
#define PH_STOP NPHASE
#endif
    for (int p = 0; p < PH_STOP; ++p) {
        a.ph_lo = p; a.ph_hi = p + 1;
        void* args[] = {&a};
        hipError_t e = hipLaunchCooperativeKernel((const void*)hybrid_fwd, dim3(grid), dim3(512), args, LDS_BYTES, stream);
        if (e != hipSuccess) { fprintf(stderr, "cooperative launch %d failed: %s (grid %d)\n", p, hipGetErrorString(e), grid); break; }
    }
#endif
}
```
